# Optimizing an MI355X kernel written in HIP

```python
import jax
import jax.numpy as jnp
from jax import lax
import numpy as np

D_MODEL = 1024
BATCH = 4
SEQ = 8192
DEPTH = 1

GRID_W = 64
N_MEM = 256
HEAD_DIM = 64
NA_HEADS = 6
NA_WIDTH = NA_HEADS * HEAD_DIM
NA_WIN_ROWS = 8
NA_WIN_COLS = 16
RW_HEADS = 6
RW_WIDTH = RW_HEADS * HEAD_DIM
DECAY_LORA = 64
AAA_LORA = 64
GATE_LORA = 128
MEM_HEADS = 4
MEM_WIDTH = MEM_HEADS * HEAD_DIM
N_BRANCH = 3
N_EXPERTS = 16
EC_CAPACITY = 2
EXPERT_FF = 2 * D_MODEL
RMS_EPS = 1e-6
GN_EPS = 64e-5
IN_WIDTHS = (NA_WIDTH, NA_WIDTH, NA_WIDTH, RW_WIDTH, RW_WIDTH, RW_WIDTH, DECAY_LORA, AAA_LORA, GATE_LORA, MEM_WIDTH, D_MODEL, D_MODEL, D_MODEL)
D_IN = sum(IN_WIDTHS)

kernel_name = 'hybrid_na_rwkv7_mem_ecmoe_encoder'


def rms_norm(x, g):
    xf = x.astype(jnp.float32)
    y = xf * lax.rsqrt(jnp.mean(xf * xf, axis=-1, keepdims=True) + RMS_EPS)
    return (y * g.astype(jnp.float32)).astype(x.dtype)


def split_columns(p):
    cuts = []
    acc = 0
    for w in IN_WIDTHS[:-1]:
        acc += w
        cuts.append(acc)
    return jnp.split(p, cuts, axis=-1)


def to_heads(t, n_heads):
    b, s, c = t.shape
    return t.reshape(b, s, n_heads, c // n_heads)


def neighborhood_attention(q, k, v, rpb):
    b, s, h, dh = q.shape
    rows = s // GRID_W
    kr = min(NA_WIN_ROWS, rows)
    kc = NA_WIN_COLS
    q = (q * (dh ** -0.5)).reshape(b, rows, GRID_W, h, dh).transpose(1, 0, 2, 3, 4)
    k = k.reshape(b, rows, GRID_W, h, dh)
    v = v.reshape(b, rows, GRID_W, h, dh)
    col = jnp.arange(GRID_W)
    col_start = jnp.clip(col - kc // 2, 0, GRID_W - kc)
    col_idx = col_start[:, None] + jnp.arange(kc)[None, :]
    col_off = col_idx - col[:, None] + (NA_WIN_COLS - 1)

    def row_block(args):
        r, q_r = args
        r_start = jnp.clip(r - kr // 2, 0, rows - kr)
        k_win = lax.dynamic_slice_in_dim(k, r_start, kr, axis=1)[:, :, col_idx]
        v_win = lax.dynamic_slice_in_dim(v, r_start, kr, axis=1)[:, :, col_idx]
        row_off = r_start + jnp.arange(kr) - r + (NA_WIN_ROWS - 1)
        bias = rpb[:, row_off[:, None, None], col_off[None, :, :]].transpose(0, 2, 1, 3)
        scores = jnp.einsum('bwhd,biwjhd->bhwij', q_r, k_win).astype(jnp.float32) + bias.astype(jnp.float32)[None]
        probs = jax.nn.softmax(scores.reshape(b, h, GRID_W, kr * kc), axis=-1).reshape(b, h, GRID_W, kr, kc)
        return jnp.einsum('bhwij,biwjhd->bwhd', probs.astype(v.dtype), v_win)

    out = lax.map(row_block, (jnp.arange(rows), q))
    return out.transpose(1, 0, 2, 3, 4).reshape(b, s, h * dh)


def token_shift(t, direction):
    if direction == 0:
        return jnp.pad(t[:, :-1], ((0, 0), (1, 0), (0, 0)))
    return jnp.pad(t[:, 1:], ((0, 0), (0, 1), (0, 0)))


def wkv7_scan(r, w, k, v, a, b, reverse):
    bsz, _, h, n = r.shape

    def step(state, inp):
        r_t, w_t, k_t, v_t, a_t, b_t = inp
        sa = jnp.einsum('bhvk,bhk->bhv', state, a_t)
        state = state * w_t[:, :, None, :] + sa[..., None] * b_t[:, :, None, :] + v_t[..., None] * k_t[:, :, None, :]
        return state, jnp.einsum('bhvk,bhk->bhv', state, r_t)

    xs = tuple(t.transpose(1, 0, 2, 3) for t in (r, w, k, v, a, b))
    _, y = lax.scan(step, jnp.zeros((bsz, h, n, n), jnp.float32), xs, reverse=reverse)
    return y.transpose(1, 0, 2, 3)


def rwkv7_bidirectional(p_r, p_k, p_v, lat_w, lat_a, lat_g, mu_rkv, mu_w, mu_a, w0, w2, a0, a2, k_k, k_a, r_k, g2, ln_g, ln_b):
    out_dtype = p_r.dtype
    f32 = lambda t: t.astype(jnp.float32)
    p_r, p_k, p_v, lat_w, lat_a, lat_g = (f32(t) for t in (p_r, p_k, p_v, lat_w, lat_a, lat_g))
    mu_rkv, mu_w, mu_a, w0, w2, a0, a2 = (f32(t) for t in (mu_rkv, mu_w, mu_a, w0, w2, a0, a2))
    k_k, k_a, r_k, g2, ln_g, ln_b = (f32(t) for t in (k_k, k_a, r_k, g2, ln_g, ln_b))
    bsz, s, c = p_r.shape
    y_sum = jnp.zeros((bsz, s, RW_HEADS, HEAD_DIM), jnp.float32)
    bonus_sum = jnp.zeros((bsz, s, RW_HEADS, HEAD_DIM), jnp.float32)
    for d in range(2):
        def mix(t, mu):
            return t + (token_shift(t, d) - t) * mu
        r = mix(p_r, mu_rkv[d, 0])
        k = mix(p_k, mu_rkv[d, 1])
        v = mix(p_v, mu_rkv[d, 2])
        w_log = -jax.nn.softplus(-(w0[d] + jnp.tanh(mix(lat_w, mu_w[d])) @ w2[d])) - 0.5
        decay = jnp.exp(-jnp.exp(w_log))
        a = jax.nn.sigmoid(a0[d] + mix(lat_a, mu_a[d]) @ a2[d])
        kk = to_heads(k * k_k, RW_HEADS)
        kk = kk / jnp.maximum(jnp.sqrt(jnp.sum(kk * kk, axis=-1, keepdims=True)), 1e-12)
        k = k * (1.0 + (a - 1.0) * k_a)
        rh, kh, vh, ah = (to_heads(t, RW_HEADS) for t in (r, k, v, a))
        y_sum = y_sum + wkv7_scan(rh, to_heads(decay, RW_HEADS), kh, vh, -kk, kk * ah, reverse=(d == 1))
        bonus_sum = bonus_sum + jnp.sum(rh * kh * r_k, axis=-1, keepdims=True) * vh
    mean = jnp.mean(y_sum, axis=-1, keepdims=True)
    var = jnp.mean(jnp.square(y_sum - mean), axis=-1, keepdims=True)
    y = ((y_sum - mean) * lax.rsqrt(var + GN_EPS)).reshape(bsz, s, c) * ln_g + ln_b
    y = y + bonus_sum.reshape(bsz, s, c)
    g = jax.nn.sigmoid(lat_g) @ g2
    return (y * g).astype(out_dtype)


def memory_attention(q, mem_h, w_mem_kv):
    b, s, _ = q.shape
    mk, mv = jnp.split(mem_h @ w_mem_kv, 2, axis=-1)
    qh = to_heads(q, MEM_HEADS) * (HEAD_DIM ** -0.5)
    kh = to_heads(mk, MEM_HEADS)
    vh = to_heads(mv, MEM_HEADS)
    scores = jnp.einsum('bshd,bmhd->bhsm', qh, kh).astype(jnp.float32)
    probs = jax.nn.softmax(scores, axis=-1)
    return jnp.einsum('bhsm,bmhd->bshd', probs.astype(vh.dtype), vh).reshape(b, s, MEM_WIDTH)


def expert_choice_ffn(h, w_router, w_gate, w_up, w_down):
    b, s, d = h.shape
    cap = EC_CAPACITY * s // N_EXPERTS
    affinity = jax.nn.softmax((h @ w_router).astype(jnp.float32), axis=-1)
    top_val, top_idx = lax.top_k(affinity.transpose(0, 2, 1), cap)
    xe = jax.vmap(lambda hb, ib: hb[ib])(h, top_idx)
    act = jax.nn.silu(jnp.einsum('becd,edf->becf', xe, w_gate)) * jnp.einsum('becd,edf->becf', xe, w_up)
    ye = jnp.einsum('becf,efd->becd', act, w_down) * top_val[..., None].astype(h.dtype)
    return jax.vmap(lambda yb, ib: jnp.zeros((s, d), yb.dtype).at[ib.reshape(-1)].add(yb.reshape(-1, d)))(ye, top_idx)


def setup_inputs(seed: int = 0) -> dict:
    key = jax.random.key(seed)
    ks = iter(jax.random.split(key, 40))
    L = DEPTH

    def nrm(shape, scale):
        return scale * jax.random.normal(next(ks), shape, jnp.float32)

    def uni(shape):
        return jax.random.uniform(next(ks), shape, jnp.float32, 0.0, 1.0)

    decay_ramp = jnp.linspace(-6.5, -1.5, RW_WIDTH, dtype=jnp.float32)
    return {
        'x': nrm((BATCH, SEQ, D_MODEL), 1.0),
        'mem': nrm((BATCH, N_MEM, D_MODEL), 1.0),
        'norm_mix_g': 1.0 + nrm((L, D_MODEL), 0.02),
        'norm_mem_g': 1.0 + nrm((L, D_MODEL), 0.02),
        'w_in': nrm((L, D_MODEL, D_IN), D_MODEL ** -0.5),
        'na_rpb': nrm((L, NA_HEADS, 2 * NA_WIN_ROWS - 1, 2 * NA_WIN_COLS - 1), 0.05),
        'rw_mu_rkv': uni((L, 2, 3, RW_WIDTH)),
        'rw_mu_w': uni((L, 2, DECAY_LORA)),
        'rw_mu_a': uni((L, 2, AAA_LORA)),
        'rw_w0': decay_ramp + nrm((L, 2, RW_WIDTH), 0.1),
        'rw_w2': nrm((L, 2, DECAY_LORA, RW_WIDTH), 0.1),
        'rw_a0': nrm((L, 2, RW_WIDTH), 0.1),
        'rw_a2': nrm((L, 2, AAA_LORA, RW_WIDTH), 0.1),
        'rw_k_k': 0.85 + nrm((L, RW_WIDTH), 0.02),
        'rw_k_a': 1.0 + nrm((L, RW_WIDTH), 0.02),
        'rw_r_k': nrm((L, RW_HEADS, HEAD_DIM), 0.1),
        'rw_g2': nrm((L, GATE_LORA, RW_WIDTH), GATE_LORA ** -0.5),
        'rw_ln_g': 1.0 + nrm((L, RW_WIDTH), 0.02),
        'rw_ln_b': nrm((L, RW_WIDTH), 0.02),
        'w_mem_kv': nrm((L, D_MODEL, 2 * MEM_WIDTH), D_MODEL ** -0.5),
        'w_branch_na': nrm((L, NA_WIDTH, D_MODEL), NA_WIDTH ** -0.5),
        'w_branch_rw': nrm((L, RW_WIDTH, D_MODEL), RW_WIDTH ** -0.5),
        'w_branch_mem': nrm((L, MEM_WIDTH, D_MODEL), MEM_WIDTH ** -0.5),
        'w_out': nrm((L, D_MODEL, D_MODEL), D_MODEL ** -0.5),
        'norm_ffn_g': 1.0 + nrm((L, D_MODEL), 0.02),
        'w_router': nrm((L, D_MODEL, N_EXPERTS), D_MODEL ** -0.5),
        'w_exp_gate': nrm((L, N_EXPERTS, D_MODEL, EXPERT_FF), D_MODEL ** -0.5),
        'w_exp_up': nrm((L, N_EXPERTS, D_MODEL, EXPERT_FF), D_MODEL ** -0.5),
        'w_exp_down': nrm((L, N_EXPERTS, EXPERT_FF, D_MODEL), EXPERT_FF ** -0.5),
        'norm_final_g': 1.0 + nrm((D_MODEL,), 0.02),
    }


def reference(x, mem, norm_mix_g, norm_mem_g, w_in, na_rpb, rw_mu_rkv, rw_mu_w, rw_mu_a, rw_w0, rw_w2, rw_a0, rw_a2, rw_k_k, rw_k_a, rw_r_k, rw_g2, rw_ln_g, rw_ln_b, w_mem_kv, w_branch_na, w_branch_rw, w_branch_mem, w_out, norm_ffn_g, w_router, w_exp_gate, w_exp_up, w_exp_down, norm_final_g):
    for l in range(DEPTH):
        h = rms_norm(x, norm_mix_g[l])
        (na_q, na_k, na_v, p_r, p_k, p_v, lat_w, lat_a, lat_g, mem_q,
         gate_na, gate_rw, gate_mem) = split_columns(h @ w_in[l])
        y_na = neighborhood_attention(to_heads(na_q, NA_HEADS), to_heads(na_k, NA_HEADS), to_heads(na_v, NA_HEADS), na_rpb[l])
        y_rw = rwkv7_bidirectional(p_r, p_k, p_v, lat_w, lat_a, lat_g, rw_mu_rkv[l], rw_mu_w[l], rw_mu_a[l], rw_w0[l], rw_w2[l], rw_a0[l], rw_a2[l], rw_k_k[l], rw_k_a[l], rw_r_k[l], rw_g2[l], rw_ln_g[l], rw_ln_b[l])
        y_mem = memory_attention(mem_q, rms_norm(mem, norm_mem_g[l]), w_mem_kv[l])
        merged = (jax.nn.sigmoid(gate_na) * (y_na @ w_branch_na[l])
                  + jax.nn.sigmoid(gate_rw) * (y_rw @ w_branch_rw[l])
                  + jax.nn.sigmoid(gate_mem) * (y_mem @ w_branch_mem[l]))
        x = x + merged @ w_out[l]
        x = x + expert_choice_ffn(rms_norm(x, norm_ffn_g[l]), w_router[l], w_exp_gate[l], w_exp_up[l], w_exp_down[l])
    return rms_norm(x, norm_final_g)
```

```cpp
#include <hip/hip_runtime.h>
#include <hip/hip_cooperative_groups.h>
#include <cstdio>
#include <cstdint>
namespace cg = cooperative_groups;

#define LAS __attribute__((address_space(3)))
typedef unsigned short bf16_t;
typedef short bf16x8 __attribute__((ext_vector_type(8)));
typedef short s16x4 __attribute__((ext_vector_type(4)));
typedef float f32x4 __attribute__((ext_vector_type(4)));
typedef float f32x2 __attribute__((ext_vector_type(2)));
typedef unsigned u32x4 __attribute__((ext_vector_type(4)));
typedef unsigned u32x2 __attribute__((ext_vector_type(2)));
typedef __bf16 bf16x2_t __attribute__((ext_vector_type(2)));

constexpr int DM = 1024, NB = 4, SEQ = 8192, T = NB * SEQ, GRIDW = 64, GROWS = SEQ / GRIDW, NMEM = 256, HD = 64;
constexpr int NAH = 6, NAW = 384, RWH = 6, RWW = 384, MEMH = 4, MEMW = 256, NE = 16, CAP = 1024, FF = 2048;
constexpr int DIN = 5888, PW = 2816, GWD = 3072;
constexpr int C_NAQ = 0, C_NAK = 384, C_NAV = 768, C_PR = 1152, C_PK = 1536, C_PV = 1920, C_LW = 2304, C_LA = 2368, C_LG = 2432, C_MQ = 2560;
constexpr int NCH = SEQ / 64;
constexpr float RMS_EPS = 1e-6f, GN_EPS = 64e-5f;

constexpr size_t MiB = (size_t)1 << 20;
constexpr size_t WS_CTL = 0;
constexpr size_t WS_W2T = 1 * MiB;
constexpr size_t WS_A2T = WS_W2T + 98304;
constexpr size_t WS_G2T = WS_A2T + 98304;
constexpr size_t WS_AFF = 2 * MiB;
constexpr size_t WS_TIDX = 4 * MiB;
constexpr size_t WS_TVAL = WS_TIDX + 262144;
constexpr size_t WS_SLOT = 5 * MiB;
constexpr size_t WS_WIN = 8 * MiB;
constexpr size_t WS_WBR = 20 * MiB;
constexpr size_t WS_WOUT = 22 * MiB;
constexpr size_t WS_WMKV = 24 * MiB;
constexpr size_t WS_MEMN = 25 * MiB;
constexpr size_t WS_MKV = 27 * MiB;
constexpr size_t WS_XN = 28 * MiB;
constexpr size_t WS_YNA = WS_XN, WS_YMEM = WS_XN + 24 * MiB, WS_YRW = WS_XN + 40 * MiB;
constexpr size_t WS_P = 92 * MiB;
constexpr size_t WS_G = 268 * MiB;
constexpr size_t WS_RN = 460 * MiB;
constexpr size_t WS_YB = 508 * MiB;
constexpr size_t WS_MERGED = 460 * MiB;
constexpr size_t WS_WGU = 92 * MiB;
constexpr size_t WS_WD = 220 * MiB;
constexpr size_t WS_ACT = 284 * MiB;
constexpr size_t WS_YE = 92 * MiB;
constexpr size_t WS_END = 540 * MiB;
constexpr size_t DO_RM = 0;
constexpr size_t DO_RR = 48 * MiB;
constexpr size_t DO_RG = 96 * MiB;

__device__ __forceinline__ unsigned cvtpk(float lo, float hi) { f32x2 v = {lo, hi}; bf16x2_t b = __builtin_convertvector(v, bf16x2_t); return __builtin_bit_cast(unsigned, b); }
__device__ __forceinline__ bf16_t f2bf(float f) { return (bf16_t)(cvtpk(f, 0.f) & 0xffffu); }
__device__ __forceinline__ float bf2f(unsigned h) { return __uint_as_float(h << 16); }
__device__ __forceinline__ float bflo(unsigned w) { return __uint_as_float(w << 16); }
__device__ __forceinline__ float bfhi(unsigned w) { return __uint_as_float(w & 0xffff0000u); }
__device__ __forceinline__ float wave_sum(float v) {
#pragma unroll
    for (int o = 1; o < 64; o <<= 1) v += __shfl_xor(v, o);
    return v;
}
__device__ __forceinline__ float sigmoidf_(float x) { return 1.f / (1.f + __expf(-x)); }
#define LDS_WAIT() asm volatile("s_waitcnt lgkmcnt(0)" ::: "memory")
#define VM_WAIT() asm volatile("s_waitcnt vmcnt(0)" ::: "memory")
__device__ __forceinline__ void unpack8(const u32x4 w, float (&o)[8]) { o[0] = bflo(w.x); o[1] = bfhi(w.x); o[2] = bflo(w.y); o[3] = bfhi(w.y); o[4] = bflo(w.z); o[5] = bfhi(w.z); o[6] = bflo(w.w); o[7] = bfhi(w.w); }
__device__ __forceinline__ u32x4 pack8(const float (&o)[8]) { u32x4 w; w.x = cvtpk(o[0], o[1]); w.y = cvtpk(o[2], o[3]); w.z = cvtpk(o[4], o[5]); w.w = cvtpk(o[6], o[7]); return w; }
__device__ __forceinline__ void ld8f(const float* p, float (&o)[8]) { const f32x4 a = *(const f32x4*)p, b = *(const f32x4*)(p + 4); o[0] = a.x; o[1] = a.y; o[2] = a.z; o[3] = a.w; o[4] = b.x; o[5] = b.y; o[6] = b.z; o[7] = b.w; }

namespace gm {
constexpr int BM = 256, BK = 64, HALF = 128, HTB = HALF * BK * 2  , STAGE_BYTES = 8 * HTB, NXCD = 8, WGM = 8;
__device__ __forceinline__ int lds_byte(int r, int c) { const int st = (r >> 4) * 2 + (c >> 5), rr = r & 15, cc = c & 31, ob = rr * 64 + cc * 2; return st * 1024 + (ob ^ (((ob >> 9) & 1) << 5)); }
__device__ __forceinline__ void stage_rc(int b, int& R, int& C) { const int st = b / 1024, sb = b % 1024, swz = sb ^ (((sb >> 9) & 1) << 5); R = (st >> 1) * 16 + swz / 64; C = (st & 1) * 32 + (swz % 64) / 2; }
__device__ __forceinline__ int perm32(int rho) { const int n = rho >> 4, i = rho & 15; return 8 * (i >> 2) + 4 * n + (i & 3); }

struct GUnit { const char* A; const char* B; const int* gidx; int pm, pn, aux; };

__device__ __forceinline__ void tile_of(int L, int nM, int nN, int& pm, int& pn) {
    const int nwg = nM * nN; int wgid = L;
    { const int q = nwg / NXCD, r = nwg % NXCD, xcd = wgid % NXCD, off = wgid / NXCD; wgid = (xcd < r ? xcd * (q + 1) : r * (q + 1) + (xcd - r) * q) + off; }
    const int nig = WGM * nN, gid = wgid / nig, fm = gid * WGM, gsz = (nM - fm) < WGM ? (nM - fm) : WGM;
    pm = fm + ((wgid % nig) % gsz); pn = (wgid % nig) / gsz;
}

template <class Epi, class Sched>
__device__ __forceinline__ void gemm_phase(LAS unsigned char* lds, const Sched& S, const Epi& E) {
    const int tid = threadIdx.x, wid = __builtin_amdgcn_readfirstlane(tid >> 6), lane = tid & 63, wr = wid >> 2, wc = wid & 3, fr = lane & 15, fq = lane >> 4;
    const int nt = S.nt;
    const unsigned lda2 = S.lda2, ldb2 = S.ldb2;
    int RA[2]; unsigned C2[2]; unsigned voffA[2], voffB[2];
#pragma unroll
    for (int i = 0; i < 2; ++i) { int R, C; stage_rc(tid * 16 + i * 8192, R, C); const int Rb = Epi::PERM ? ((R & ~31) + perm32(R & 31)) : R;
        RA[i] = R; C2[i] = (unsigned)C * 2u; voffA[i] = (unsigned)R * lda2 + C2[i]; voffB[i] = (unsigned)Rb * ldb2 + C2[i]; }
    const size_t kstep = (size_t)(BK * 2);
    const size_t hstepA = (size_t)HALF * lda2, hstepB = (size_t)HALF * ldb2;
    const unsigned ldsw = (unsigned)wid * 1024u;
    const int aoff = lds_byte(wr * 64 + fr, fq * 8), boff = lds_byte(wc * 32 + fr, fq * 8);
#define PG8_SA(b, h) (((b) * 2 + (h)) * HTB)
#define PG8_SB(b, h) ((4 + (b) * 2 + (h)) * HTB)
#define PG8_STAGE(bufoff, gbase, voff) do { _Pragma("unroll") for (int _i = 0; _i < 2; ++_i) \
        __builtin_amdgcn_global_load_lds((const unsigned*)((const char*)(gbase) + (voff)[_i]), (LAS unsigned*)(lds + (bufoff) + ldsw + _i * 8192), 16, 0, 0); } while (0)
#define PG8_STAGE_A(bufoff, gbase, h, VO) do { if constexpr (Sched::GATHER) { PG8_STAGE(bufoff, gbase, (VO)[h]); } else { PG8_STAGE(bufoff, (gbase) + (h) * hstepA, voffA); } } while (0)
#define PG8_LDA(dst, b, h) do { _Pragma("unroll") for (int m = 0; m < 4; ++m) _Pragma("unroll") for (int k = 0; k < 2; ++k) dst[m][k] = *(const LAS bf16x8*)(lds + PG8_SA(b, h) + aoff + m * 2048 + k * 1024); } while (0)
#define PG8_LDB(dst, b, h) do { _Pragma("unroll") for (int n = 0; n < 2; ++n) _Pragma("unroll") for (int k = 0; k < 2; ++k) dst[n][k] = *(const LAS bf16x8*)(lds + PG8_SB(b, h) + boff + n * 2048 + k * 1024); } while (0)
#define PG8_MMA(ai, bj, At, Bt) do { __builtin_amdgcn_s_setprio(1); _Pragma("unroll") for (int m = 0; m < 4; ++m) _Pragma("unroll") for (int n = 0; n < 2; ++n) _Pragma("unroll") for (int k = 0; k < 2; ++k) \
        acc[ai][bj][m][n] = __builtin_amdgcn_mfma_f32_16x16x32_bf16(Bt[n][k], At[m][k], acc[ai][bj][m][n], 0, 0, 0); __builtin_amdgcn_s_setprio(0); } while (0)
#define PG8_WAIT_V(n) asm volatile("s_waitcnt vmcnt(" #n ")" ::: "memory")
#define PG8_WAIT_L(n) asm volatile("s_waitcnt lgkmcnt(" #n ")" ::: "memory")
#define PG8_BAR __builtin_amdgcn_s_barrier()
#define PG8_SCHED __builtin_amdgcn_sched_barrier(0)
    GUnit cur, nxt; int ui = 0;
    if (!S.next(0, cur)) return;
    f32x4 acc[2][2][4][2];
#pragma unroll
    for (int a = 0; a < 2; ++a)
#pragma unroll
        for (int b = 0; b < 2; ++b)
#pragma unroll
            for (int m = 0; m < 4; ++m)
#pragma unroll
                for (int n = 0; n < 2; ++n) acc[a][b][m][n] = (f32x4){0.f, 0.f, 0.f, 0.f};
    bf16x8 At[4][2], B0[2][2], B1[2][2];
    const char* cA = cur.A; const char* cB = cur.B;
    unsigned cvo[2][2], nvo[2][2];
    if constexpr (Sched::GATHER) {
#pragma unroll
        for (int h = 0; h < 2; ++h)
#pragma unroll
            for (int i = 0; i < 2; ++i) { cvo[h][i] = (unsigned)cur.gidx[h * HALF + RA[i]] * lda2 + C2[i]; nvo[h][i] = cvo[h][i]; }
    }
    PG8_STAGE(PG8_SB(0, 0), cB, voffB); PG8_STAGE(PG8_SB(0, 1), cB + hstepB, voffB); PG8_STAGE_A(PG8_SA(0, 0), cA, 0, cvo); PG8_STAGE_A(PG8_SA(0, 1), cA, 1, cvo);
    if (wr == 1) PG8_BAR;
    PG8_WAIT_V(2); PG8_BAR;
    PG8_STAGE(PG8_SB(1, 0), cB + kstep, voffB); PG8_STAGE_A(PG8_SA(1, 0), cA + kstep, 0, cvo); PG8_STAGE(PG8_SB(1, 1), cB + hstepB + kstep, voffB);
    PG8_WAIT_V(6); PG8_BAR;
    for (;;) {
        const bool has_next = S.next(ui + 1, nxt);
        const char* nA = has_next ? nxt.A : cA; const char* nB = has_next ? nxt.B : cB;
        int gi[2][2];
        if constexpr (Sched::GATHER) {
            const int* gp = has_next ? nxt.gidx : cur.gidx;
#pragma unroll
            for (int h = 0; h < 2; ++h)
#pragma unroll
                for (int i = 0; i < 2; ++i) gi[h][i] = gp[h * HALF + RA[i]];
        }
        for (int t = 0; t < nt; t += 2) {
            const bool last = (t == nt - 2);
            const char* a1 = cA + (size_t)(t + 1) * kstep;
            const char* a2 = last ? nA : cA + (size_t)(t + 2) * kstep; const char* b2 = last ? nB : cB + (size_t)(t + 2) * kstep;
            const char* a3 = a2 + kstep; const char* b3 = b2 + kstep;
            unsigned vo2[2][2];
            if constexpr (Sched::GATHER) {
                if (last) {
#pragma unroll
                    for (int h = 0; h < 2; ++h)
#pragma unroll
                        for (int i = 0; i < 2; ++i) nvo[h][i] = (unsigned)gi[h][i] * lda2 + C2[i];
                }
#pragma unroll
                for (int h = 0; h < 2; ++h)
#pragma unroll
                    for (int i = 0; i < 2; ++i) vo2[h][i] = last ? nvo[h][i] : cvo[h][i];
            }
            PG8_LDB(B0, 0, 0); PG8_LDB(B1, 0, 1); PG8_SCHED; PG8_LDA(At, 0, 0); PG8_STAGE_A(PG8_SA(1, 1), a1, 1, cvo);
            PG8_WAIT_V(8); PG8_WAIT_L(0); PG8_BAR; PG8_MMA(0, 0, At, B0); PG8_MMA(0, 1, At, B1); PG8_BAR; PG8_SCHED;
            PG8_LDA(At, 0, 1); PG8_STAGE(PG8_SB(0, 0), b2, voffB); PG8_STAGE(PG8_SB(0, 1), b2 + hstepB, voffB); PG8_STAGE_A(PG8_SA(0, 0), a2, 0, vo2);
            PG8_WAIT_V(8); PG8_WAIT_L(0); PG8_BAR; PG8_MMA(1, 0, At, B0); PG8_MMA(1, 1, At, B1); PG8_BAR; PG8_SCHED;
            PG8_LDB(B0, 1, 0); PG8_LDB(B1, 1, 1); PG8_SCHED; PG8_LDA(At, 1, 0); PG8_STAGE_A(PG8_SA(0, 1), a2, 1, vo2);
            PG8_WAIT_V(8); PG8_WAIT_L(0); PG8_BAR; PG8_MMA(0, 0, At, B0); PG8_MMA(0, 1, At, B1); PG8_BAR; PG8_SCHED;
            PG8_LDA(At, 1, 1); PG8_STAGE(PG8_SB(1, 0), b3, voffB); PG8_STAGE(PG8_SB(1, 1), b3 + hstepB, voffB); PG8_STAGE_A(PG8_SA(1, 0), a3, 0, vo2);
            PG8_WAIT_V(8); PG8_WAIT_L(0); PG8_BAR; PG8_MMA(1, 0, At, B0); PG8_MMA(1, 1, At, B1); PG8_BAR; PG8_SCHED;
        }
        if (wr == 0) PG8_BAR;
        E(acc, cur, wr, wc, fr, fq);
        if (!has_next) break;
#pragma unroll
        for (int a = 0; a < 2; ++a)
#pragma unroll
            for (int b = 0; b < 2; ++b)
#pragma unroll
                for (int m = 0; m < 4; ++m)
#pragma unroll
                    for (int n = 0; n < 2; ++n) acc[a][b][m][n] = (f32x4){0.f, 0.f, 0.f, 0.f};
        cur = nxt; cA = nA; cB = nB; ++ui;
        if constexpr (Sched::GATHER) {
#pragma unroll
            for (int h = 0; h < 2; ++h)
#pragma unroll
                for (int i = 0; i < 2; ++i) cvo[h][i] = nvo[h][i];
        }
        if (wr == 1) PG8_BAR;
    }
    PG8_WAIT_V(0);
    PG8_BAR;
#undef PG8_SA
#undef PG8_SB
#undef PG8_STAGE
#undef PG8_STAGE_A
#undef PG8_LDA
#undef PG8_LDB
#undef PG8_MMA
#undef PG8_WAIT_V
#undef PG8_WAIT_L
#undef PG8_BAR
#undef PG8_SCHED
}
}
using gm::GUnit;
struct SchedIn {
    static constexpr bool GATHER = false;
    int nt; unsigned lda2, ldb2; const char* XN; const char* WT; const char* MEMN; const char* WMKV; int G, c;
    __device__ __forceinline__ bool next(int i, GUnit& u) const {
        int L = i * G + c; u.gidx = nullptr;
        if (L < 128 * 23) { int pm, pn; gm::tile_of(L, 128, 23, pm, pn); u.A = XN + (size_t)pm * 256 * 2048; u.B = WT + (size_t)pn * 256 * 2048; u.pm = pm; u.pn = pn; u.aux = 0; return true; }
        L -= 128 * 23;
        if (L < 8) { const int pm = L >> 1, pn = L & 1; u.A = MEMN + (size_t)pm * 256 * 2048; u.B = WMKV + (size_t)pn * 256 * 2048; u.pm = pm; u.pn = pn; u.aux = 1; return true; }
        return false;
    }
};
struct EpiIn {
    static constexpr bool PERM = true;
    bf16_t* P; bf16_t* Gt; bf16_t* MKV;
    __device__ __forceinline__ void operator()(const f32x4 (&acc)[2][2][4][2], const GUnit& u, int wr, int wc, int fr, int fq) const {
        const int row0 = u.pm * 256 + wr * 64 + fr;
        bf16_t* base; int ldc, colt; bool sig = false;
        if (u.aux == 1) { base = MKV; ldc = 512; colt = u.pn * 256; }
        else if (u.pn < 11) { base = P; ldc = PW; colt = u.pn * 256; }
        else { base = Gt; ldc = GWD; colt = (u.pn - 11) * 256; sig = true; }
        const int col0 = colt + wc * 32 + 8 * fq;
#pragma unroll
        for (int ai = 0; ai < 2; ++ai)
#pragma unroll
            for (int m = 0; m < 4; ++m) { bf16_t* rowp = base + (size_t)(row0 + ai * 128 + m * 16) * ldc + col0;
#pragma unroll
                for (int bj = 0; bj < 2; ++bj) { f32x4 v0 = acc[ai][bj][m][0], v1 = acc[ai][bj][m][1];
                    if (sig) {
#pragma unroll
                        for (int j = 0; j < 4; ++j) { v0[j] = sigmoidf_(v0[j]); v1[j] = sigmoidf_(v1[j]); } }
                    u32x4 w; w.x = cvtpk(v0[0], v0[1]); w.y = cvtpk(v0[2], v0[3]); w.z = cvtpk(v1[0], v1[1]); w.w = cvtpk(v1[2], v1[3]);
                    *(u32x4*)(rowp + bj * 128) = w; } }
    }
};
struct SchedMerge {
    static constexpr bool GATHER = false;
    int nt; unsigned lda2, ldb2; const char* Y; const char* WT; int G, c;
    __device__ __forceinline__ bool next(int i, GUnit& u) const {
        const int L = i * G + c; u.gidx = nullptr; if (L >= 512) return false;
        int pm, pn; gm::tile_of(L, 128, 4, pm, pn); u.A = Y + (size_t)pm * 256 * lda2; u.B = WT + (size_t)pn * 256 * ldb2; u.pm = pm; u.pn = pn; u.aux = 0; return true;
    }
};
struct EpiMerge {
    static constexpr bool PERM = true;
    const bf16_t* Gt; bf16_t* MG; int pass;
    __device__ __forceinline__ void operator()(const f32x4 (&acc)[2][2][4][2], const GUnit& u, int wr, int wc, int fr, int fq) const {
        const int row0 = u.pm * 256 + wr * 64 + fr, col0 = u.pn * 256 + wc * 32 + 8 * fq;
#pragma unroll
        for (int ai = 0; ai < 2; ++ai)
#pragma unroll
            for (int m = 0; m < 4; ++m) { const size_t row = (size_t)(row0 + ai * 128 + m * 16);
#pragma unroll
                for (int bj = 0; bj < 2; ++bj) {
                    const u32x4 g = *(const u32x4*)(Gt + row * GWD + pass * 1024 + col0 + bj * 128);
                    bf16_t* mp = MG + row * DM + col0 + bj * 128;
                    float o[8];
                    const f32x4 v0 = acc[ai][bj][m][0], v1 = acc[ai][bj][m][1];
                    o[0] = bflo(g.x) * v0[0]; o[1] = bfhi(g.x) * v0[1]; o[2] = bflo(g.y) * v0[2]; o[3] = bfhi(g.y) * v0[3];
                    o[4] = bflo(g.z) * v1[0]; o[5] = bfhi(g.z) * v1[1]; o[6] = bflo(g.w) * v1[2]; o[7] = bfhi(g.w) * v1[3];
                    if (pass > 0) { const u32x4 p = *(const u32x4*)mp;
                        o[0] += bflo(p.x); o[1] += bfhi(p.x); o[2] += bflo(p.y); o[3] += bfhi(p.y); o[4] += bflo(p.z); o[5] += bfhi(p.z); o[6] += bflo(p.w); o[7] += bfhi(p.w); }
                    u32x4 w; w.x = cvtpk(o[0], o[1]); w.y = cvtpk(o[2], o[3]); w.z = cvtpk(o[4], o[5]); w.w = cvtpk(o[6], o[7]);
                    *(u32x4*)mp = w; } }
    }
};
struct SchedOut {
    static constexpr bool GATHER = false;
    int nt; unsigned lda2, ldb2; const char* A; const char* WT; int G, c;
    __device__ __forceinline__ bool next(int i, GUnit& u) const {
        const int L = i * G + c; u.gidx = nullptr; if (L >= 512) return false;
        int pm, pn; gm::tile_of(L, 128, 4, pm, pn); u.A = A + (size_t)pm * 256 * lda2; u.B = WT + (size_t)pn * 256 * ldb2; u.pm = pm; u.pn = pn; u.aux = 0; return true;
    }
};
struct EpiOut {
    static constexpr bool PERM = false;
    const float* X; float* O;
    __device__ __forceinline__ void operator()(const f32x4 (&acc)[2][2][4][2], const GUnit& u, int wr, int wc, int fr, int fq) const {
        const int row0 = u.pm * 256 + wr * 64 + fr, col0 = u.pn * 256 + wc * 32 + 4 * fq;
#pragma unroll
        for (int ai = 0; ai < 2; ++ai)
#pragma unroll
            for (int m = 0; m < 4; ++m) { const size_t off = (size_t)(row0 + ai * 128 + m * 16) * DM + col0;
#pragma unroll
                for (int bj = 0; bj < 2; ++bj)
#pragma unroll
                    for (int n = 0; n < 2; ++n) { const f32x4 xv = *(const f32x4*)(X + off + bj * 128 + n * 16); *(f32x4*)(O + off + bj * 128 + n * 16) = xv + acc[ai][bj][m][n]; } }
    }
};
struct SchedMoe1 {
    static constexpr bool GATHER = true;
    int nt; unsigned lda2, ldb2; const char* XN2; const char* WGU; const int* TIDX; int G, c;
    __device__ __forceinline__ bool next(int i, GUnit& u) const {
        const int L = i * G + c; if (L >= NE * 256) return false;
        const int e = L >> 8; int pm, pn; gm::tile_of(L & 255, 16, 16, pm, pn);
        u.A = XN2; u.gidx = TIDX + e * 4096 + pm * 256; u.B = WGU + ((size_t)e * 4096 + (size_t)pn * 256) * 2048; u.pm = e * 16 + pm; u.pn = pn; u.aux = 0; return true;
    }
};
struct EpiMoe1 {
    static constexpr bool PERM = true;
    bf16_t* ACT;
    __device__ __forceinline__ void operator()(const f32x4 (&acc)[2][2][4][2], const GUnit& u, int wr, int wc, int fr, int fq) const {
        const int row0 = u.pm * 256 + wr * 64 + fr, col0 = u.pn * 128 + wc * 32 + 8 * fq;
#pragma unroll
        for (int ai = 0; ai < 2; ++ai)
#pragma unroll
            for (int m = 0; m < 4; ++m) { bf16_t* rowp = ACT + (size_t)(row0 + ai * 128 + m * 16) * FF + col0;
                float o[8];
#pragma unroll
                for (int n = 0; n < 2; ++n)
#pragma unroll
                    for (int j = 0; j < 4; ++j) { const float g = acc[ai][0][m][n][j], up = acc[ai][1][m][n][j]; o[n * 4 + j] = g * sigmoidf_(g) * up; }
                u32x4 w; w.x = cvtpk(o[0], o[1]); w.y = cvtpk(o[2], o[3]); w.z = cvtpk(o[4], o[5]); w.w = cvtpk(o[6], o[7]);
                *(u32x4*)rowp = w; }
    }
};
struct SchedMoe2 {
    static constexpr bool GATHER = false;
    int nt; unsigned lda2, ldb2; const char* ACT; const char* WD; int G, c;
    __device__ __forceinline__ bool next(int i, GUnit& u) const {
        const int L = i * G + c; u.gidx = nullptr; if (L >= NE * 64) return false;
        const int e = L >> 6; int pm, pn; gm::tile_of(L & 63, 16, 4, pm, pn);
        u.A = ACT + ((size_t)e * 4096 + (size_t)pm * 256) * 4096; u.B = WD + ((size_t)e * 1024 + (size_t)pn * 256) * 4096; u.pm = e * 16 + pm; u.pn = pn; u.aux = 0; return true;
    }
};
struct EpiMoe2 {
    static constexpr bool PERM = true;
    bf16_t* YE; const float* TVAL;
    __device__ __forceinline__ void operator()(const f32x4 (&acc)[2][2][4][2], const GUnit& u, int wr, int wc, int fr, int fq) const {
        const int row0 = u.pm * 256 + wr * 64 + fr, col0 = u.pn * 256 + wc * 32 + 8 * fq;
#pragma unroll
        for (int ai = 0; ai < 2; ++ai)
#pragma unroll
            for (int m = 0; m < 4; ++m) { const int row = row0 + ai * 128 + m * 16; const float tv = TVAL[row]; bf16_t* rowp = YE + (size_t)row * DM + col0;
#pragma unroll
                for (int bj = 0; bj < 2; ++bj) { const f32x4 v0 = acc[ai][bj][m][0] * tv, v1 = acc[ai][bj][m][1] * tv;
                    u32x4 w; w.x = cvtpk(v0[0], v0[1]); w.y = cvtpk(v0[2], v0[3]); w.z = cvtpk(v1[0], v1[1]); w.w = cvtpk(v1[2], v1[3]);
                    *(u32x4*)(rowp + bj * 128) = w; } }
    }
};
constexpr int NWAVES = 8, NTHR = 512;
constexpr int LDS_BYTES = 147456;
struct Args { const float* in[30]; float* out; unsigned char* ws; int ph_lo, ph_hi; };
enum { I_X = 0, I_MEM, I_NMIXG, I_NMEMG, I_WIN, I_RPB, I_MURKV, I_MUW, I_MUA, I_W0, I_W2, I_A0, I_A2, I_KK, I_KA, I_RK, I_G2, I_LNG, I_LNB, I_WMKV, I_WBNA, I_WBRW, I_WBMEM, I_WOUT,
       I_NFFNG, I_WROUTER, I_WEG, I_WEU, I_WED, I_NFING };

__device__ __forceinline__ void transpose_item(const float* __restrict__ W, int N, bf16_t* __restrict__ WT, int ldw, int drow0, int k0, int n0, LAS float* scr, int lane) {
#pragma unroll 8
    for (int i = 0; i < 32; ++i) { const int kk = 2 * i + (lane >> 5); scr[kk * 33 + (lane & 31)] = W[(size_t)(k0 + kk) * N + n0 + (lane & 31)]; }
    LDS_WAIT(); asm volatile("" ::: "memory");
    const int c = lane & 7;
#pragma unroll
    for (int j = 0; j < 4; ++j) { const int n = (lane >> 3) + 8 * j; const LAS float* s = scr + (8 * c) * 33 + n;
        u32x4 o; o.x = cvtpk(s[0 * 33], s[1 * 33]); o.y = cvtpk(s[2 * 33], s[3 * 33]); o.z = cvtpk(s[4 * 33], s[5 * 33]); o.w = cvtpk(s[6 * 33], s[7 * 33]);
        *(u32x4*)(WT + (size_t)(drow0 + n) * ldw + k0 + 8 * c) = o; }
    LDS_WAIT(); asm volatile("" ::: "memory");
}
__device__ __forceinline__ bool tr_matrix(int& it, const float* W, int K, int N, bf16_t* WT, LAS float* scr, int lane) {
    const int nblk = N / 32, items = (K / 64) * nblk;
    if (it < items) { const int kb = it / nblk, nb = it % nblk; transpose_item(W, N, WT, K, 32 * nb, 64 * kb, 32 * nb, scr, lane); return true; }
    it -= items; return false;
}
__device__ __forceinline__ void rms_row_to_bf16(const float* __restrict__ xrow, const float* __restrict__ g, bf16_t* __restrict__ orow, int lane) {
    const f32x4* xr = (const f32x4*)xrow + lane; const f32x4* gr = (const f32x4*)g + lane;
    f32x4 v[4]; float s = 0.f;
#pragma unroll
    for (int j = 0; j < 4; ++j) { v[j] = xr[64 * j]; s += (v[j].x * v[j].x + v[j].y * v[j].y) + (v[j].z * v[j].z + v[j].w * v[j].w); }
    const float rstd = 1.f / sqrtf(wave_sum(s) * (1.f / DM) + RMS_EPS);
    unsigned long long* o8 = (unsigned long long*)orow + lane;
#pragma unroll
    for (int j = 0; j < 4; ++j) { const f32x4 gg = gr[64 * j];
        o8[64 * j] = (unsigned long long)cvtpk(v[j].x * rstd * gg.x, v[j].y * rstd * gg.y) | ((unsigned long long)cvtpk(v[j].z * rstd * gg.z, v[j].w * rstd * gg.w) << 32); }
}
__device__ __forceinline__ void phase_prologue(const Args& a, LAS unsigned char* lds, int wave, int lane) {
    unsigned char* ws = a.ws;
    LAS float* scr = (LAS float*)(lds + wave * 16384);
    const int gw = blockIdx.x * NWAVES + wave, NGW = gridDim.x * NWAVES;
    constexpr int NITEMS = 16 * 184 + 192 + 192 + 128 + 512 + 256 + 12 * 4 + 24;
    for (int it0 = gw; it0 < NITEMS; it0 += NGW) {
        int it = it0;
        if (tr_matrix(it, a.in[I_WIN], DM, DIN, (bf16_t*)(ws + WS_WIN), scr, lane)) continue;
        if (tr_matrix(it, a.in[I_WBNA], NAW, DM, (bf16_t*)(ws + WS_WBR), scr, lane)) continue;
        if (tr_matrix(it, a.in[I_WBRW], RWW, DM, (bf16_t*)(ws + WS_WBR) + 1024 * 384, scr, lane)) continue;
        if (tr_matrix(it, a.in[I_WBMEM], MEMW, DM, (bf16_t*)(ws + WS_WBR) + 2 * 1024 * 384, scr, lane)) continue;
        if (tr_matrix(it, a.in[I_WOUT], DM, DM, (bf16_t*)(ws + WS_WOUT), scr, lane)) continue;
        if (tr_matrix(it, a.in[I_WMKV], DM, 512, (bf16_t*)(ws + WS_WMKV), scr, lane)) continue;
        if (tr_matrix(it, a.in[I_W2], 64, 384, (bf16_t*)(ws + WS_W2T), scr, lane)) continue;
        if (tr_matrix(it, a.in[I_W2] + 64 * 384, 64, 384, (bf16_t*)(ws + WS_W2T) + 384 * 64, scr, lane)) continue;
        if (tr_matrix(it, a.in[I_A2], 64, 384, (bf16_t*)(ws + WS_A2T), scr, lane)) continue;
        if (tr_matrix(it, a.in[I_A2] + 64 * 384, 64, 384, (bf16_t*)(ws + WS_A2T) + 384 * 64, scr, lane)) continue;
        tr_matrix(it, a.in[I_G2], 128, 384, (bf16_t*)(ws + WS_G2T), scr, lane);
    }
    for (int m = gw; m < T; m += NGW) rms_row_to_bf16(a.in[I_X] + (size_t)m * DM, a.in[I_NMIXG], (bf16_t*)(ws + WS_XN) + (size_t)m * DM, lane);
    for (int m = gw; m < NB * NMEM; m += NGW) rms_row_to_bf16(a.in[I_MEM] + (size_t)m * DM, a.in[I_NMEMG], (bf16_t*)(ws + WS_MEMN) + (size_t)m * DM, lane);
}

template <int CTRL> __device__ __forceinline__ float dppf(float v) { return __int_as_float(__builtin_amdgcn_update_dpp(0, __float_as_int(v), CTRL, 0xf, 0xf, true)); }
__device__ __forceinline__ float sum8(float v) { v += dppf<0xB1>(v); v += dppf<0x4E>(v); v += dppf<0x141>(v); return v; }
__device__ __forceinline__ float dot8(const float (&q)[8], const u32x4 t4) {
    return q[0] * bflo(t4.x) + q[1] * bfhi(t4.x) + q[2] * bflo(t4.y) + q[3] * bfhi(t4.y) + q[4] * bflo(t4.z) + q[5] * bfhi(t4.z) + q[6] * bflo(t4.w) + q[7] * bfhi(t4.w);
}
__device__ __forceinline__ void axpy8(float (&o)[8], float p, const u32x4 t4) {
    o[0] += p * bflo(t4.x); o[1] += p * bfhi(t4.x); o[2] += p * bflo(t4.y); o[3] += p * bfhi(t4.y); o[4] += p * bflo(t4.z); o[5] += p * bfhi(t4.z); o[6] += p * bflo(t4.w); o[7] += p * bfhi(t4.w);
}
__device__ __forceinline__ void na_unit(const Args& a, LAS unsigned char* lds, int unit, int tid) {
    const int h = unit % NAH, r = (unit / NAH) % GROWS, b = unit / (NAH * GROWS);
    const bf16_t* P = (const bf16_t*)(a.ws + WS_P);
    const int rs = min(max(r - 4, 0), GROWS - 8);
    LAS unsigned char* Ks = lds; LAS unsigned char* Vs = lds + 65536; LAS float* RPB = (LAS float*)(lds + 131072);
    const int w = tid >> 3, sub = tid & 7;
    {
#pragma unroll
        for (int p = 0; p < 8; ++p) { const int key = w + 64 * p; const size_t tok = (size_t)b * SEQ + (size_t)(rs + (key >> 6)) * GRIDW + (key & 63);
            *(LAS u32x4*)(Ks + key * 128 + sub * 16) = *(const u32x4*)(P + tok * PW + C_NAK + h * 64 + sub * 8);
            *(LAS u32x4*)(Vs + key * 128 + sub * 16) = *(const u32x4*)(P + tok * PW + C_NAV + h * 64 + sub * 8); }
        if (tid < 15 * 31) RPB[tid] = a.in[I_RPB][h * 15 * 31 + tid];
    }
    float q[8];
    {   const size_t tok = (size_t)b * SEQ + (size_t)r * GRIDW + w; float t8[8]; unpack8(*(const u32x4*)(P + tok * PW + C_NAQ + h * 64 + sub * 8), t8);
#pragma unroll
        for (int j = 0; j < 8; ++j) q[j] = t8[j] * 0.125f; }
    __syncthreads();
    const int cs = min(max(w - 8, 0), GRIDW - 16);
    float o[8];
#pragma unroll
    for (int d = 0; d < 8; ++d) o[d] = 0.f;
    float mx = -1e30f, l = 0.f;
#pragma unroll 1
    for (int i = 0; i < 8; ++i) {
        const LAS float* bp = RPB + (rs + i - r + 7) * 31 + (cs - w + 15);
#pragma unroll 1
        for (int j0 = 0; j0 < 16; j0 += 4) {
            float s[4];
#pragma unroll
            for (int j = 0; j < 4; ++j) { const int key = i * 64 + cs + j0 + j; s[j] = sum8(dot8(q, *(const LAS u32x4*)(Ks + key * 128 + sub * 16))) + bp[j0 + j]; }
            const float mn = fmaxf(fmaxf(mx, fmaxf(s[0], s[1])), fmaxf(s[2], s[3])), sc = __expf(mx - mn);
            l *= sc; mx = mn;
#pragma unroll
            for (int d = 0; d < 8; ++d) o[d] *= sc;
#pragma unroll
            for (int j = 0; j < 4; ++j) { const int key = i * 64 + cs + j0 + j; const float p = __expf(s[j] - mn); l += p; axpy8(o, p, *(const LAS u32x4*)(Vs + key * 128 + sub * 16)); }
        }
    }
    {   const float il = 1.f / l; const size_t tok = (size_t)b * SEQ + (size_t)r * GRIDW + w;
#pragma unroll
        for (int d = 0; d < 8; ++d) o[d] *= il;
        *(u32x4*)((bf16_t*)(a.ws + WS_YNA) + tok * NAW + h * 64 + sub * 8) = pack8(o); }
    __syncthreads();
}
__device__ __forceinline__ void mem_unit(const Args& a, LAS unsigned char* lds, int unit, int tid) {
    const int qb = unit & 15, mh = (unit >> 4) & 3, b = unit >> 6;
    const bf16_t* MKV = (const bf16_t*)(a.ws + WS_MKV); const bf16_t* P = (const bf16_t*)(a.ws + WS_P);
    LAS unsigned char* Ks = lds; LAS unsigned char* Vs = lds + 32768;
    const int w = tid >> 3, sub = tid & 7;
#pragma unroll
    for (int p = 0; p < 4; ++p) { const int key = w + 64 * p; const bf16_t* src = MKV + (size_t)(b * NMEM + key) * 512 + mh * 64 + sub * 8;
        *(LAS u32x4*)(Ks + key * 128 + sub * 16) = *(const u32x4*)src; *(LAS u32x4*)(Vs + key * 128 + sub * 16) = *(const u32x4*)(src + 256); }
    __syncthreads();
#pragma unroll 1
    for (int pass = 0; pass < 8; ++pass) {
        const size_t tok = (size_t)b * SEQ + (size_t)qb * 512 + pass * 64 + w;
        float q[8], o[8];
        {   float t8[8]; unpack8(*(const u32x4*)(P + tok * PW + C_MQ + mh * 64 + sub * 8), t8);
#pragma unroll
            for (int j = 0; j < 8; ++j) { q[j] = t8[j] * 0.125f; o[j] = 0.f; } }
        float mx = -1e30f, l = 0.f;
#pragma unroll 1
        for (int k0 = 0; k0 < NMEM; k0 += 4) {
            float s[4];
#pragma unroll
            for (int j = 0; j < 4; ++j) s[j] = sum8(dot8(q, *(const LAS u32x4*)(Ks + (k0 + j) * 128 + sub * 16)));
            const float mn = fmaxf(fmaxf(mx, fmaxf(s[0], s[1])), fmaxf(s[2], s[3])), sc = __expf(mx - mn);
            l *= sc; mx = mn;
#pragma unroll
            for (int d = 0; d < 8; ++d) o[d] *= sc;
#pragma unroll
            for (int j = 0; j < 4; ++j) { const float p = __expf(s[j] - mn); l += p; axpy8(o, p, *(const LAS u32x4*)(Vs + (k0 + j) * 128 + sub * 16)); }
        }
        const float il = 1.f / l;
#pragma unroll
        for (int d = 0; d < 8; ++d) o[d] *= il;
        *(u32x4*)((bf16_t*)(a.ws + WS_YMEM) + tok * MEMW + mh * 64 + sub * 8) = pack8(o);
    }
    __syncthreads();
}

__device__ __forceinline__ void phase_norm_router(const Args& a, LAS unsigned char* lds, int wave, int lane) {
    const int gw = blockIdx.x * NWAVES + wave, NGW = gridDim.x * NWAVES;
    const float* x1 = a.out; const float* g = a.in[I_NFFNG]; const LAS float* wr = (const LAS float*)lds;
    bf16_t* XN2 = (bf16_t*)(a.ws + WS_XN); float* AFF = (float*)(a.ws + WS_AFF);
    for (int m = gw; m < T; m += NGW) {
        const f32x4* xr = (const f32x4*)(x1 + (size_t)m * DM) + lane; const f32x4* gr = (const f32x4*)g + lane;
        f32x4 v[4]; float s = 0.f;
#pragma unroll
        for (int j = 0; j < 4; ++j) { v[j] = xr[64 * j]; s += (v[j].x * v[j].x + v[j].y * v[j].y) + (v[j].z * v[j].z + v[j].w * v[j].w); }
        const float rstd = 1.f / sqrtf(wave_sum(s) * (1.f / DM) + RMS_EPS);
        unsigned long long* o8 = (unsigned long long*)(XN2 + (size_t)m * DM) + lane;
        float lg[16];
#pragma unroll
        for (int e = 0; e < 16; ++e) lg[e] = 0.f;
#pragma unroll 1
        for (int j = 0; j < 4; ++j) { const f32x4 gg = gr[64 * j]; f32x4 hh; hh.x = v[j].x * rstd * gg.x; hh.y = v[j].y * rstd * gg.y; hh.z = v[j].z * rstd * gg.z; hh.w = v[j].w * rstd * gg.w;
            o8[64 * j] = (unsigned long long)cvtpk(hh.x, hh.y) | ((unsigned long long)cvtpk(hh.z, hh.w) << 32);
            const int d0 = 4 * (64 * j + lane);
#pragma unroll
            for (int dd = 0; dd < 4; ++dd) { const LAS f32x4* wp = (const LAS f32x4*)(wr + (d0 + dd) * NE); const float hv = hh[dd];
#pragma unroll
                for (int e4 = 0; e4 < 4; ++e4) { const f32x4 wv = wp[e4]; lg[e4 * 4] += hv * wv.x; lg[e4 * 4 + 1] += hv * wv.y; lg[e4 * 4 + 2] += hv * wv.z; lg[e4 * 4 + 3] += hv * wv.w; } } }
#pragma unroll
        for (int e = 0; e < 16; ++e) lg[e] = wave_sum(lg[e]);
        float mxv = lg[0];
#pragma unroll
        for (int e = 1; e < 16; ++e) mxv = fmaxf(mxv, lg[e]);
        float se = 0.f;
#pragma unroll
        for (int e = 0; e < 16; ++e) { lg[e] = expf(lg[e] - mxv); se += lg[e]; }
        const float inv = 1.f / se;
        if (lane < 4) { f32x4 ov;
            if (lane == 0) ov = (f32x4){lg[0], lg[1], lg[2], lg[3]}; else if (lane == 1) ov = (f32x4){lg[4], lg[5], lg[6], lg[7]};
            else if (lane == 2) ov = (f32x4){lg[8], lg[9], lg[10], lg[11]}; else ov = (f32x4){lg[12], lg[13], lg[14], lg[15]};
            *(f32x4*)(AFF + (size_t)m * NE + lane * 4) = ov * inv; }
    }
}

__device__ __forceinline__ unsigned block_sum_u32(unsigned v, LAS unsigned* red, int tid) {
    unsigned s = v;
#pragma unroll
    for (int o = 1; o < 64; o <<= 1) s += __shfl_xor(s, o);
    if ((tid & 63) == 0) red[tid >> 6] = s;
    __syncthreads();
    unsigned t = 0;
#pragma unroll
    for (int w = 0; w < 8; ++w) t += red[w];
    __syncthreads();
    return t;
}
__device__ __forceinline__ unsigned block_excl_scan(unsigned v, LAS unsigned* red, int tid) {
    const int lane = tid & 63, wv = tid >> 6;
    unsigned inc = v;
#pragma unroll
    for (int o = 1; o < 64; o <<= 1) { const unsigned n = __shfl_up(inc, o); if (lane >= o) inc += n; }
    if (lane == 63) red[wv] = inc;
    __syncthreads();
    unsigned base = 0;
#pragma unroll
    for (int w = 0; w < 8; ++w) if (w < wv) base += red[w];
    __syncthreads();
    return base + inc - v;
}
__device__ __forceinline__ void topk_unit(const Args& a, LAS unsigned char* lds, int unit, int tid) {
    const int e = unit & 15, b = unit >> 4;
    const float* AFF = (const float*)(a.ws + WS_AFF);
    int* TIDX = (int*)(a.ws + WS_TIDX); float* TVAL = (float*)(a.ws + WS_TVAL); int* SLOT = (int*)(a.ws + WS_SLOT);
    LAS unsigned* red = (LAS unsigned*)lds;
    unsigned key[16];
#pragma unroll
    for (int j = 0; j < 16; ++j) key[j] = __float_as_uint(AFF[((size_t)b * SEQ + tid * 16 + j) * NE + e]);
    unsigned prefix = 0;
    for (int bit = 30; bit >= 0; --bit) {
        const unsigned cand = prefix | (1u << bit); unsigned c = 0;
#pragma unroll
        for (int j = 0; j < 16; ++j) c += (key[j] >= cand) ? 1u : 0u;
        const unsigned tot = block_sum_u32(c, red, tid);
        if (tot >= (unsigned)CAP) prefix = cand;
    }
    unsigned cg_ = 0, ce = 0;
#pragma unroll
    for (int j = 0; j < 16; ++j) { cg_ += (key[j] > prefix) ? 1u : 0u; ce += (key[j] == prefix) ? 1u : 0u; }
    const unsigned ngt = block_sum_u32(cg_, red, tid);
    const unsigned need = (unsigned)CAP - ngt;
    unsigned erank = block_excl_scan(ce, red, tid);
    unsigned sel = 0, nsel = 0;
#pragma unroll
    for (int j = 0; j < 16; ++j) { bool s = key[j] > prefix; if (key[j] == prefix) { s = erank < need; ++erank; } if (s) { sel |= 1u << j; ++nsel; } }
    unsigned pos = block_excl_scan(nsel, red, tid);
#pragma unroll
    for (int j = 0; j < 16; ++j) { const int tok = b * SEQ + tid * 16 + j; int slot = -1;
        if (sel & (1u << j)) { slot = e * 4096 + b * 1024 + (int)pos; ++pos; TIDX[slot] = tok; TVAL[slot] = __uint_as_float(key[j]); }
        SLOT[(size_t)tok * NE + e] = slot; }
}

__device__ __forceinline__ void expert_convert(const Args& a, LAS unsigned char* lds, int wave, int lane, int gw, int NGW) {
    LAS float* scr = (LAS float*)(lds + 4096 + wave * 16384);
    bf16_t* WGU = (bf16_t*)(a.ws + WS_WGU); bf16_t* WD = (bf16_t*)(a.ws + WS_WD);
    constexpr int PER_E = 3072, NIT = NE * PER_E;
    for (int it0 = gw; it0 < NIT; it0 += NGW) {
        const int e = it0 / PER_E; int it = it0 % PER_E;
        if (it < 2048) { const int up = it >> 10; it &= 1023; const int kb = it >> 6, nb = it & 63, n0 = 32 * nb;
            const float* W = a.in[up ? I_WEU : I_WEG] + (size_t)e * DM * FF;
            transpose_item(W, FF, WGU + (size_t)e * 4096 * 1024, 1024, 256 * (n0 >> 7) + (up ? 128 : 0) + (n0 & 127), 64 * kb, n0, scr, lane); }
        else { it -= 2048; const int kb = it >> 5, nb = it & 31;
            transpose_item(a.in[I_WED] + (size_t)e * FF * DM, DM, WD + (size_t)e * 1024 * 2048, 2048, 32 * nb, 64 * kb, 32 * nb, scr, lane); }
    }
}

__device__ __forceinline__ void phase_final(const Args& a, int wave, int lane) {
    const int gw = blockIdx.x * NWAVES + wave, NGW = gridDim.x * NWAVES;
    float* x1 = a.out; const float* g = a.in[I_NFING]; const int* SLOT = (const int*)(a.ws + WS_SLOT); const bf16_t* YE = (const bf16_t*)(a.ws + WS_YE);
    for (int m = gw; m < T; m += NGW) {
        f32x4* xr = (f32x4*)(x1 + (size_t)m * DM) + lane; const f32x4* gr = (const f32x4*)g + lane;
        f32x4 v[4];
#pragma unroll
        for (int j = 0; j < 4; ++j) v[j] = xr[64 * j];
        const int myslot = (lane < NE) ? SLOT[(size_t)m * NE + lane] : -1;
        for (int e = 0; e < NE; ++e) { const int sl = __shfl(myslot, e);
            if (sl >= 0) { const u32x2* yp = (const u32x2*)(YE + (size_t)sl * DM) + lane;
#pragma unroll
                for (int j = 0; j < 4; ++j) { const u32x2 y2 = yp[64 * j]; v[j].x += bflo(y2.x); v[j].y += bfhi(y2.x); v[j].z += bflo(y2.y); v[j].w += bfhi(y2.y); } } }
        float s = 0.f;
#pragma unroll
        for (int j = 0; j < 4; ++j) s += (v[j].x * v[j].x + v[j].y * v[j].y) + (v[j].z * v[j].z + v[j].w * v[j].w);
        const float rstd = 1.f / sqrtf(wave_sum(s) * (1.f / DM) + RMS_EPS);
#pragma unroll
        for (int j = 0; j < 4; ++j) { const f32x4 gg = gr[64 * j]; xr[64 * j] = v[j] * rstd * gg; }
    }
}
constexpr int LP = 72;
constexpr int RB = 64 * LP * 2;
#define RWBUF(n) ((LAS bf16_t*)(lds + (n) * RB))

__device__ __forceinline__ void mm64(const LAS bf16_t* A, const LAS bf16_t* Bt, f32x4 (&acc)[2], int wid, int fr, int fq) {
    const int rt = wid >> 1, ct0 = 2 * (wid & 1);
#pragma unroll
    for (int s = 0; s < 2; ++s) {
        const bf16x8 af = *(const LAS bf16x8*)(A + (16 * rt + fr) * LP + 32 * s + 8 * fq);
#pragma unroll
        for (int c = 0; c < 2; ++c) { const bf16x8 bfrag = *(const LAS bf16x8*)(Bt + (16 * (ct0 + c) + fr) * LP + 32 * s + 8 * fq);
            acc[c] = __builtin_amdgcn_mfma_f32_16x16x32_bf16(af, bfrag, acc[c], 0, 0, 0); }
    }
}
__device__ __forceinline__ void zero2(f32x4 (&acc)[2]) { acc[0] = (f32x4){0.f, 0.f, 0.f, 0.f}; acc[1] = acc[0]; }
template <int MASK> __device__ __forceinline__ void mask2(f32x4 (&acc)[2], int wid, int fr, int fq) {
    if (MASK == 0) return;
    const int rt = wid >> 1, ct0 = 2 * (wid & 1);
#pragma unroll
    for (int c = 0; c < 2; ++c)
#pragma unroll
        for (int g = 0; g < 4; ++g) { const int row = 16 * rt + 4 * fq + g, col = 16 * (ct0 + c) + fr; const bool keep = (MASK == 1) ? (row > col) : (row >= col); if (!keep) acc[c][g] = 0.f; }
}
__device__ __forceinline__ void store_rm(LAS bf16_t* D, const f32x4 (&acc)[2], int wid, int fr, int fq) {
    const int rt = wid >> 1, ct0 = 2 * (wid & 1);
#pragma unroll
    for (int c = 0; c < 2; ++c)
#pragma unroll
        for (int g = 0; g < 4; ++g) D[(16 * rt + 4 * fq + g) * LP + 16 * (ct0 + c) + fr] = f2bf(acc[c][g]);
}
__device__ __forceinline__ void store_tr(LAS bf16_t* D, const f32x4 (&acc)[2], int wid, int fr, int fq) {
    const int rt = wid >> 1, ct0 = 2 * (wid & 1);
#pragma unroll
    for (int c = 0; c < 2; ++c) { u32x2 w; w.x = cvtpk(acc[c][0], acc[c][1]); w.y = cvtpk(acc[c][2], acc[c][3]); *(LAS u32x2*)(D + (16 * (ct0 + c) + fr) * LP + 16 * rt + 4 * fq) = w; }
}
__device__ __forceinline__ int afrag_index(int row, int k) {
    const int tile = row >> 4, fr = row & 15, s = k >> 5, j = 4 * ((k >> 4) & 1) + (k & 3), fq = (k >> 2) & 3;
    return ((tile * 2 + s) * 64 + fq * 16 + fr) * 8 + j;
}
__device__ __forceinline__ int nfrag_index(int v, int k) { const int vg = v >> 4, fr = v & 15, kt = k >> 4, fq = (k >> 2) & 3, reg = k & 3; return ((vg * 64 + fq * 16 + fr) * 16) + kt * 4 + reg; }

__device__ __forceinline__ int scan_tok(int d, int c, int i) { const int p = 64 * c + i; return d ? (SEQ - 1 - p) : p; }

__device__ __forceinline__ void rwkv_chunk_unit(const Args& a, LAS unsigned char* lds, int unit, int tid) {
    const int c = unit & 127, h = (unit >> 7) % RWH, db = unit / (128 * RWH), b = db & 3, d = db >> 2;
    const int wid = __builtin_amdgcn_readfirstlane(tid >> 6), lane = tid & 63, fr = lane & 15, fq = lane >> 4;
    const int i = tid >> 3, jq = tid & 7, ch0 = h * 64 + jq * 8;
    const bf16_t* P = (const bf16_t*)(a.ws + WS_P);
    const int s_cur = scan_tok(d, c, i); const bool has_prev = !(c == 0 && i == 0); const int s_prev = d ? s_cur + 1 : s_cur - 1;
    const size_t tok = (size_t)b * SEQ + s_cur, tokp = (size_t)b * SEQ + (has_prev ? s_prev : s_cur);
    LAS bf16_t *AT = RWBUF(0), *RT = RWBUF(1), *BT = RWBUF(2), *KT = RWBUF(3), *ATc = RWBUF(4), *VTc = RWBUF(5), *KHc = RWBUF(6), *BHc = RWBUF(7);
    LAS bf16_t *L0 = RWBUF(8), *L0T = RWBUF(9), *AAK = RWBUF(10), *ARB = RWBUF(11), *ARK = RWBUF(12), *T2 = RWBUF(13);
    LAS bf16_t *XTc = RWBUF(2), *L1 = RWBUF(3), *L1T = RWBUF(0), *T1 = RWBUF(10), *ABc = RWBUF(8), *UBc = RWBUF(9);
    LAS bf16_t *X1 = RWBUF(8), *X2 = RWBUF(9), *W2s = RWBUF(10), *A2s = RWBUF(11);
    LAS float *WPf = (LAS float*)(lds + 12 * RB), *APf = (LAS float*)(lds + 0 * RB), *Ef = (LAS float*)(lds + 2 * RB), *TOT = (LAS float*)(lds + 4 * RB);
    float pr[8], pk[8], pv[8], tmp[8], mu[8];
    {   float cur[8], prv[8];
        unpack8(*(const u32x4*)(P + tok * PW + C_LW + jq * 8), cur); unpack8(*(const u32x4*)(P + tokp * PW + C_LW + jq * 8), prv); ld8f(a.in[I_MUW] + d * 64 + jq * 8, mu);
#pragma unroll
        for (int j = 0; j < 8; ++j) { const float sh = has_prev ? prv[j] : 0.f; tmp[j] = tanhf(cur[j] + (sh - cur[j]) * mu[j]); }
        *(LAS u32x4*)(X1 + i * LP + jq * 8) = pack8(tmp);
        unpack8(*(const u32x4*)(P + tok * PW + C_LA + jq * 8), cur); unpack8(*(const u32x4*)(P + tokp * PW + C_LA + jq * 8), prv); ld8f(a.in[I_MUA] + d * 64 + jq * 8, mu);
#pragma unroll
        for (int j = 0; j < 8; ++j) { const float sh = has_prev ? prv[j] : 0.f; tmp[j] = cur[j] + (sh - cur[j]) * mu[j]; }
        *(LAS u32x4*)(X2 + i * LP + jq * 8) = pack8(tmp);
        *(LAS u32x4*)(W2s + i * LP + jq * 8) = *(const u32x4*)((const bf16_t*)(a.ws + WS_W2T) + ((size_t)d * 384 + h * 64 + i) * 64 + jq * 8);
        *(LAS u32x4*)(A2s + i * LP + jq * 8) = *(const u32x4*)((const bf16_t*)(a.ws + WS_A2T) + ((size_t)d * 384 + h * 64 + i) * 64 + jq * 8);
        unpack8(*(const u32x4*)(P + tok * PW + C_PR + ch0), cur); unpack8(*(const u32x4*)(P + tokp * PW + C_PR + ch0), prv); ld8f(a.in[I_MURKV] + (d * 3 + 0) * 384 + ch0, mu);
#pragma unroll
        for (int j = 0; j < 8; ++j) { const float sh = has_prev ? prv[j] : 0.f; pr[j] = cur[j] + (sh - cur[j]) * mu[j]; }
        unpack8(*(const u32x4*)(P + tok * PW + C_PK + ch0), cur); unpack8(*(const u32x4*)(P + tokp * PW + C_PK + ch0), prv); ld8f(a.in[I_MURKV] + (d * 3 + 1) * 384 + ch0, mu);
#pragma unroll
        for (int j = 0; j < 8; ++j) { const float sh = has_prev ? prv[j] : 0.f; pk[j] = cur[j] + (sh - cur[j]) * mu[j]; }
        unpack8(*(const u32x4*)(P + tok * PW + C_PV + ch0), cur); unpack8(*(const u32x4*)(P + tokp * PW + C_PV + ch0), prv); ld8f(a.in[I_MURKV] + (d * 3 + 2) * 384 + ch0, mu);
#pragma unroll
        for (int j = 0; j < 8; ++j) { const float sh = has_prev ? prv[j] : 0.f; pv[j] = cur[j] + (sh - cur[j]) * mu[j]; }
    }
    __syncthreads();
    {   f32x4 acc[2]; const int rt = wid >> 1, ct0 = 2 * (wid & 1);
        zero2(acc); mm64(X1, W2s, acc, wid, fr, fq);
#pragma unroll
        for (int cc = 0; cc < 2; ++cc)
#pragma unroll
            for (int g = 0; g < 4; ++g) WPf[(16 * rt + 4 * fq + g) * 64 + 16 * (ct0 + cc) + fr] = acc[cc][g];
        zero2(acc); mm64(X2, A2s, acc, wid, fr, fq);
#pragma unroll
        for (int cc = 0; cc < 2; ++cc)
#pragma unroll
            for (int g = 0; g < 4; ++g) APf[(16 * rt + 4 * fq + g) * 64 + 16 * (ct0 + cc) + fr] = acc[cc][g];
    }
    __syncthreads();
    float ev[8], ah[8], kk[8], kp[8];
    {   float w0[8], a0[8], kkw[8], kaw[8], wp[8], ap[8];
        ld8f(a.in[I_W0] + d * 384 + ch0, w0); ld8f(a.in[I_A0] + d * 384 + ch0, a0); ld8f(a.in[I_KK] + ch0, kkw); ld8f(a.in[I_KA] + ch0, kaw);
        { const f32x4 x0 = *(const LAS f32x4*)(WPf + i * 64 + jq * 8), x1 = *(const LAS f32x4*)(WPf + i * 64 + jq * 8 + 4); wp[0] = x0.x; wp[1] = x0.y; wp[2] = x0.z; wp[3] = x0.w; wp[4] = x1.x; wp[5] = x1.y; wp[6] = x1.z; wp[7] = x1.w; }
        { const f32x4 x0 = *(const LAS f32x4*)(APf + i * 64 + jq * 8), x1 = *(const LAS f32x4*)(APf + i * 64 + jq * 8 + 4); ap[0] = x0.x; ap[1] = x0.y; ap[2] = x0.z; ap[3] = x0.w; ap[4] = x1.x; ap[5] = x1.y; ap[6] = x1.z; ap[7] = x1.w; }
        float ss = 0.f;
#pragma unroll
        for (int j = 0; j < 8; ++j) {
            const float z = -(w0[j] + wp[j]);
            const float sp = (z > 20.f) ? z : log1pf(__expf(z));
            ev[j] = __expf(-sp - 0.5f);
            ah[j] = sigmoidf_(a0[j] + ap[j]);
            kk[j] = pk[j] * kkw[j]; ss += kk[j] * kk[j];
            kp[j] = pk[j] * (1.f + (ah[j] - 1.f) * kaw[j]);
        }
        ss += __shfl_xor(ss, 1); ss += __shfl_xor(ss, 2); ss += __shfl_xor(ss, 4);
        const float inv = 1.f / fmaxf(sqrtf(ss), 1e-12f);
#pragma unroll
        for (int j = 0; j < 8; ++j) kk[j] *= inv;
    }
    __syncthreads();
    *(LAS f32x4*)(Ef + i * 64 + jq * 8) = (f32x4){ev[0], ev[1], ev[2], ev[3]}; *(LAS f32x4*)(Ef + i * 64 + jq * 8 + 4) = (f32x4){ev[4], ev[5], ev[6], ev[7]};
    __syncthreads();
    {
        const int j = tid & 63, tq = tid >> 6; float run = 0.f;
#pragma unroll
        for (int s = 0; s < 8; ++s) { run += Ef[(tq * 8 + s) * 64 + j]; Ef[(tq * 8 + s) * 64 + j] = run; }
        TOT[tq * 64 + j] = run;
    }
    __syncthreads();
    float G[8], G63[8];
    {   const f32x4 x0 = *(const LAS f32x4*)(Ef + i * 64 + jq * 8), x1 = *(const LAS f32x4*)(Ef + i * 64 + jq * 8 + 4);
        G[0] = x0.x; G[1] = x0.y; G[2] = x0.z; G[3] = x0.w; G[4] = x1.x; G[5] = x1.y; G[6] = x1.z; G[7] = x1.w;
#pragma unroll
        for (int j = 0; j < 8; ++j) G63[j] = 0.f;
        const int tq = i >> 3;
#pragma unroll
        for (int q = 0; q < 8; ++q) { const f32x4 t0 = *(const LAS f32x4*)(TOT + q * 64 + jq * 8), t1 = *(const LAS f32x4*)(TOT + q * 64 + jq * 8 + 4);
            const float tt[8] = {t0.x, t0.y, t0.z, t0.w, t1.x, t1.y, t1.z, t1.w};
#pragma unroll
            for (int j = 0; j < 8; ++j) { G63[j] += tt[j]; if (q < tq) G[j] += tt[j]; } }
    }
    __syncthreads();
    {   float at[8], rt_[8], bt[8], kt[8], bh[8], kh[8];
#pragma unroll
        for (int j = 0; j < 8; ++j) {
            const float gi = __expf(-G[j]), gpi = __expf(-(G[j] - ev[j])), ig = __expf(G[j]), gc = __expf(-(G63[j] - G[j]));
            const float bb = kk[j] * ah[j];
            at[j] = -kk[j] * gpi; rt_[j] = pr[j] * gi; bt[j] = bb * ig; kt[j] = kp[j] * ig; bh[j] = bb * gc; kh[j] = kp[j] * gc;
        }
        *(LAS u32x4*)(AT + i * LP + jq * 8) = pack8(at); *(LAS u32x4*)(RT + i * LP + jq * 8) = pack8(rt_);
        *(LAS u32x4*)(BT + i * LP + jq * 8) = pack8(bt); *(LAS u32x4*)(KT + i * LP + jq * 8) = pack8(kt);
#pragma unroll
        for (int j = 0; j < 8; ++j) { const int cj = jq * 8 + j; ATc[cj * LP + i] = f2bf(at[j]); VTc[cj * LP + i] = f2bf(pv[j]); KHc[cj * LP + i] = f2bf(kh[j]); BHc[cj * LP + i] = f2bf(bh[j]); }
        if (i == 0) { float* RG = (float*)((unsigned char*)a.out + DO_RG) + (size_t)unit * 64 + jq * 8;
            *(f32x4*)RG = (f32x4){__expf(-G63[0]), __expf(-G63[1]), __expf(-G63[2]), __expf(-G63[3])}; *(f32x4*)(RG + 4) = (f32x4){__expf(-G63[4]), __expf(-G63[5]), __expf(-G63[6]), __expf(-G63[7])}; }
    }
    __syncthreads();
    f32x4 acc[2];
    zero2(acc); mm64(AT, BT, acc, wid, fr, fq); mask2<1>(acc, wid, fr, fq); store_rm(L0, acc, wid, fr, fq); store_tr(L0T, acc, wid, fr, fq);
    zero2(acc); mm64(AT, KT, acc, wid, fr, fq); mask2<1>(acc, wid, fr, fq); store_rm(AAK, acc, wid, fr, fq);
    zero2(acc); mm64(RT, BT, acc, wid, fr, fq); mask2<2>(acc, wid, fr, fq); store_rm(ARB, acc, wid, fr, fq);
    zero2(acc); mm64(RT, KT, acc, wid, fr, fq); mask2<2>(acc, wid, fr, fq); store_rm(ARK, acc, wid, fr, fq);
    __syncthreads();
    zero2(acc); mm64(AAK, VTc, acc, wid, fr, fq); store_tr(XTc, acc, wid, fr, fq);
    zero2(acc); mm64(L0, L0T, acc, wid, fr, fq); store_rm(L1, acc, wid, fr, fq); store_tr(L1T, acc, wid, fr, fq);
    __syncthreads();
    {   const int rt = wid >> 1, ct0 = 2 * (wid & 1);
#pragma unroll
        for (int cc = 0; cc < 2; ++cc)
#pragma unroll
            for (int g = 0; g < 4; ++g) { const int row = 16 * rt + 4 * fq + g, col = 16 * (ct0 + cc) + fr; const float v = bf2f(L0[row * LP + col]) + (row == col ? 1.f : 0.f); T1[row * LP + col] = f2bf(v); }
    }
    __syncthreads();
    {   LAS bf16_t *Lc = L1, *LcT = L1T, *Ln = L0, *LnT = L0T, *Tc = T1, *Tn = T2;
        const int rt = wid >> 1, ct0 = 2 * (wid & 1);
#pragma unroll 1
        for (int p = 1; p <= 5; ++p) {
#pragma unroll
            for (int cc = 0; cc < 2; ++cc)
#pragma unroll
                for (int g = 0; g < 4; ++g) acc[cc][g] = bf2f(Tc[(16 * rt + 4 * fq + g) * LP + 16 * (ct0 + cc) + fr]);
            mm64(Tc, LcT, acc, wid, fr, fq); store_rm(Tn, acc, wid, fr, fq);
            if (p < 5) { f32x4 a2[2]; zero2(a2); mm64(Lc, LcT, a2, wid, fr, fq); store_rm(Ln, a2, wid, fr, fq); store_tr(LnT, a2, wid, fr, fq); }
            __syncthreads();
            LAS bf16_t* t; t = Lc; Lc = Ln; Ln = t; t = LcT; LcT = LnT; LnT = t; t = Tc; Tc = Tn; Tn = t;
        }
    }
    LAS bf16_t* TF = T2;
    zero2(acc); mm64(TF, ATc, acc, wid, fr, fq); store_tr(ABc, acc, wid, fr, fq);
    zero2(acc); mm64(TF, XTc, acc, wid, fr, fq); store_tr(UBc, acc, wid, fr, fq);
    __syncthreads();
    {   const int rt = wid >> 1, ct0 = 2 * (wid & 1);
        bf16_t* RM = (bf16_t*)((unsigned char*)a.out + DO_RM) + (size_t)unit * 4096;
        zero2(acc); mm64(BHc, ABc, acc, wid, fr, fq);
#pragma unroll
        for (int cc = 0; cc < 2; ++cc)
#pragma unroll
            for (int g = 0; g < 4; ++g) RM[afrag_index(16 * rt + 4 * fq + g, 16 * (ct0 + cc) + fr)] = f2bf(acc[cc][g]);
        bf16_t* RN = (bf16_t*)(a.ws + WS_RN) + (size_t)unit * 4096;
        zero2(acc); mm64(VTc, KHc, acc, wid, fr, fq); mm64(UBc, BHc, acc, wid, fr, fq);
#pragma unroll
        for (int cc = 0; cc < 2; ++cc)
#pragma unroll
            for (int g = 0; g < 4; ++g) RN[nfrag_index(16 * rt + 4 * fq + g, 16 * (ct0 + cc) + fr)] = f2bf(acc[cc][g]);
        bf16_t* RR = (bf16_t*)((unsigned char*)a.out + DO_RR) + (size_t)unit * 4096;
#pragma unroll
        for (int cc = 0; cc < 2; ++cc)
#pragma unroll
            for (int g = 0; g < 4; ++g) acc[cc][g] = bf2f(RT[(16 * rt + 4 * fq + g) * LP + 16 * (ct0 + cc) + fr]);
        mm64(ARB, ABc, acc, wid, fr, fq);
#pragma unroll
        for (int cc = 0; cc < 2; ++cc)
#pragma unroll
            for (int g = 0; g < 4; ++g) RR[afrag_index(16 * rt + 4 * fq + g, 16 * (ct0 + cc) + fr)] = f2bf(acc[cc][g]);
        bf16_t* Y = (bf16_t*)(a.ws + (d ? WS_YB : WS_YRW));
        zero2(acc); mm64(ARB, UBc, acc, wid, fr, fq); mm64(ARK, VTc, acc, wid, fr, fq);
#pragma unroll
        for (int cc = 0; cc < 2; ++cc)
#pragma unroll
            for (int g = 0; g < 4; ++g) { const int ti = 16 * rt + 4 * fq + g, v = 16 * (ct0 + cc) + fr; Y[((size_t)b * SEQ + scan_tok(d, c, ti)) * RWW + h * 64 + v] = f2bf(acc[cc][g]); }
    }
    __syncthreads();
}

__device__ __forceinline__ void rwkv_state_pass(const Args& a, int task, int lane) {
    const int vg = task & 3, chain = task >> 2, h = chain % RWH, db = chain / RWH, b = db & 3, d = db >> 2;
    const int fr = lane & 15, fq = lane >> 4;
    const bf16_t* RM = (const bf16_t*)((const unsigned char*)a.out + DO_RM); const bf16_t* RR = (const bf16_t*)((const unsigned char*)a.out + DO_RR);
    const float* RG = (const float*)((const unsigned char*)a.out + DO_RG); const bf16_t* RN = (const bf16_t*)(a.ws + WS_RN);
    bf16_t* Y = (bf16_t*)(a.ws + (d ? WS_YB : WS_YRW));
    f32x4 S[4];
#pragma unroll
    for (int kt = 0; kt < 4; ++kt) S[kt] = (f32x4){0.f, 0.f, 0.f, 0.f};
#pragma unroll 1
    for (int c = 0; c < NCH; ++c) {
        const size_t unit = (size_t)chain * NCH + c;
        const bf16x8* mp = (const bf16x8*)(RM + unit * 4096) + lane; const bf16x8* rp = (const bf16x8*)(RR + unit * 4096) + lane;
        bf16x8 mf[4][2], rf[4][2];
#pragma unroll
        for (int t4 = 0; t4 < 4; ++t4)
#pragma unroll
            for (int s = 0; s < 2; ++s) { mf[t4][s] = mp[(t4 * 2 + s) * 64]; rf[t4][s] = rp[(t4 * 2 + s) * 64]; }
        const u32x4* np = (const u32x4*)(RN + unit * 4096 + (size_t)(vg * 64 + lane) * 16); const u32x4 n0 = np[0], n1 = np[1];
        f32x4 gm4[4];
#pragma unroll
        for (int kt = 0; kt < 4; ++kt) gm4[kt] = *(const f32x4*)(RG + unit * 64 + 16 * kt + 4 * fq);
        bf16x8 bs[2];
#pragma unroll
        for (int s = 0; s < 2; ++s) { u32x4 w; w.x = cvtpk(S[2 * s][0], S[2 * s][1]); w.y = cvtpk(S[2 * s][2], S[2 * s][3]); w.z = cvtpk(S[2 * s + 1][0], S[2 * s + 1][1]); w.w = cvtpk(S[2 * s + 1][2], S[2 * s + 1][3]); bs[s] = __builtin_bit_cast(bf16x8, w); }
#pragma unroll
        for (int tt = 0; tt < 4; ++tt) { f32x4 ya = (f32x4){0.f, 0.f, 0.f, 0.f};
            ya = __builtin_amdgcn_mfma_f32_16x16x32_bf16(rf[tt][0], bs[0], ya, 0, 0, 0); ya = __builtin_amdgcn_mfma_f32_16x16x32_bf16(rf[tt][1], bs[1], ya, 0, 0, 0);
#pragma unroll
            for (int g = 0; g < 4; ++g) { bf16_t* yp = Y + ((size_t)b * SEQ + scan_tok(d, c, 16 * tt + 4 * fq + g)) * RWW + h * 64 + 16 * vg + fr; *yp = f2bf(ya[g] + bf2f(*yp)); } }
        const float nv[16] = {bflo(n0.x), bfhi(n0.x), bflo(n0.y), bfhi(n0.y), bflo(n0.z), bfhi(n0.z), bflo(n0.w), bfhi(n0.w), bflo(n1.x), bfhi(n1.x), bflo(n1.y), bfhi(n1.y), bflo(n1.z), bfhi(n1.z), bflo(n1.w), bfhi(n1.w)};
#pragma unroll
        for (int kt = 0; kt < 4; ++kt) { f32x4 na;
#pragma unroll
            for (int g = 0; g < 4; ++g) na[g] = S[kt][g] * gm4[kt][g] + nv[kt * 4 + g];
            na = __builtin_amdgcn_mfma_f32_16x16x32_bf16(mf[kt][0], bs[0], na, 0, 0, 0); na = __builtin_amdgcn_mfma_f32_16x16x32_bf16(mf[kt][1], bs[1], na, 0, 0, 0);
            S[kt] = na; }
    }
}

__device__ __forceinline__ void rwkv_final_unit(const Args& a, LAS unsigned char* lds, int unit, int tid) {
    const int tc = unit & 127, h = (unit >> 7) % RWH, b = unit / (128 * RWH);
    const int wid = __builtin_amdgcn_readfirstlane(tid >> 6), lane = tid & 63, fr = lane & 15, fq = lane >> 4;
    const int i = tid >> 3, jq = tid & 7, ch0 = h * 64 + jq * 8;
    const bf16_t* P = (const bf16_t*)(a.ws + WS_P);
    const int s_cur = tc * 64 + i; const size_t tok = (size_t)b * SEQ + s_cur;
    LAS bf16_t *XA0 = RWBUF(0), *XA1 = RWBUF(1), *A2s0 = RWBUF(2), *A2s1 = RWBUF(3);
    LAS bf16_t *XG = (LAS bf16_t*)(lds + 4 * RB);
    LAS bf16_t *G2s = (LAS bf16_t*)(lds + 4 * RB + 64 * 136 * 2);
    LAS float *AP0 = (LAS float*)(lds + 8 * RB), *AP1 = (LAS float*)(lds + 8 * RB + 16384), *GP = (LAS float*)(lds + 8 * RB + 32768);
    float r_[2][8], k_[2][8], v_[2][8];
    {   float cur[8], nb[8], mu[8], tmp[8];
#pragma unroll
        for (int d = 0; d < 2; ++d) {
            const bool has = d ? (s_cur < SEQ - 1) : (s_cur > 0); const size_t tokp = has ? (d ? tok + 1 : tok - 1) : tok;
            unpack8(*(const u32x4*)(P + tok * PW + C_LA + jq * 8), cur); unpack8(*(const u32x4*)(P + tokp * PW + C_LA + jq * 8), nb); ld8f(a.in[I_MUA] + d * 64 + jq * 8, mu);
#pragma unroll
            for (int j = 0; j < 8; ++j) { const float sh = has ? nb[j] : 0.f; tmp[j] = cur[j] + (sh - cur[j]) * mu[j]; }
            *(LAS u32x4*)((d ? XA1 : XA0) + i * LP + jq * 8) = pack8(tmp);
            *(LAS u32x4*)((d ? A2s1 : A2s0) + i * LP + jq * 8) = *(const u32x4*)((const bf16_t*)(a.ws + WS_A2T) + ((size_t)d * 384 + h * 64 + i) * 64 + jq * 8);
            unpack8(*(const u32x4*)(P + tok * PW + C_PR + ch0), cur); unpack8(*(const u32x4*)(P + tokp * PW + C_PR + ch0), nb); ld8f(a.in[I_MURKV] + (d * 3 + 0) * 384 + ch0, mu);
#pragma unroll
            for (int j = 0; j < 8; ++j) { const float sh = has ? nb[j] : 0.f; r_[d][j] = cur[j] + (sh - cur[j]) * mu[j]; }
            unpack8(*(const u32x4*)(P + tok * PW + C_PK + ch0), cur); unpack8(*(const u32x4*)(P + tokp * PW + C_PK + ch0), nb); ld8f(a.in[I_MURKV] + (d * 3 + 1) * 384 + ch0, mu);
#pragma unroll
            for (int j = 0; j < 8; ++j) { const float sh = has ? nb[j] : 0.f; k_[d][j] = cur[j] + (sh - cur[j]) * mu[j]; }
            unpack8(*(const u32x4*)(P + tok * PW + C_PV + ch0), cur); unpack8(*(const u32x4*)(P + tokp * PW + C_PV + ch0), nb); ld8f(a.in[I_MURKV] + (d * 3 + 2) * 384 + ch0, mu);
#pragma unroll
            for (int j = 0; j < 8; ++j) { const float sh = has ? nb[j] : 0.f; v_[d][j] = cur[j] + (sh - cur[j]) * mu[j]; }
        }
#pragma unroll
        for (int q = 0; q < 2; ++q) {
            unpack8(*(const u32x4*)(P + tok * PW + C_LG + jq * 16 + q * 8), cur);
#pragma unroll
            for (int j = 0; j < 8; ++j) tmp[j] = sigmoidf_(cur[j]);
            *(LAS u32x4*)(XG + i * 136 + jq * 16 + q * 8) = pack8(tmp);
            *(LAS u32x4*)(G2s + i * 136 + jq * 16 + q * 8) = *(const u32x4*)((const bf16_t*)(a.ws + WS_G2T) + ((size_t)h * 64 + i) * 128 + jq * 16 + q * 8);
        }
    }
    __syncthreads();
    {   f32x4 acc[2]; const int rt = wid >> 1, ct0 = 2 * (wid & 1);
        zero2(acc); mm64(XA0, A2s0, acc, wid, fr, fq);
#pragma unroll
        for (int cc = 0; cc < 2; ++cc)
#pragma unroll
            for (int g = 0; g < 4; ++g) AP0[(16 * rt + 4 * fq + g) * 64 + 16 * (ct0 + cc) + fr] = acc[cc][g];
        zero2(acc); mm64(XA1, A2s1, acc, wid, fr, fq);
#pragma unroll
        for (int cc = 0; cc < 2; ++cc)
#pragma unroll
            for (int g = 0; g < 4; ++g) AP1[(16 * rt + 4 * fq + g) * 64 + 16 * (ct0 + cc) + fr] = acc[cc][g];
        zero2(acc);
#pragma unroll
        for (int s = 0; s < 4; ++s) { const bf16x8 af = *(const LAS bf16x8*)(XG + (16 * rt + fr) * 136 + 32 * s + 8 * fq);
#pragma unroll
            for (int cc = 0; cc < 2; ++cc) { const bf16x8 bfrag = *(const LAS bf16x8*)(G2s + (16 * (ct0 + cc) + fr) * 136 + 32 * s + 8 * fq); acc[cc] = __builtin_amdgcn_mfma_f32_16x16x32_bf16(af, bfrag, acc[cc], 0, 0, 0); } }
#pragma unroll
        for (int cc = 0; cc < 2; ++cc)
#pragma unroll
            for (int g = 0; g < 4; ++g) GP[(16 * rt + 4 * fq + g) * 64 + 16 * (ct0 + cc) + fr] = acc[cc][g];
    }
    __syncthreads();
    {   float bonus[8], rk[8], kaw[8], a0[8], ap[8];
#pragma unroll
        for (int j = 0; j < 8; ++j) bonus[j] = 0.f;
        ld8f(a.in[I_RK] + ch0, rk); ld8f(a.in[I_KA] + ch0, kaw);
#pragma unroll
        for (int d = 0; d < 2; ++d) {
            ld8f(a.in[I_A0] + d * 384 + ch0, a0);
            const LAS float* APd = d ? AP1 : AP0;
            { const f32x4 x0 = *(const LAS f32x4*)(APd + i * 64 + jq * 8), x1 = *(const LAS f32x4*)(APd + i * 64 + jq * 8 + 4); ap[0] = x0.x; ap[1] = x0.y; ap[2] = x0.z; ap[3] = x0.w; ap[4] = x1.x; ap[5] = x1.y; ap[6] = x1.z; ap[7] = x1.w; }
            float dot = 0.f;
#pragma unroll
            for (int j = 0; j < 8; ++j) { const float ahv = sigmoidf_(a0[j] + ap[j]); const float kp = k_[d][j] * (1.f + (ahv - 1.f) * kaw[j]); dot += r_[d][j] * kp * rk[j]; }
            dot += __shfl_xor(dot, 1); dot += __shfl_xor(dot, 2); dot += __shfl_xor(dot, 4);
#pragma unroll
            for (int j = 0; j < 8; ++j) bonus[j] += dot * v_[d][j];
        }
        float yf[8], yb[8], ys[8], lng[8], lnb[8], gg[8];
        bf16_t* YF = (bf16_t*)(a.ws + WS_YRW) + tok * RWW + ch0; const bf16_t* YBp = (const bf16_t*)(a.ws + WS_YB) + tok * RWW + ch0;
        unpack8(*(const u32x4*)YF, yf); unpack8(*(const u32x4*)YBp, yb); ld8f(a.in[I_LNG] + ch0, lng); ld8f(a.in[I_LNB] + ch0, lnb);
        { const f32x4 x0 = *(const LAS f32x4*)(GP + i * 64 + jq * 8), x1 = *(const LAS f32x4*)(GP + i * 64 + jq * 8 + 4); gg[0] = x0.x; gg[1] = x0.y; gg[2] = x0.z; gg[3] = x0.w; gg[4] = x1.x; gg[5] = x1.y; gg[6] = x1.z; gg[7] = x1.w; }
        float sm = 0.f;
#pragma unroll
        for (int j = 0; j < 8; ++j) { ys[j] = yf[j] + yb[j]; sm += ys[j]; }
        sm += __shfl_xor(sm, 1); sm += __shfl_xor(sm, 2); sm += __shfl_xor(sm, 4);
        const float mean = sm * (1.f / 64.f); float vs = 0.f;
#pragma unroll
        for (int j = 0; j < 8; ++j) { const float dd = ys[j] - mean; vs += dd * dd; }
        vs += __shfl_xor(vs, 1); vs += __shfl_xor(vs, 2); vs += __shfl_xor(vs, 4);
        const float rstd = 1.f / sqrtf(vs * (1.f / 64.f) + GN_EPS);
        float o[8];
#pragma unroll
        for (int j = 0; j < 8; ++j) o[j] = ((ys[j] - mean) * rstd * lng[j] + lnb[j] + bonus[j]) * gg[j];
        *(u32x4*)YF = pack8(o);
    }
    __syncthreads();
}
#ifndef ONE_LAUNCH
#define ONE_LAUNCH 0
#endif
constexpr int NPHASE = 12;
template <int PHM> __global__ void __launch_bounds__(NTHR, 2) fwd_kernel(Args a) {
    extern __shared__ __attribute__((aligned(16))) unsigned char lds_raw[];
    LAS unsigned char* lds = (LAS unsigned char*)lds_raw;
    const int tid = threadIdx.x, lane = tid & 63, wave = __builtin_amdgcn_readfirstlane(tid >> 6);
    const int G = gridDim.x, bx = blockIdx.x;
    unsigned char* ws = a.ws;
#if ONE_LAUNCH
    cg::grid_group grid = cg::this_grid();
#define SEAM(k) do { if ((k) + 1 < a.ph_hi) grid.sync(); } while (0)
#else
#define SEAM(k) do { } while (0)
#endif
#define IN(k) (((PHM >> (k)) & 1) && a.ph_lo <= (k) && (k) < a.ph_hi)
    if (IN(0)) { phase_prologue(a, lds, wave, lane); SEAM(0); }
    if (IN(1)) {
        SchedIn S{16, 2048u, 2048u, (const char*)(ws + WS_XN), (const char*)(ws + WS_WIN), (const char*)(ws + WS_MEMN), (const char*)(ws + WS_WMKV), G, bx};
        EpiIn E{(bf16_t*)(ws + WS_P), (bf16_t*)(ws + WS_G), (bf16_t*)(ws + WS_MKV)};
        gm::gemm_phase<EpiIn, SchedIn>(lds, S, E);
        SEAM(1);
    }
    if (IN(2)) {
        for (int u = bx; u < NB * GROWS * NAH; u += G) na_unit(a, lds, u, tid);
        for (int u = bx; u < NB * MEMH * 16; u += G) mem_unit(a, lds, u, tid);
        for (int u = bx; u < 2 * NB * RWH * NCH; u += G) rwkv_chunk_unit(a, lds, u, tid);
        SEAM(2);
    }
    if (IN(3)) {
        if (wave == 0) for (int t = bx; t < 2 * NB * RWH * 4; t += G) rwkv_state_pass(a, t, lane);
        SEAM(3);
    }
    if (IN(4)) {
        for (int u = bx; u < NB * RWH * NCH; u += G) rwkv_final_unit(a, lds, u, tid);
        SEAM(4);
    }
    if (IN(5)) {
        const bf16_t* WBR = (const bf16_t*)(ws + WS_WBR);
        { SchedMerge S{6, 768u, 768u, (const char*)(ws + WS_YNA), (const char*)WBR, G, bx}; EpiMerge E{(const bf16_t*)(ws + WS_G), (bf16_t*)(ws + WS_MERGED), 0}; gm::gemm_phase<EpiMerge, SchedMerge>(lds, S, E); }
        VM_WAIT(); __syncthreads();
        { SchedMerge S{6, 768u, 768u, (const char*)(ws + WS_YRW), (const char*)(WBR + 1024 * 384), G, bx}; EpiMerge E{(const bf16_t*)(ws + WS_G), (bf16_t*)(ws + WS_MERGED), 1}; gm::gemm_phase<EpiMerge, SchedMerge>(lds, S, E); }
        VM_WAIT(); __syncthreads();
        { SchedMerge S{4, 512u, 512u, (const char*)(ws + WS_YMEM), (const char*)(WBR + 2 * 1024 * 384), G, bx}; EpiMerge E{(const bf16_t*)(ws + WS_G), (bf16_t*)(ws + WS_MERGED), 2}; gm::gemm_phase<EpiMerge, SchedMerge>(lds, S, E); }
        SEAM(5);
    }
    if (IN(6)) {
        SchedOut S{16, 2048u, 2048u, (const char*)(ws + WS_MERGED), (const char*)(ws + WS_WOUT), G, bx}; EpiOut E{a.in[I_X], a.out};
        gm::gemm_phase<EpiOut, SchedOut>(lds, S, E);
        SEAM(6);
    }
    if (IN(7)) {
        {
            const f32x4* src = (const f32x4*)a.in[I_WROUTER]; LAS f32x4* dst = (LAS f32x4*)lds;
            for (int q = tid; q < DM * NE / 4; q += NTHR) dst[q] = src[q];
            __syncthreads();
        }
        phase_norm_router(a, lds, wave, lane);
        SEAM(7);
    }
    if (IN(8)) {
        if (bx < NB * NE) topk_unit(a, lds, bx, tid);
        expert_convert(a, lds, wave, lane, bx * NWAVES + wave, G * NWAVES);
        SEAM(8);
    }
    if (IN(9)) {
        SchedMoe1 S{16, 2048u, 2048u, (const char*)(ws + WS_XN), (const char*)(ws + WS_WGU), (const int*)(ws + WS_TIDX), G, bx}; EpiMoe1 E{(bf16_t*)(ws + WS_ACT)};
        gm::gemm_phase<EpiMoe1, SchedMoe1>(lds, S, E);
        SEAM(9);
    }
    if (IN(10)) {
        SchedMoe2 S{32, 4096u, 4096u, (const char*)(ws + WS_ACT), (const char*)(ws + WS_WD), G, bx}; EpiMoe2 E{(bf16_t*)(ws + WS_YE), (const float*)(ws + WS_TVAL)};
        gm::gemm_phase<EpiMoe2, SchedMoe2>(lds, S, E);
        SEAM(10);
    }
    if (IN(11)) phase_final(a, wave, lane);
#undef IN
#undef SEAM
}

template <int PHM> static bool prep_kernel(int& per_cu) {
    if (hipFuncSetAttribute((const void*)fwd_kernel<PHM>, hipFuncAttributeMaxDynamicSharedMemorySize, LDS_BYTES) != hipSuccess) return false;
    int pc = 0; if (hipOccupancyMaxActiveBlocksPerMultiprocessor(&pc, (const void*)fwd_kernel<PHM>, NTHR, LDS_BYTES) != hipSuccess) pc = 0;
    (void)hipGetLastError(); if (pc < per_cu) per_cu = pc; return true;
}
template <int P> static void launch_phase(int grid, Args a, hipStream_t stream) { a.ph_lo = P; a.ph_hi = P + 1; hipLaunchKernelGGL(fwd_kernel<(1 << P)>, dim3(grid), dim3(NTHR), LDS_BYTES, stream, a); }
extern "C" void kernel_launch(void* const* d_in, const int* in_sizes, int n_in, void* d_out, int out_size, void* d_ws, size_t ws_size, hipStream_t stream) {
    static int grid = 0;
    if (grid == 0) {
        if (n_in != 30 || out_size != T * DM || ws_size < WS_END) { fprintf(stderr, "kernel_launch: unexpected sizes: n_in %d out %d ws %zu (need %zu)\n", n_in, out_size, ws_size, (size_t)WS_END); grid = -1; return; }
        int dev = 0, cus = 0, per_cu = 99; bool ok = true;
        if (hipGetDevice(&dev) != hipSuccess || hipDeviceGetAttribute(&cus, hipDeviceAttributeMultiprocessorCount, dev) != hipSuccess) ok = false;
#if ONE_LAUNCH
        ok = ok && prep_kernel<0xfff>(per_cu);
#else
        ok = ok && prep_kernel<1>(per_cu) && prep_kernel<2>(per_cu) && prep_kernel<4>(per_cu) && prep_kernel<8>(per_cu) && prep_kernel<16>(per_cu) && prep_kernel<32>(per_cu) && prep_kernel<64>(per_cu)
                && prep_kernel<128>(per_cu) && prep_kernel<256>(per_cu) && prep_kernel<512>(per_cu) && prep_kernel<1024>(per_cu) && prep_kernel<2048>(per_cu);
#endif
        if (!ok || per_cu < 1) { fprintf(stderr, "kernel_launch: set-up failed (ok %d, per_cu %d)\n", (int)ok, per_cu); grid = -1; return; }
        grid = cus;
        fprintf(stderr, "kernel_launch: grid %d, per_cu %d, ws %zu\n", grid, per_cu, ws_size);
    }
    if (grid < 0) return;
    Args a{};
    for (int i = 0; i < 30; ++i) a.in[i] = (const float*)d_in[i];
    a.out = (float*)d_out; a.ws = (unsigned char*)d_ws;
#if ONE_LAUNCH
    a.ph_lo = 0; a.ph_hi = NPHASE;
    void* args[] = {&a};
    hipError_t e = hipLaunchCooperativeKernel((const void*)fwd_kernel<0xfff>, dim3(grid), dim3(NTHR), args, LDS_BYTES, stream);
    if (e != hipSuccess) fprintf(stderr, "cooperative launch failed: %s\n", hipGetErrorString(e));
#else
    launch_phase<0>(grid, a, stream); launch_phase<1>(grid, a, stream); launch_phase<2>(grid, a, stream); launch_phase<3>(grid, a, stream); launch_phase<4>(grid, a, stream); launch_phase<5>(grid, a, stream);
    launch_phase<6>(grid, a, stream); launch_phase<7>(grid, a, stream); launch_phase<8>(grid, a, stream); launch_phase<9>(grid, a, stream); launch_phase<10>(grid, a, stream); launch_phase<11>(grid, a, stream);
#endif
}
```

```cpp
#include <hip/hip_runtime.h>
#include <hip/hip_cooperative_groups.h>
#include <cstdio>
#include <cstdint>
namespace cg = cooperative_groups;

#define LAS __attribute__((address_space(3)))
typedef unsigned short bf16_t;
typedef short bf16x8 __attribute__((ext_vector_type(8)));
typedef short s16x4 __attribute__((ext_vector_type(4)));
typedef float f32x4 __attribute__((ext_vector_type(4)));
typedef float f32x2 __attribute__((ext_vector_type(2)));
typedef unsigned u32x4 __attribute__((ext_vector_type(4)));
typedef unsigned u32x2 __attribute__((ext_vector_type(2)));
typedef __bf16 bf16x2_t __attribute__((ext_vector_type(2)));

constexpr int DM = 1024, NB = 4, SEQ = 8192, T = NB * SEQ, GRIDW = 64, GROWS = SEQ / GRIDW, NMEM = 256, HD = 64;
constexpr int NAH = 6, NAW = 384, RWH = 6, RWW = 384, MEMH = 4, MEMW = 256, NE = 16, CAP = 1024, FF = 2048;
constexpr int DIN = 5888, PW = 2816, GWD = 3072;
constexpr int C_NAQ = 0, C_NAK = 384, C_NAV = 768, C_PR = 1152, C_PK = 1536, C_PV = 1920, C_LW = 2304, C_LA = 2368, C_LG = 2432, C_MQ = 2560;
constexpr int NCH = SEQ / 64;
constexpr float RMS_EPS = 1e-6f, GN_EPS = 64e-5f;

constexpr size_t MiB = (size_t)1 << 20;
constexpr size_t WS_CTL = 0;
constexpr size_t WS_W2T = 1 * MiB;
constexpr size_t WS_A2T = WS_W2T + 98304;
constexpr size_t WS_G2T = WS_A2T + 98304;
constexpr size_t WS_AFF = 2 * MiB;
constexpr size_t WS_TIDX = 4 * MiB;
constexpr size_t WS_TVAL = WS_TIDX + 262144;
constexpr size_t WS_SLOT = 5 * MiB;
constexpr size_t WS_WIN = 8 * MiB;
constexpr size_t WS_WBR = 20 * MiB;
constexpr size_t WS_WOUT = 22 * MiB;
constexpr size_t WS_WMKV = 24 * MiB;
constexpr size_t WS_MEMN = 25 * MiB;
constexpr size_t WS_MKV = 27 * MiB;
constexpr size_t WS_XN = 28 * MiB;
constexpr size_t WS_YNA = WS_XN, WS_YMEM = WS_XN + 24 * MiB, WS_YRW = WS_XN + 40 * MiB;
constexpr size_t WS_P = 92 * MiB;
constexpr size_t WS_G = 268 * MiB;
constexpr size_t WS_RN = 460 * MiB;
constexpr size_t WS_YB = 508 * MiB;
constexpr size_t WS_MERGED = 460 * MiB;
constexpr size_t WS_WGU = 92 * MiB;
constexpr size_t WS_WD = 220 * MiB;
constexpr size_t WS_ACT = 284 * MiB;
constexpr size_t WS_YE = 92 * MiB;
constexpr size_t WS_END = 540 * MiB;
constexpr size_t DO_RM = 0;
constexpr size_t DO_RR = 48 * MiB;
constexpr size_t DO_RG = 96 * MiB;

__device__ __forceinline__ unsigned cvtpk(float lo, float hi) { f32x2 v = {lo, hi}; bf16x2_t b = __builtin_convertvector(v, bf16x2_t); return __builtin_bit_cast(unsigned, b); }
__device__ __forceinline__ bf16_t f2bf(float f) { return (bf16_t)(cvtpk(f, 0.f) & 0xffffu); }
__device__ __forceinline__ float bf2f(unsigned h) { return __uint_as_float(h << 16); }
__device__ __forceinline__ float bflo(unsigned w) { return __uint_as_float(w << 16); }
__device__ __forceinline__ float bfhi(unsigned w) { return __uint_as_float(w & 0xffff0000u); }
__device__ __forceinline__ float wave_sum(float v) {
#pragma unroll
    for (int o = 1; o < 64; o <<= 1) v += __shfl_xor(v, o);
    return v;
}
__device__ __forceinline__ float sigmoidf_(float x) { return 1.f / (1.f + __expf(-x)); }
#define LDS_WAIT() asm volatile("s_waitcnt lgkmcnt(0)" ::: "memory")
#define VM_WAIT() asm volatile("s_waitcnt vmcnt(0)" ::: "memory")
__device__ __forceinline__ void unpack8(const u32x4 w, float (&o)[8]) { o[0] = bflo(w.x); o[1] = bfhi(w.x); o[2] = bflo(w.y); o[3] = bfhi(w.y); o[4] = bflo(w.z); o[5] = bfhi(w.z); o[6] = bflo(w.w); o[7] = bfhi(w.w); }
__device__ __forceinline__ u32x4 pack8(const float (&o)[8]) { u32x4 w; w.x = cvtpk(o[0], o[1]); w.y = cvtpk(o[2], o[3]); w.z = cvtpk(o[4], o[5]); w.w = cvtpk(o[6], o[7]); return w; }
__device__ __forceinline__ void ld8f(const float* p, float (&o)[8]) { const f32x4 a = *(const f32x4*)p, b = *(const f32x4*)(p + 4); o[0] = a.x; o[1] = a.y; o[2] = a.z; o[3] = a.w; o[4] = b.x; o[5] = b.y; o[6] = b.z; o[7] = b.w; }

namespace gm {
constexpr int BM = 256, BK = 64, HALF = 128, HTB = HALF * BK * 2  , STAGE_BYTES = 8 * HTB, NXCD = 8, WGM = 8;
__device__ __forceinline__ int lds_byte(int r, int c) { const int st = (r >> 4) * 2 + (c >> 5), rr = r & 15, cc = c & 31, ob = rr * 64 + cc * 2; return st * 1024 + (ob ^ (((ob >> 9) & 1) << 5)); }
__device__ __forceinline__ void stage_rc(int b, int& R, int& C) { const int st = b / 1024, sb = b % 1024, swz = sb ^ (((sb >> 9) & 1) << 5); R = (st >> 1) * 16 + swz / 64; C = (st & 1) * 32 + (swz % 64) / 2; }
__device__ __forceinline__ int perm32(int rho) { const int n = rho >> 4, i = rho & 15; return 8 * (i >> 2) + 4 * n + (i & 3); }

struct GUnit { const char* A; const char* B; const int* gidx; int pm, pn, aux; };

__device__ __forceinline__ void tile_of(int L, int nM, int nN, int& pm, int& pn) {
    const int nwg = nM * nN; int wgid = L;
    { const int q = nwg / NXCD, r = nwg % NXCD, xcd = wgid % NXCD, off = wgid / NXCD; wgid = (xcd < r ? xcd * (q + 1) : r * (q + 1) + (xcd - r) * q) + off; }
    const int nig = WGM * nN, gid = wgid / nig, fm = gid * WGM, gsz = (nM - fm) < WGM ? (nM - fm) : WGM;
    pm = fm + ((wgid % nig) % gsz); pn = (wgid % nig) / gsz;
}

template <class Epi, class Sched>
__device__ __forceinline__ void gemm_phase(LAS unsigned char* lds, const Sched& S, const Epi& E) {
    const int tid = threadIdx.x, wid = __builtin_amdgcn_readfirstlane(tid >> 6), lane = tid & 63, wr = wid >> 2, wc = wid & 3, fr = lane & 15, fq = lane >> 4;
    const int nt = S.nt;
    const unsigned lda2 = S.lda2, ldb2 = S.ldb2;
    int RA[2]; unsigned C2[2]; unsigned voffA[2], voffB[2];
#pragma unroll
    for (int i = 0; i < 2; ++i) { int R, C; stage_rc(tid * 16 + i * 8192, R, C); const int Rb = Epi::PERM ? ((R & ~31) + perm32(R & 31)) : R;
        RA[i] = R; C2[i] = (unsigned)C * 2u; voffA[i] = (unsigned)R * lda2 + C2[i]; voffB[i] = (unsigned)Rb * ldb2 + C2[i]; }
    const size_t kstep = (size_t)(BK * 2);
    const size_t hstepA = (size_t)HALF * lda2, hstepB = (size_t)HALF * ldb2;
    const unsigned ldsw = (unsigned)wid * 1024u;
    const int aoff = lds_byte(wr * 64 + fr, fq * 8), boff = lds_byte(wc * 32 + fr, fq * 8);
#define PG8_SA(b, h) (((b) * 2 + (h)) * HTB)
#define PG8_SB(b, h) ((4 + (b) * 2 + (h)) * HTB)
#define PG8_STAGE(bufoff, gbase, voff) do { _Pragma("unroll") for (int _i = 0; _i < 2; ++_i) \
        __builtin_amdgcn_global_load_lds((const unsigned*)((const char*)(gbase) + (voff)[_i]), (LAS unsigned*)(lds + (bufoff) + ldsw + _i * 8192), 16, 0, 0); } while (0)
#define PG8_STAGE_A(bufoff, gbase, h, VO) do { if constexpr (Sched::GATHER) { PG8_STAGE(bufoff, gbase, (VO)[h]); } else { PG8_STAGE(bufoff, (gbase) + (h) * hstepA, voffA); } } while (0)
#define PG8_LDA(dst, b, h) do { _Pragma("unroll") for (int m = 0; m < 4; ++m) _Pragma("unroll") for (int k = 0; k < 2; ++k) dst[m][k] = *(const LAS bf16x8*)(lds + PG8_SA(b, h) + aoff + m * 2048 + k * 1024); } while (0)
#define PG8_LDB(dst, b, h) do { _Pragma("unroll") for (int n = 0; n < 2; ++n) _Pragma("unroll") for (int k = 0; k < 2; ++k) dst[n][k] = *(const LAS bf16x8*)(lds + PG8_SB(b, h) + boff + n * 2048 + k * 1024); } while (0)
#define PG8_MMA(ai, bj, At, Bt) do { __builtin_amdgcn_s_setprio(1); _Pragma("unroll") for (int m = 0; m < 4; ++m) _Pragma("unroll") for (int n = 0; n < 2; ++n) _Pragma("unroll") for (int k = 0; k < 2; ++k) \
        acc[ai][bj][m][n] = __builtin_amdgcn_mfma_f32_16x16x32_bf16(Bt[n][k], At[m][k], acc[ai][bj][m][n], 0, 0, 0); __builtin_amdgcn_s_setprio(0); } while (0)
#define PG8_WAIT_V(n) asm volatile("s_waitcnt vmcnt(" #n ")" ::: "memory")
#define PG8_WAIT_L(n) asm volatile("s_waitcnt lgkmcnt(" #n ")" ::: "memory")
#define PG8_BAR __builtin_amdgcn_s_barrier()
#define PG8_SCHED __builtin_amdgcn_sched_barrier(0)
    GUnit cur, nxt; int ui = 0;
    if (!S.next(0, cur)) return;
    f32x4 acc[2][2][4][2];
#pragma unroll
    for (int a = 0; a < 2; ++a)
#pragma unroll
        for (int b = 0; b < 2; ++b)
#pragma unroll
            for (int m = 0; m < 4; ++m)
#pragma unroll
                for (int n = 0; n < 2; ++n) acc[a][b][m][n] = (f32x4){0.f, 0.f, 0.f, 0.f};
    bf16x8 At[4][2], B0[2][2], B1[2][2];
    const char* cA = cur.A; const char* cB = cur.B;
    unsigned cvo[2][2], nvo[2][2];
    if constexpr (Sched::GATHER) {
#pragma unroll
        for (int h = 0; h < 2; ++h)
#pragma unroll
            for (int i = 0; i < 2; ++i) { cvo[h][i] = (unsigned)cur.gidx[h * HALF + RA[i]] * lda2 + C2[i]; nvo[h][i] = cvo[h][i]; }
    }
    PG8_STAGE(PG8_SB(0, 0), cB, voffB); PG8_STAGE(PG8_SB(0, 1), cB + hstepB, voffB); PG8_STAGE_A(PG8_SA(0, 0), cA, 0, cvo); PG8_STAGE_A(PG8_SA(0, 1), cA, 1, cvo);
    if (wr == 1) PG8_BAR;
    PG8_WAIT_V(2); PG8_BAR;
    PG8_STAGE(PG8_SB(1, 0), cB + kstep, voffB); PG8_STAGE_A(PG8_SA(1, 0), cA + kstep, 0, cvo); PG8_STAGE(PG8_SB(1, 1), cB + hstepB + kstep, voffB);
    PG8_WAIT_V(6); PG8_BAR;
    for (;;) {
        const bool has_next = S.next(ui + 1, nxt);
        const char* nA = has_next ? nxt.A : cA; const char* nB = has_next ? nxt.B : cB;
        int gi[2][2];
        if constexpr (Sched::GATHER) {
            const int* gp = has_next ? nxt.gidx : cur.gidx;
#pragma unroll
            for (int h = 0; h < 2; ++h)
#pragma unroll
                for (int i = 0; i < 2; ++i) gi[h][i] = gp[h * HALF + RA[i]];
        }
        for (int t = 0; t < nt; t += 2) {
            const bool last = (t == nt - 2);
            const char* a1 = cA + (size_t)(t + 1) * kstep;
            const char* a2 = last ? nA : cA + (size_t)(t + 2) * kstep; const char* b2 = last ? nB : cB + (size_t)(t + 2) * kstep;
            const char* a3 = a2 + kstep; const char* b3 = b2 + kstep;
            unsigned vo2[2][2];
            if constexpr (Sched::GATHER) {
                if (last) {
#pragma unroll
                    for (int h = 0; h < 2; ++h)
#pragma unroll
                        for (int i = 0; i < 2; ++i) nvo[h][i] = (unsigned)gi[h][i] * lda2 + C2[i];
                }
#pragma unroll
                for (int h = 0; h < 2; ++h)
#pragma unroll
                    for (int i = 0; i < 2; ++i) vo2[h][i] = last ? nvo[h][i] : cvo[h][i];
            }
            PG8_LDB(B0, 0, 0); PG8_LDB(B1, 0, 1); PG8_SCHED; PG8_LDA(At, 0, 0); PG8_STAGE_A(PG8_SA(1, 1), a1, 1, cvo);
            PG8_WAIT_V(8); PG8_WAIT_L(0); PG8_BAR; PG8_MMA(0, 0, At, B0); PG8_MMA(0, 1, At, B1); PG8_BAR; PG8_SCHED;
            PG8_LDA(At, 0, 1); PG8_STAGE(PG8_SB(0, 0), b2, voffB); PG8_STAGE(PG8_SB(0, 1), b2 + hstepB, voffB); PG8_STAGE_A(PG8_SA(0, 0), a2, 0, vo2);
            PG8_WAIT_V(8); PG8_WAIT_L(0); PG8_BAR; PG8_MMA(1, 0, At, B0); PG8_MMA(1, 1, At, B1); PG8_BAR; PG8_SCHED;
            PG8_LDB(B0, 1, 0); PG8_LDB(B1, 1, 1); PG8_SCHED; PG8_LDA(At, 1, 0); PG8_STAGE_A(PG8_SA(0, 1), a2, 1, vo2);
            PG8_WAIT_V(8); PG8_WAIT_L(0); PG8_BAR; PG8_MMA(0, 0, At, B0); PG8_MMA(0, 1, At, B1); PG8_BAR; PG8_SCHED;
            PG8_LDA(At, 1, 1); PG8_STAGE(PG8_SB(1, 0), b3, voffB); PG8_STAGE(PG8_SB(1, 1), b3 + hstepB, voffB); PG8_STAGE_A(PG8_SA(1, 0), a3, 0, vo2);
            PG8_WAIT_V(8); PG8_WAIT_L(0); PG8_BAR; PG8_MMA(1, 0, At, B0); PG8_MMA(1, 1, At, B1); PG8_BAR; PG8_SCHED;
        }
        if (wr == 0) PG8_BAR;
        E(acc, cur, wr, wc, fr, fq);
        if (!has_next) break;
#pragma unroll
        for (int a = 0; a < 2; ++a)
#pragma unroll
            for (int b = 0; b < 2; ++b)
#pragma unroll
                for (int m = 0; m < 4; ++m)
#pragma unroll
                    for (int n = 0; n < 2; ++n) acc[a][b][m][n] = (f32x4){0.f, 0.f, 0.f, 0.f};
        cur = nxt; cA = nA; cB = nB; ++ui;
        if constexpr (Sched::GATHER) {
#pragma unroll
            for (int h = 0; h < 2; ++h)
#pragma unroll
                for (int i = 0; i < 2; ++i) cvo[h][i] = nvo[h][i];
        }
        if (wr == 1) PG8_BAR;
    }
    PG8_WAIT_V(0);
    PG8_BAR;
#undef PG8_SA
#undef PG8_SB
#undef PG8_STAGE
#undef PG8_STAGE_A
#undef PG8_LDA
#undef PG8_LDB
#undef PG8_MMA
#undef PG8_WAIT_V
#undef PG8_WAIT_L
#undef PG8_BAR
#undef PG8_SCHED
}
}
using gm::GUnit;
struct SchedIn {
    static constexpr bool GATHER = false;
    int nt; unsigned lda2, ldb2; const char* XN; const char* WT; const char* MEMN; const char* WMKV; int G, c;
    __device__ __forceinline__ bool next(int i, GUnit& u) const {
        int L = i * G + c; u.gidx = nullptr;
        if (L < 128 * 23) { int pm, pn; gm::tile_of(L, 128, 23, pm, pn); u.A = XN + (size_t)pm * 256 * 2048; u.B = WT + (size_t)pn * 256 * 2048; u.pm = pm; u.pn = pn; u.aux = 0; return true; }
        L -= 128 * 23;
        if (L < 8) { const int pm = L >> 1, pn = L & 1; u.A = MEMN + (size_t)pm * 256 * 2048; u.B = WMKV + (size_t)pn * 256 * 2048; u.pm = pm; u.pn = pn; u.aux = 1; return true; }
        return false;
    }
};
struct EpiIn {
    static constexpr bool PERM = true;
    bf16_t* P; bf16_t* Gt; bf16_t* MKV;
    __device__ __forceinline__ void operator()(const f32x4 (&acc)[2][2][4][2], const GUnit& u, int wr, int wc, int fr, int fq) const {
        const int row0 = u.pm * 256 + wr * 64 + fr;
        bf16_t* base; int ldc, colt; bool sig = false;
        if (u.aux == 1) { base = MKV; ldc = 512; colt = u.pn * 256; }
        else if (u.pn < 11) { base = P; ldc = PW; colt = u.pn * 256; }
        else { base = Gt; ldc = GWD; colt = (u.pn - 11) * 256; sig = true; }
        const int col0 = colt + wc * 32 + 8 * fq;
#pragma unroll
        for (int ai = 0; ai < 2; ++ai)
#pragma unroll
            for (int m = 0; m < 4; ++m) { bf16_t* rowp = base + (size_t)(row0 + ai * 128 + m * 16) * ldc + col0;
#pragma unroll
                for (int bj = 0; bj < 2; ++bj) { f32x4 v0 = acc[ai][bj][m][0], v1 = acc[ai][bj][m][1];
                    if (sig) {
#pragma unroll
                        for (int j = 0; j < 4; ++j) { v0[j] = sigmoidf_(v0[j]); v1[j] = sigmoidf_(v1[j]); } }
                    u32x4 w; w.x = cvtpk(v0[0], v0[1]); w.y = cvtpk(v0[2], v0[3]); w.z = cvtpk(v1[0], v1[1]); w.w = cvtpk(v1[2], v1[3]);
                    *(u32x4*)(rowp + bj * 128) = w; } }
    }
};
struct SchedMerge {
    static constexpr bool GATHER = false;
    int nt; unsigned lda2, ldb2; const char* Y; const char* WT; int G, c;
    __device__ __forceinline__ bool next(int i, GUnit& u) const {
        const int L = i * G + c; u.gidx = nullptr; if (L >= 512) return false;
        int pm, pn; gm::tile_of(L, 128, 4, pm, pn); u.A = Y + (size_t)pm * 256 * lda2; u.B = WT + (size_t)pn * 256 * ldb2; u.pm = pm; u.pn = pn; u.aux = 0; return true;
    }
};
struct EpiMerge {
    static constexpr bool PERM = true;
    const bf16_t* Gt; bf16_t* MG; int pass;
    __device__ __forceinline__ void operator()(const f32x4 (&acc)[2][2][4][2], const GUnit& u, int wr, int wc, int fr, int fq) const {
        const int row0 = u.pm * 256 + wr * 64 + fr, col0 = u.pn * 256 + wc * 32 + 8 * fq;
#pragma unroll
        for (int ai = 0; ai < 2; ++ai)
#pragma unroll
            for (int m = 0; m < 4; ++m) { const size_t row = (size_t)(row0 + ai * 128 + m * 16);
#pragma unroll
                for (int bj = 0; bj < 2; ++bj) {
                    const u32x4 g = *(const u32x4*)(Gt + row * GWD + pass * 1024 + col0 + bj * 128);
                    bf16_t* mp = MG + row * DM + col0 + bj * 128;
                    float o[8];
                    const f32x4 v0 = acc[ai][bj][m][0], v1 = acc[ai][bj][m][1];
                    o[0] = bflo(g.x) * v0[0]; o[1] = bfhi(g.x) * v0[1]; o[2] = bflo(g.y) * v0[2]; o[3] = bfhi(g.y) * v0[3];
                    o[4] = bflo(g.z) * v1[0]; o[5] = bfhi(g.z) * v1[1]; o[6] = bflo(g.w) * v1[2]; o[7] = bfhi(g.w) * v1[3];
                    if (pass > 0) { const u32x4 p = *(const u32x4*)mp;
                        o[0] += bflo(p.x); o[1] += bfhi(p.x); o[2] += bflo(p.y); o[3] += bfhi(p.y); o[4] += bflo(p.z); o[5] += bfhi(p.z); o[6] += bflo(p.w); o[7] += bfhi(p.w); }
                    u32x4 w; w.x = cvtpk(o[0], o[1]); w.y = cvtpk(o[2], o[3]); w.z = cvtpk(o[4], o[5]); w.w = cvtpk(o[6], o[7]);
                    *(u32x4*)mp = w; } }
    }
};
struct SchedOut {
    static constexpr bool GATHER = false;
    int nt; unsigned lda2, ldb2; const char* A; const char* WT; int G, c;
    __device__ __forceinline__ bool next(int i, GUnit& u) const {
        const int L = i * G + c; u.gidx = nullptr; if (L >= 512) return false;
        int pm, pn; gm::tile_of(L, 128, 4, pm, pn); u.A = A + (size_t)pm * 256 * lda2; u.B = WT + (size_t)pn * 256 * ldb2; u.pm = pm; u.pn = pn; u.aux = 0; return true;
    }
};
struct EpiOut {
    static constexpr bool PERM = false;
    const float* X; float* O;
    __device__ __forceinline__ void operator()(const f32x4 (&acc)[2][2][4][2], const GUnit& u, int wr, int wc, int fr, int fq) const {
        const int row0 = u.pm * 256 + wr * 64 + fr, col0 = u.pn * 256 + wc * 32 + 4 * fq;
#pragma unroll
        for (int ai = 0; ai < 2; ++ai)
#pragma unroll
            for (int m = 0; m < 4; ++m) { const size_t off = (size_t)(row0 + ai * 128 + m * 16) * DM + col0;
#pragma unroll
                for (int bj = 0; bj < 2; ++bj)
#pragma unroll
                    for (int n = 0; n < 2; ++n) { const f32x4 xv = *(const f32x4*)(X + off + bj * 128 + n * 16); *(f32x4*)(O + off + bj * 128 + n * 16) = xv + acc[ai][bj][m][n]; } }
    }
};
struct SchedMoe1 {
    static constexpr bool GATHER = true;
    int nt; unsigned lda2, ldb2; const char* XN2; const char* WGU; const int* TIDX; int G, c;
    __device__ __forceinline__ bool next(int i, GUnit& u) const {
        const int L = i * G + c; if (L >= NE * 256) return false;
        const int e = L >> 8; int pm, pn; gm::tile_of(L & 255, 16, 16, pm, pn);
        u.A = XN2; u.gidx = TIDX + e * 4096 + pm * 256; u.B = WGU + ((size_t)e * 4096 + (size_t)pn * 256) * 2048; u.pm = e * 16 + pm; u.pn = pn; u.aux = 0; return true;
    }
};
struct EpiMoe1 {
    static constexpr bool PERM = true;
    bf16_t* ACT;
    __device__ __forceinline__ void operator()(const f32x4 (&acc)[2][2][4][2], const GUnit& u, int wr, int wc, int fr, int fq) const {
        const int row0 = u.pm * 256 + wr * 64 + fr, col0 = u.pn * 128 + wc * 32 + 8 * fq;
#pragma unroll
        for (int ai = 0; ai < 2; ++ai)
#pragma unroll
            for (int m = 0; m < 4; ++m) { bf16_t* rowp = ACT + (size_t)(row0 + ai * 128 + m * 16) * FF + col0;
                float o[8];
#pragma unroll
                for (int n = 0; n < 2; ++n)
#pragma unroll
                    for (int j = 0; j < 4; ++j) { const float g = acc[ai][0][m][n][j], up = acc[ai][1][m][n][j]; o[n * 4 + j] = g * sigmoidf_(g) * up; }
                u32x4 w; w.x = cvtpk(o[0], o[1]); w.y = cvtpk(o[2], o[3]); w.z = cvtpk(o[4], o[5]); w.w = cvtpk(o[6], o[7]);
                *(u32x4*)rowp = w; }
    }
};
struct SchedMoe2 {
    static constexpr bool GATHER = false;
    int nt; unsigned lda2, ldb2; const char* ACT; const char* WD; int G, c;
    __device__ __forceinline__ bool next(int i, GUnit& u) const {
        const int L = i * G + c; u.gidx = nullptr; if (L >= NE * 64) return false;
        const int e = L >> 6; int pm, pn; gm::tile_of(L & 63, 16, 4, pm, pn);
        u.A = ACT + ((size_t)e * 4096 + (size_t)pm * 256) * 4096; u.B = WD + ((size_t)e * 1024 + (size_t)pn * 256) * 4096; u.pm = e * 16 + pm; u.pn = pn; u.aux = 0; return true;
    }
};
struct EpiMoe2 {
    static constexpr bool PERM = true;
    bf16_t* YE; const float* TVAL;
    __device__ __forceinline__ void operator()(const f32x4 (&acc)[2][2][4][2], const GUnit& u, int wr, int wc, int fr, int fq) const {
        const int row0 = u.pm * 256 + wr * 64 + fr, col0 = u.pn * 256 + wc * 32 + 8 * fq;
#pragma unroll
        for (int ai = 0; ai < 2; ++ai)
#pragma unroll
            for (int m = 0; m < 4; ++m) { const int row = row0 + ai * 128 + m * 16; const float tv = TVAL[row]; bf16_t* rowp = YE + (size_t)row * DM + col0;
#pragma unroll
                for (int bj = 0; bj < 2; ++bj) { const f32x4 v0 = acc[ai][bj][m][0] * tv, v1 = acc[ai][bj][m][1] * tv;
                    u32x4 w; w.x = cvtpk(v0[0], v0[1]); w.y = cvtpk(v0[2], v0[3]); w.z = cvtpk(v1[0], v1[1]); w.w = cvtpk(v1[2], v1[3]);
                    *(u32x4*)(rowp + bj * 128) = w; } }
    }
};
constexpr int NWAVES = 8, NTHR = 512;
constexpr int LDS_BYTES = 147456;
struct Args { const float* in[30]; float* out; unsigned char* ws; int ph_lo, ph_hi; };
enum { I_X = 0, I_MEM, I_NMIXG, I_NMEMG, I_WIN, I_RPB, I_MURKV, I_MUW, I_MUA, I_W0, I_W2, I_A0, I_A2, I_KK, I_KA, I_RK, I_G2, I_LNG, I_LNB, I_WMKV, I_WBNA, I_WBRW, I_WBMEM, I_WOUT,
       I_NFFNG, I_WROUTER, I_WEG, I_WEU, I_WED, I_NFING };

__device__ __forceinline__ void transpose_item(const float* __restrict__ W, int N, bf16_t* __restrict__ WT, int ldw, int drow0, int k0, int n0, LAS float* scr, int lane) {
#pragma unroll 8
    for (int i = 0; i < 32; ++i) { const int kk = 2 * i + (lane >> 5); scr[kk * 33 + (lane & 31)] = W[(size_t)(k0 + kk) * N + n0 + (lane & 31)]; }
    LDS_WAIT(); asm volatile("" ::: "memory");
    const int c = lane & 7;
#pragma unroll
    for (int j = 0; j < 4; ++j) { const int n = (lane >> 3) + 8 * j; const LAS float* s = scr + (8 * c) * 33 + n;
        u32x4 o; o.x = cvtpk(s[0 * 33], s[1 * 33]); o.y = cvtpk(s[2 * 33], s[3 * 33]); o.z = cvtpk(s[4 * 33], s[5 * 33]); o.w = cvtpk(s[6 * 33], s[7 * 33]);
        *(u32x4*)(WT + (size_t)(drow0 + n) * ldw + k0 + 8 * c) = o; }
    LDS_WAIT(); asm volatile("" ::: "memory");
}
__device__ __forceinline__ bool tr_matrix(int& it, const float* W, int K, int N, bf16_t* WT, LAS float* scr, int lane) {
    const int nblk = N / 32, items = (K / 64) * nblk;
    if (it < items) { const int kb = it / nblk, nb = it % nblk; transpose_item(W, N, WT, K, 32 * nb, 64 * kb, 32 * nb, scr, lane); return true; }
    it -= items; return false;
}
__device__ __forceinline__ void rms_row_to_bf16(const float* __restrict__ xrow, const float* __restrict__ g, bf16_t* __restrict__ orow, int lane) {
    const f32x4* xr = (const f32x4*)xrow + lane; const f32x4* gr = (const f32x4*)g + lane;
    f32x4 v[4]; float s = 0.f;
#pragma unroll
    for (int j = 0; j < 4; ++j) { v[j] = xr[64 * j]; s += (v[j].x * v[j].x + v[j].y * v[j].y) + (v[j].z * v[j].z + v[j].w * v[j].w); }
    const float rstd = 1.f / sqrtf(wave_sum(s) * (1.f / DM) + RMS_EPS);
    unsigned long long* o8 = (unsigned long long*)orow + lane;
#pragma unroll
    for (int j = 0; j < 4; ++j) { const f32x4 gg = gr[64 * j];
        o8[64 * j] = (unsigned long long)cvtpk(v[j].x * rstd * gg.x, v[j].y * rstd * gg.y) | ((unsigned long long)cvtpk(v[j].z * rstd * gg.z, v[j].w * rstd * gg.w) << 32); }
}
__device__ __forceinline__ void phase_prologue(const Args& a, LAS unsigned char* lds, int wave, int lane) {
    unsigned char* ws = a.ws;
    LAS float* scr = (LAS float*)(lds + wave * 16384);
    const int gw = blockIdx.x * NWAVES + wave, NGW = gridDim.x * NWAVES;
    constexpr int NITEMS = 16 * 184 + 192 + 192 + 128 + 512 + 256 + 12 * 4 + 24;
    for (int it0 = gw; it0 < NITEMS; it0 += NGW) {
        int it = it0;
        if (tr_matrix(it, a.in[I_WIN], DM, DIN, (bf16_t*)(ws + WS_WIN), scr, lane)) continue;
        if (tr_matrix(it, a.in[I_WBNA], NAW, DM, (bf16_t*)(ws + WS_WBR), scr, lane)) continue;
        if (tr_matrix(it, a.in[I_WBRW], RWW, DM, (bf16_t*)(ws + WS_WBR) + 1024 * 384, scr, lane)) continue;
        if (tr_matrix(it, a.in[I_WBMEM], MEMW, DM, (bf16_t*)(ws + WS_WBR) + 2 * 1024 * 384, scr, lane)) continue;
        if (tr_matrix(it, a.in[I_WOUT], DM, DM, (bf16_t*)(ws + WS_WOUT), scr, lane)) continue;
        if (tr_matrix(it, a.in[I_WMKV], DM, 512, (bf16_t*)(ws + WS_WMKV), scr, lane)) continue;
        if (tr_matrix(it, a.in[I_W2], 64, 384, (bf16_t*)(ws + WS_W2T), scr, lane)) continue;
        if (tr_matrix(it, a.in[I_W2] + 64 * 384, 64, 384, (bf16_t*)(ws + WS_W2T) + 384 * 64, scr, lane)) continue;
        if (tr_matrix(it, a.in[I_A2], 64, 384, (bf16_t*)(ws + WS_A2T), scr, lane)) continue;
        if (tr_matrix(it, a.in[I_A2] + 64 * 384, 64, 384, (bf16_t*)(ws + WS_A2T) + 384 * 64, scr, lane)) continue;
        tr_matrix(it, a.in[I_G2], 128, 384, (bf16_t*)(ws + WS_G2T), scr, lane);
    }
    for (int m = gw; m < T; m += NGW) rms_row_to_bf16(a.in[I_X] + (size_t)m * DM, a.in[I_NMIXG], (bf16_t*)(ws + WS_XN) + (size_t)m * DM, lane);
    for (int m = gw; m < NB * NMEM; m += NGW) rms_row_to_bf16(a.in[I_MEM] + (size_t)m * DM, a.in[I_NMEMG], (bf16_t*)(ws + WS_MEMN) + (size_t)m * DM, lane);
}

template <int CTRL> __device__ __forceinline__ float dppf(float v) { return __int_as_float(__builtin_amdgcn_update_dpp(0, __float_as_int(v), CTRL, 0xf, 0xf, true)); }
__device__ __forceinline__ float sum8(float v) { v += dppf<0xB1>(v); v += dppf<0x4E>(v); v += dppf<0x141>(v); return v; }
__device__ __forceinline__ float dot8(const float (&q)[8], const u32x4 t4) {
    return q[0] * bflo(t4.x) + q[1] * bfhi(t4.x) + q[2] * bflo(t4.y) + q[3] * bfhi(t4.y) + q[4] * bflo(t4.z) + q[5] * bfhi(t4.z) + q[6] * bflo(t4.w) + q[7] * bfhi(t4.w);
}
__device__ __forceinline__ void axpy8(float (&o)[8], float p, const u32x4 t4) {
    o[0] += p * bflo(t4.x); o[1] += p * bfhi(t4.x); o[2] += p * bflo(t4.y); o[3] += p * bfhi(t4.y); o[4] += p * bflo(t4.z); o[5] += p * bfhi(t4.z); o[6] += p * bflo(t4.w); o[7] += p * bfhi(t4.w);
}
__device__ __forceinline__ void na_unit(const Args& a, LAS unsigned char* lds, int unit, int tid) {
    const int h = unit % NAH, r = (unit / NAH) % GROWS, b = unit / (NAH * GROWS);
    const bf16_t* P = (const bf16_t*)(a.ws + WS_P);
    const int rs = min(max(r - 4, 0), GROWS - 8);
    LAS unsigned char* Ks = lds; LAS unsigned char* Vs = lds + 65536; LAS float* RPB = (LAS float*)(lds + 131072);
    const int w = tid >> 3, sub = tid & 7;
    {
#pragma unroll
        for (int p = 0; p < 8; ++p) { const int key = w + 64 * p; const size_t tok = (size_t)b * SEQ + (size_t)(rs + (key >> 6)) * GRIDW + (key & 63);
            *(LAS u32x4*)(Ks + key * 128 + sub * 16) = *(const u32x4*)(P + tok * PW + C_NAK + h * 64 + sub * 8);
            *(LAS u32x4*)(Vs + key * 128 + sub * 16) = *(const u32x4*)(P + tok * PW + C_NAV + h * 64 + sub * 8); }
        if (tid < 15 * 31) RPB[tid] = a.in[I_RPB][h * 15 * 31 + tid];
    }
    float q[8];
    {   const size_t tok = (size_t)b * SEQ + (size_t)r * GRIDW + w; float t8[8]; unpack8(*(const u32x4*)(P + tok * PW + C_NAQ + h * 64 + sub * 8), t8);
#pragma unroll
        for (int j = 0; j < 8; ++j) q[j] = t8[j] * 0.125f; }
    __syncthreads();
    const int cs = min(max(w - 8, 0), GRIDW - 16);
    float o[8];
#pragma unroll
    for (int d = 0; d < 8; ++d) o[d] = 0.f;
    float mx = -1e30f, l = 0.f;
#pragma unroll 1
    for (int i = 0; i < 8; ++i) {
        const LAS float* bp = RPB + (rs + i - r + 7) * 31 + (cs - w + 15);
#pragma unroll 1
        for (int j0 = 0; j0 < 16; j0 += 4) {
            float s[4];
#pragma unroll
            for (int j = 0; j < 4; ++j) { const int key = i * 64 + cs + j0 + j; s[j] = sum8(dot8(q, *(const LAS u32x4*)(Ks + key * 128 + sub * 16))) + bp[j0 + j]; }
            const float mn = fmaxf(fmaxf(mx, fmaxf(s[0], s[1])), fmaxf(s[2], s[3])), sc = __expf(mx - mn);
            l *= sc; mx = mn;
#pragma unroll
            for (int d = 0; d < 8; ++d) o[d] *= sc;
#pragma unroll
            for (int j = 0; j < 4; ++j) { const int key = i * 64 + cs + j0 + j; const float p = __expf(s[j] - mn); l += p; axpy8(o, p, *(const LAS u32x4*)(Vs + key * 128 + sub * 16)); }
        }
    }
    {   const float il = 1.f / l; const size_t tok = (size_t)b * SEQ + (size_t)r * GRIDW + w;
#pragma unroll
        for (int d = 0; d < 8; ++d) o[d] *= il;
        *(u32x4*)((bf16_t*)(a.ws + WS_YNA) + tok * NAW + h * 64 + sub * 8) = pack8(o); }
    __syncthreads();
}
__device__ __forceinline__ void mem_unit(const Args& a, LAS unsigned char* lds, int unit, int tid) {
    const int qb = unit & 15, mh = (unit >> 4) & 3, b = unit >> 6;
    const bf16_t* MKV = (const bf16_t*)(a.ws + WS_MKV); const bf16_t* P = (const bf16_t*)(a.ws + WS_P);
    LAS unsigned char* Ks = lds; LAS unsigned char* Vs = lds + 32768;
    const int w = tid >> 3, sub = tid & 7;
#pragma unroll
    for (int p = 0; p < 4; ++p) { const int key = w + 64 * p; const bf16_t* src = MKV + (size_t)(b * NMEM + key) * 512 + mh * 64 + sub * 8;
        *(LAS u32x4*)(Ks + key * 128 + sub * 16) = *(const u32x4*)src; *(LAS u32x4*)(Vs + key * 128 + sub * 16) = *(const u32x4*)(src + 256); }
    __syncthreads();
#pragma unroll 1
    for (int pass = 0; pass < 8; ++pass) {
        const size_t tok = (size_t)b * SEQ + (size_t)qb * 512 + pass * 64 + w;
        float q[8], o[8];
        {   float t8[8]; unpack8(*(const u32x4*)(P + tok * PW + C_MQ + mh * 64 + sub * 8), t8);
#pragma unroll
            for (int j = 0; j < 8; ++j) { q[j] = t8[j] * 0.125f; o[j] = 0.f; } }
        float mx = -1e30f, l = 0.f;
#pragma unroll 1
        for (int k0 = 0; k0 < NMEM; k0 += 4) {
            float s[4];
#pragma unroll
            for (int j = 0; j < 4; ++j) s[j] = sum8(dot8(q, *(const LAS u32x4*)(Ks + (k0 + j) * 128 + sub * 16)));
            const float mn = fmaxf(fmaxf(mx, fmaxf(s[0], s[1])), fmaxf(s[2], s[3])), sc = __expf(mx - mn);
            l *= sc; mx = mn;
#pragma unroll
            for (int d = 0; d < 8; ++d) o[d] *= sc;
#pragma unroll
            for (int j = 0; j < 4; ++j) { const float p = __expf(s[j] - mn); l += p; axpy8(o, p, *(const LAS u32x4*)(Vs + (k0 + j) * 128 + sub * 16)); }
        }
        const float il = 1.f / l;
#pragma unroll
        for (int d = 0; d < 8; ++d) o[d] *= il;
        *(u32x4*)((bf16_t*)(a.ws + WS_YMEM) + tok * MEMW + mh * 64 + sub * 8) = pack8(o);
    }
    __syncthreads();
}

__device__ __forceinline__ void phase_norm_router(const Args& a, LAS unsigned char* lds, int wave, int lane) {
    const int gw = blockIdx.x * NWAVES + wave, NGW = gridDim.x * NWAVES;
    const float* x1 = a.out; const float* g = a.in[I_NFFNG]; const LAS float* wr = (const LAS float*)lds;
    bf16_t* XN2 = (bf16_t*)(a.ws + WS_XN); float* AFF = (float*)(a.ws + WS_AFF);
    for (int m = gw; m < T; m += NGW) {
        const f32x4* xr = (const f32x4*)(x1 + (size_t)m * DM) + lane; const f32x4* gr = (const f32x4*)g + lane;
        f32x4 v[4]; float s = 0.f;
#pragma unroll
        for (int j = 0; j < 4; ++j) { v[j] = xr[64 * j]; s += (v[j].x * v[j].x + v[j].y * v[j].y) + (v[j].z * v[j].z + v[j].w * v[j].w); }
        const float rstd = 1.f / sqrtf(wave_sum(s) * (1.f / DM) + RMS_EPS);
        unsigned long long* o8 = (unsigned long long*)(XN2 + (size_t)m * DM) + lane;
        float lg[16];
#pragma unroll
        for (int e = 0; e < 16; ++e) lg[e] = 0.f;
#pragma unroll 1
        for (int j = 0; j < 4; ++j) { const f32x4 gg = gr[64 * j]; f32x4 hh; hh.x = v[j].x * rstd * gg.x; hh.y = v[j].y * rstd * gg.y; hh.z = v[j].z * rstd * gg.z; hh.w = v[j].w * rstd * gg.w;
            o8[64 * j] = (unsigned long long)cvtpk(hh.x, hh.y) | ((unsigned long long)cvtpk(hh.z, hh.w) << 32);
            const int d0 = 4 * (64 * j + lane);
#pragma unroll
            for (int dd = 0; dd < 4; ++dd) { const LAS f32x4* wp = (const LAS f32x4*)(wr + (d0 + dd) * NE); const float hv = hh[dd];
#pragma unroll
                for (int e4 = 0; e4 < 4; ++e4) { const f32x4 wv = wp[e4]; lg[e4 * 4] += hv * wv.x; lg[e4 * 4 + 1] += hv * wv.y; lg[e4 * 4 + 2] += hv * wv.z; lg[e4 * 4 + 3] += hv * wv.w; } } }
#pragma unroll
        for (int e = 0; e < 16; ++e) lg[e] = wave_sum(lg[e]);
        float mxv = lg[0];
#pragma unroll
        for (int e = 1; e < 16; ++e) mxv = fmaxf(mxv, lg[e]);
        float se = 0.f;
#pragma unroll
        for (int e = 0; e < 16; ++e) { lg[e] = expf(lg[e] - mxv); se += lg[e]; }
        const float inv = 1.f / se;
        if (lane < 4) { f32x4 ov;
            if (lane == 0) ov = (f32x4){lg[0], lg[1], lg[2], lg[3]}; else if (lane == 1) ov = (f32x4){lg[4], lg[5], lg[6], lg[7]};
            else if (lane == 2) ov = (f32x4){lg[8], lg[9], lg[10], lg[11]}; else ov = (f32x4){lg[12], lg[13], lg[14], lg[15]};
            *(f32x4*)(AFF + (size_t)m * NE + lane * 4) = ov * inv; }
    }
}

__device__ __forceinline__ unsigned block_sum_u32(unsigned v, LAS unsigned* red, int tid) {
    unsigned s = v;
#pragma unroll
    for (int o = 1; o < 64; o <<= 1) s += __shfl_xor(s, o);
    if ((tid & 63) == 0) red[tid >> 6] = s;
    __syncthreads();
    unsigned t = 0;
#pragma unroll
    for (int w = 0; w < 8; ++w) t += red[w];
    __syncthreads();
    return t;
}
__device__ __forceinline__ unsigned block_excl_scan(unsigned v, LAS unsigned* red, int tid) {
    const int lane = tid & 63, wv = tid >> 6;
    unsigned inc = v;
#pragma unroll
    for (int o = 1; o < 64; o <<= 1) { const unsigned n = __shfl_up(inc, o); if (lane >= o) inc += n; }
    if (lane == 63) red[wv] = inc;
    __syncthreads();
    unsigned base = 0;
#pragma unroll
    for (int w = 0; w < 8; ++w) if (w < wv) base += red[w];
    __syncthreads();
    return base + inc - v;
}
__device__ __forceinline__ void topk_unit(const Args& a, LAS unsigned char* lds, int unit, int tid) {
    const int e = unit & 15, b = unit >> 4;
    const float* AFF = (const float*)(a.ws + WS_AFF);
    int* TIDX = (int*)(a.ws + WS_TIDX); float* TVAL = (float*)(a.ws + WS_TVAL); int* SLOT = (int*)(a.ws + WS_SLOT);
    LAS unsigned* red = (LAS unsigned*)lds;
    unsigned key[16];
#pragma unroll
    for (int j = 0; j < 16; ++j) key[j] = __float_as_uint(AFF[((size_t)b * SEQ + tid * 16 + j) * NE + e]);
    unsigned prefix = 0;
    for (int bit = 30; bit >= 0; --bit) {
        const unsigned cand = prefix | (1u << bit); unsigned c = 0;
#pragma unroll
        for (int j = 0; j < 16; ++j) c += (key[j] >= cand) ? 1u : 0u;
        const unsigned tot = block_sum_u32(c, red, tid);
        if (tot >= (unsigned)CAP) prefix = cand;
    }
    unsigned cg_ = 0, ce = 0;
#pragma unroll
    for (int j = 0; j < 16; ++j) { cg_ += (key[j] > prefix) ? 1u : 0u; ce += (key[j] == prefix) ? 1u : 0u; }
    const unsigned ngt = block_sum_u32(cg_, red, tid);
    const unsigned need = (unsigned)CAP - ngt;
    unsigned erank = block_excl_scan(ce, red, tid);
    unsigned sel = 0, nsel = 0;
#pragma unroll
    for (int j = 0; j < 16; ++j) { bool s = key[j] > prefix; if (key[j] == prefix) { s = erank < need; ++erank; } if (s) { sel |= 1u << j; ++nsel; } }
    unsigned pos = block_excl_scan(nsel, red, tid);
#pragma unroll
    for (int j = 0; j < 16; ++j) { const int tok = b * SEQ + tid * 16 + j; int slot = -1;
        if (sel & (1u << j)) { slot = e * 4096 + b * 1024 + (int)pos; ++pos; TIDX[slot] = tok; TVAL[slot] = __uint_as_float(key[j]); }
        SLOT[(size_t)tok * NE + e] = slot; }
}

__device__ __forceinline__ void expert_convert(const Args& a, LAS unsigned char* lds, int wave, int lane, int gw, int NGW) {
    LAS float* scr = (LAS float*)(lds + 4096 + wave * 16384);
    bf16_t* WGU = (bf16_t*)(a.ws + WS_WGU); bf16_t* WD = (bf16_t*)(a.ws + WS_WD);
    constexpr int PER_E = 3072, NIT = NE * PER_E;
    for (int it0 = gw; it0 < NIT; it0 += NGW) {
        const int e = it0 / PER_E; int it = it0 % PER_E;
        if (it < 2048) { const int up = it >> 10; it &= 1023; const int kb = it >> 6, nb = it & 63, n0 = 32 * nb;
            const float* W = a.in[up ? I_WEU : I_WEG] + (size_t)e * DM * FF;
            transpose_item(W, FF, WGU + (size_t)e * 4096 * 1024, 1024, 256 * (n0 >> 7) + (up ? 128 : 0) + (n0 & 127), 64 * kb, n0, scr, lane); }
        else { it -= 2048; const int kb = it >> 5, nb = it & 31;
            transpose_item(a.in[I_WED] + (size_t)e * FF * DM, DM, WD + (size_t)e * 1024 * 2048, 2048, 32 * nb, 64 * kb, 32 * nb, scr, lane); }
    }
}

__device__ __forceinline__ void phase_final(const Args& a, int wave, int lane) {
    const int gw = blockIdx.x * NWAVES + wave, NGW = gridDim.x * NWAVES;
    float* x1 = a.out; const float* g = a.in[I_NFING]; const int* SLOT = (const int*)(a.ws + WS_SLOT); const bf16_t* YE = (const bf16_t*)(a.ws + WS_YE);
    for (int m = gw; m < T; m += NGW) {
        f32x4* xr = (f32x4*)(x1 + (size_t)m * DM) + lane; const f32x4* gr = (const f32x4*)g + lane;
        f32x4 v[4];
#pragma unroll
        for (int j = 0; j < 4; ++j) v[j] = xr[64 * j];
        const int myslot = (lane < NE) ? SLOT[(size_t)m * NE + lane] : -1;
        for (int e = 0; e < NE; ++e) { const int sl = __shfl(myslot, e);
            if (sl >= 0) { const u32x2* yp = (const u32x2*)(YE + (size_t)sl * DM) + lane;
#pragma unroll
                for (int j = 0; j < 4; ++j) { const u32x2 y2 = yp[64 * j]; v[j].x += bflo(y2.x); v[j].y += bfhi(y2.x); v[j].z += bflo(y2.y); v[j].w += bfhi(y2.y); } } }
        float s = 0.f;
#pragma unroll
        for (int j = 0; j < 4; ++j) s += (v[j].x * v[j].x + v[j].y * v[j].y) + (v[j].z * v[j].z + v[j].w * v[j].w);
        const float rstd = 1.f / sqrtf(wave_sum(s) * (1.f / DM) + RMS_EPS);
#pragma unroll
        for (int j = 0; j < 4; ++j) { const f32x4 gg = gr[64 * j]; xr[64 * j] = v[j] * rstd * gg; }
    }
}
constexpr int LP = 72;
constexpr int RB = 64 * LP * 2;
#define RWBUF(n) ((LAS bf16_t*)(lds + (n) * RB))

__device__ __forceinline__ void mm64(const LAS bf16_t* A, const LAS bf16_t* Bt, f32x4 (&acc)[2], int wid, int fr, int fq) {
    const int rt = wid >> 1, ct0 = 2 * (wid & 1);
#pragma unroll
    for (int s = 0; s < 2; ++s) {
        const bf16x8 af = *(const LAS bf16x8*)(A + (16 * rt + fr) * LP + 32 * s + 8 * fq);
#pragma unroll
        for (int c = 0; c < 2; ++c) { const bf16x8 bfrag = *(const LAS bf16x8*)(Bt + (16 * (ct0 + c) + fr) * LP + 32 * s + 8 * fq);
            acc[c] = __builtin_amdgcn_mfma_f32_16x16x32_bf16(af, bfrag, acc[c], 0, 0, 0); }
    }
}
__device__ __forceinline__ void zero2(f32x4 (&acc)[2]) { acc[0] = (f32x4){0.f, 0.f, 0.f, 0.f}; acc[1] = acc[0]; }
template <int MASK> __device__ __forceinline__ void mask2(f32x4 (&acc)[2], int wid, int fr, int fq) {
    if (MASK == 0) return;
    const int rt = wid >> 1, ct0 = 2 * (wid & 1);
#pragma unroll
    for (int c = 0; c < 2; ++c)
#pragma unroll
        for (int g = 0; g < 4; ++g) { const int row = 16 * rt + 4 * fq + g, col = 16 * (ct0 + c) + fr; const bool keep = (MASK == 1) ? (row > col) : (row >= col); if (!keep) acc[c][g] = 0.f; }
}
__device__ __forceinline__ void store_rm(LAS bf16_t* D, const f32x4 (&acc)[2], int wid, int fr, int fq) {
    const int rt = wid >> 1, ct0 = 2 * (wid & 1);
#pragma unroll
    for (int c = 0; c < 2; ++c)
#pragma unroll
        for (int g = 0; g < 4; ++g) D[(16 * rt + 4 * fq + g) * LP + 16 * (ct0 + c) + fr] = f2bf(acc[c][g]);
}
__device__ __forceinline__ void store_tr(LAS bf16_t* D, const f32x4 (&acc)[2], int wid, int fr, int fq) {
    const int rt = wid >> 1, ct0 = 2 * (wid & 1);
#pragma unroll
    for (int c = 0; c < 2; ++c) { u32x2 w; w.x = cvtpk(acc[c][0], acc[c][1]); w.y = cvtpk(acc[c][2], acc[c][3]); *(LAS u32x2*)(D + (16 * (ct0 + c) + fr) * LP + 16 * rt + 4 * fq) = w; }
}
__device__ __forceinline__ int afrag_index(int row, int k) {
    const int tile = row >> 4, fr = row & 15, s = k >> 5, j = 4 * ((k >> 4) & 1) + (k & 3), fq = (k >> 2) & 3;
    return ((tile * 2 + s) * 64 + fq * 16 + fr) * 8 + j;
}
__device__ __forceinline__ int nfrag_index(int v, int k) { const int vg = v >> 4, fr = v & 15, kt = k >> 4, fq = (k >> 2) & 3, reg = k & 3; return ((vg * 64 + fq * 16 + fr) * 16) + kt * 4 + reg; }

__device__ __forceinline__ int scan_tok(int d, int c, int i) { const int p = 64 * c + i; return d ? (SEQ - 1 - p) : p; }

__device__ __forceinline__ void rwkv_chunk_unit(const Args& a, LAS unsigned char* lds, int unit, int tid) {
    const int c = unit & 127, h = (unit >> 7) % RWH, db = unit / (128 * RWH), b = db & 3, d = db >> 2;
    const int wid = __builtin_amdgcn_readfirstlane(tid >> 6), lane = tid & 63, fr = lane & 15, fq = lane >> 4;
    const int i = tid >> 3, jq = tid & 7, ch0 = h * 64 + jq * 8;
    const bf16_t* P = (const bf16_t*)(a.ws + WS_P);
    const int s_cur = scan_tok(d, c, i); const bool has_prev = !(c == 0 && i == 0); const int s_prev = d ? s_cur + 1 : s_cur - 1;
    const size_t tok = (size_t)b * SEQ + s_cur, tokp = (size_t)b * SEQ + (has_prev ? s_prev : s_cur);
    LAS bf16_t *AT = RWBUF(0), *RT = RWBUF(1), *BT = RWBUF(2), *KT = RWBUF(3), *ATc = RWBUF(4), *VTc = RWBUF(5), *KHc = RWBUF(6), *BHc = RWBUF(7);
    LAS bf16_t *L0 = RWBUF(8), *L0T = RWBUF(9), *AAK = RWBUF(10), *ARB = RWBUF(11), *ARK = RWBUF(12), *T2 = RWBUF(13);
    LAS bf16_t *XTc = RWBUF(2), *L1 = RWBUF(3), *L1T = RWBUF(0), *T1 = RWBUF(10), *ABc = RWBUF(8), *UBc = RWBUF(9);
    LAS bf16_t *X1 = RWBUF(8), *X2 = RWBUF(9), *W2s = RWBUF(10), *A2s = RWBUF(11);
    LAS float *WPf = (LAS float*)(lds + 12 * RB), *APf = (LAS float*)(lds + 0 * RB), *Ef = (LAS float*)(lds + 2 * RB), *TOT = (LAS float*)(lds + 4 * RB);
    float pr[8], pk[8], pv[8], tmp[8], mu[8];
    {   float cur[8], prv[8];
        unpack8(*(const u32x4*)(P + tok * PW + C_LW + jq * 8), cur); unpack8(*(const u32x4*)(P + tokp * PW + C_LW + jq * 8), prv); ld8f(a.in[I_MUW] + d * 64 + jq * 8, mu);
#pragma unroll
        for (int j = 0; j < 8; ++j) { const float sh = has_prev ? prv[j] : 0.f; tmp[j] = tanhf(cur[j] + (sh - cur[j]) * mu[j]); }
        *(LAS u32x4*)(X1 + i * LP + jq * 8) = pack8(tmp);
        unpack8(*(const u32x4*)(P + tok * PW + C_LA + jq * 8), cur); unpack8(*(const u32x4*)(P + tokp * PW + C_LA + jq * 8), prv); ld8f(a.in[I_MUA] + d * 64 + jq * 8, mu);
#pragma unroll
        for (int j = 0; j < 8; ++j) { const float sh = has_prev ? prv[j] : 0.f; tmp[j] = cur[j] + (sh - cur[j]) * mu[j]; }
        *(LAS u32x4*)(X2 + i * LP + jq * 8) = pack8(tmp);
        *(LAS u32x4*)(W2s + i * LP + jq * 8) = *(const u32x4*)((const bf16_t*)(a.ws + WS_W2T) + ((size_t)d * 384 + h * 64 + i) * 64 + jq * 8);
        *(LAS u32x4*)(A2s + i * LP + jq * 8) = *(const u32x4*)((const bf16_t*)(a.ws + WS_A2T) + ((size_t)d * 384 + h * 64 + i) * 64 + jq * 8);
        unpack8(*(const u32x4*)(P + tok * PW + C_PR + ch0), cur); unpack8(*(const u32x4*)(P + tokp * PW + C_PR + ch0), prv); ld8f(a.in[I_MURKV] + (d * 3 + 0) * 384 + ch0, mu);
#pragma unroll
        for (int j = 0; j < 8; ++j) { const float sh = has_prev ? prv[j] : 0.f; pr[j] = cur[j] + (sh - cur[j]) * mu[j]; }
        unpack8(*(const u32x4*)(P + tok * PW + C_PK + ch0), cur); unpack8(*(const u32x4*)(P + tokp * PW + C_PK + ch0), prv); ld8f(a.in[I_MURKV] + (d * 3 + 1) * 384 + ch0, mu);
#pragma unroll
        for (int j = 0; j < 8; ++j) { const float sh = has_prev ? prv[j] : 0.f; pk[j] = cur[j] + (sh - cur[j]) * mu[j]; }
        unpack8(*(const u32x4*)(P + tok * PW + C_PV + ch0), cur); unpack8(*(const u32x4*)(P + tokp * PW + C_PV + ch0), prv); ld8f(a.in[I_MURKV] + (d * 3 + 2) * 384 + ch0, mu);
#pragma unroll
        for (int j = 0; j < 8; ++j) { const float sh = has_prev ? prv[j] : 0.f; pv[j] = cur[j] + (sh - cur[j]) * mu[j]; }
    }
    __syncthreads();
    {   f32x4 acc[2]; const int rt = wid >> 1, ct0 = 2 * (wid & 1);
        zero2(acc); mm64(X1, W2s, acc, wid, fr, fq);
#pragma unroll
        for (int cc = 0; cc < 2; ++cc)
#pragma unroll
            for (int g = 0; g < 4; ++g) WPf[(16 * rt + 4 * fq + g) * 64 + 16 * (ct0 + cc) + fr] = acc[cc][g];
        zero2(acc); mm64(X2, A2s, acc, wid, fr, fq);
#pragma unroll
        for (int cc = 0; cc < 2; ++cc)
#pragma unroll
            for (int g = 0; g < 4; ++g) APf[(16 * rt + 4 * fq + g) * 64 + 16 * (ct0 + cc) + fr] = acc[cc][g];
    }
    __syncthreads();
    float ev[8], ah[8], kk[8], kp[8];
    {   float w0[8], a0[8], kkw[8], kaw[8], wp[8], ap[8];
        ld8f(a.in[I_W0] + d * 384 + ch0, w0); ld8f(a.in[I_A0] + d * 384 + ch0, a0); ld8f(a.in[I_KK] + ch0, kkw); ld8f(a.in[I_KA] + ch0, kaw);
        { const f32x4 x0 = *(const LAS f32x4*)(WPf + i * 64 + jq * 8), x1 = *(const LAS f32x4*)(WPf + i * 64 + jq * 8 + 4); wp[0] = x0.x; wp[1] = x0.y; wp[2] = x0.z; wp[3] = x0.w; wp[4] = x1.x; wp[5] = x1.y; wp[6] = x1.z; wp[7] = x1.w; }
        { const f32x4 x0 = *(const LAS f32x4*)(APf + i * 64 + jq * 8), x1 = *(const LAS f32x4*)(APf + i * 64 + jq * 8 + 4); ap[0] = x0.x; ap[1] = x0.y; ap[2] = x0.z; ap[3] = x0.w; ap[4] = x1.x; ap[5] = x1.y; ap[6] = x1.z; ap[7] = x1.w; }
        float ss = 0.f;
#pragma unroll
        for (int j = 0; j < 8; ++j) {
            const float z = -(w0[j] + wp[j]);
            const float sp = (z > 20.f) ? z : log1pf(__expf(z));
            ev[j] = __expf(-sp - 0.5f);
            ah[j] = sigmoidf_(a0[j] + ap[j]);
            kk[j] = pk[j] * kkw[j]; ss += kk[j] * kk[j];
            kp[j] = pk[j] * (1.f + (ah[j] - 1.f) * kaw[j]);
        }
        ss += __shfl_xor(ss, 1); ss += __shfl_xor(ss, 2); ss += __shfl_xor(ss, 4);
        const float inv = 1.f / fmaxf(sqrtf(ss), 1e-12f);
#pragma unroll
        for (int j = 0; j < 8; ++j) kk[j] *= inv;
    }
    __syncthreads();
    *(LAS f32x4*)(Ef + i * 64 + jq * 8) = (f32x4){ev[0], ev[1], ev[2], ev[3]}; *(LAS f32x4*)(Ef + i * 64 + jq * 8 + 4) = (f32x4){ev[4], ev[5], ev[6], ev[7]};
    __syncthreads();
    {
        const int j = tid & 63, tq = tid >> 6; float run = 0.f;
#pragma unroll
        for (int s = 0; s < 8; ++s) { run += Ef[(tq * 8 + s) * 64 + j]; Ef[(tq * 8 + s) * 64 + j] = run; }
        TOT[tq * 64 + j] = run;
    }
    __syncthreads();
    float G[8], G63[8];
    {   const f32x4 x0 = *(const LAS f32x4*)(Ef + i * 64 + jq * 8), x1 = *(const LAS f32x4*)(Ef + i * 64 + jq * 8 + 4);
        G[0] = x0.x; G[1] = x0.y; G[2] = x0.z; G[3] = x0.w; G[4] = x1.x; G[5] = x1.y; G[6] = x1.z; G[7] = x1.w;
#pragma unroll
        for (int j = 0; j < 8; ++j) G63[j] = 0.f;
        const int tq = i >> 3;
#pragma unroll
        for (int q = 0; q < 8; ++q) { const f32x4 t0 = *(const LAS f32x4*)(TOT + q * 64 + jq * 8), t1 = *(const LAS f32x4*)(TOT + q * 64 + jq * 8 + 4);
            const float tt[8] = {t0.x, t0.y, t0.z, t0.w, t1.x, t1.y, t1.z, t1.w};
#pragma unroll
            for (int j = 0; j < 8; ++j) { G63[j] += tt[j]; if (q < tq) G[j] += tt[j]; } }
    }
    __syncthreads();
    {   float at[8], rt_[8], bt[8], kt[8], bh[8], kh[8];
#pragma unroll
        for (int j = 0; j < 8; ++j) {
            const float gi = __expf(-G[j]), gpi = __expf(-(G[j] - ev[j])), ig = __expf(G[j]), gc = __expf(-(G63[j] - G[j]));
            const float bb = kk[j] * ah[j];
            at[j] = -kk[j] * gpi; rt_[j] = pr[j] * gi; bt[j] = bb * ig; kt[j] = kp[j] * ig; bh[j] = bb * gc; kh[j] = kp[j] * gc;
        }
        *(LAS u32x4*)(AT + i * LP + jq * 8) = pack8(at); *(LAS u32x4*)(RT + i * LP + jq * 8) = pack8(rt_);
        *(LAS u32x4*)(BT + i * LP + jq * 8) = pack8(bt); *(LAS u32x4*)(KT + i * LP + jq * 8) = pack8(kt);
#pragma unroll
        for (int j = 0; j < 8; ++j) { const int cj = jq * 8 + j; ATc[cj * LP + i] = f2bf(at[j]); VTc[cj * LP + i] = f2bf(pv[j]); KHc[cj * LP + i] = f2bf(kh[j]); BHc[cj * LP + i] = f2bf(bh[j]); }
        if (i == 0) { float* RG = (float*)((unsigned char*)a.out + DO_RG) + (size_t)unit * 64 + jq * 8;
            *(f32x4*)RG = (f32x4){__expf(-G63[0]), __expf(-G63[1]), __expf(-G63[2]), __expf(-G63[3])}; *(f32x4*)(RG + 4) = (f32x4){__expf(-G63[4]), __expf(-G63[5]), __expf(-G63[6]), __expf(-G63[7])}; }
    }
    __syncthreads();
    f32x4 acc[2];
    zero2(acc); mm64(AT, BT, acc, wid, fr, fq); mask2<1>(acc, wid, fr, fq); store_rm(L0, acc, wid, fr, fq); store_tr(L0T, acc, wid, fr, fq);
    zero2(acc); mm64(AT, KT, acc, wid, fr, fq); mask2<1>(acc, wid, fr, fq); store_rm(AAK, acc, wid, fr, fq);
    zero2(acc); mm64(RT, BT, acc, wid, fr, fq); mask2<2>(acc, wid, fr, fq); store_rm(ARB, acc, wid, fr, fq);
    zero2(acc); mm64(RT, KT, acc, wid, fr, fq); mask2<2>(acc, wid, fr, fq); store_rm(ARK, acc, wid, fr, fq);
    __syncthreads();
    zero2(acc); mm64(AAK, VTc, acc, wid, fr, fq); store_tr(XTc, acc, wid, fr, fq);
    zero2(acc); mm64(L0, L0T, acc, wid, fr, fq); store_rm(L1, acc, wid, fr, fq); store_tr(L1T, acc, wid, fr, fq);
    __syncthreads();
    {   const int rt = wid >> 1, ct0 = 2 * (wid & 1);
#pragma unroll
        for (int cc = 0; cc < 2; ++cc)
#pragma unroll
            for (int g = 0; g < 4; ++g) { const int row = 16 * rt + 4 * fq + g, col = 16 * (ct0 + cc) + fr; const float v = bf2f(L0[row * LP + col]) + (row == col ? 1.f : 0.f); T1[row * LP + col] = f2bf(v); }
    }
    __syncthreads();
    {   LAS bf16_t *Lc = L1, *LcT = L1T, *Ln = L0, *LnT = L0T, *Tc = T1, *Tn = T2;
        const int rt = wid >> 1, ct0 = 2 * (wid & 1);
#pragma unroll 1
        for (int p = 1; p <= 5; ++p) {
#pragma unroll
            for (int cc = 0; cc < 2; ++cc)
#pragma unroll
                for (int g = 0; g < 4; ++g) acc[cc][g] = bf2f(Tc[(16 * rt + 4 * fq + g) * LP + 16 * (ct0 + cc) + fr]);
            mm64(Tc, LcT, acc, wid, fr, fq); store_rm(Tn, acc, wid, fr, fq);
            if (p < 5) { f32x4 a2[2]; zero2(a2); mm64(Lc, LcT, a2, wid, fr, fq); store_rm(Ln, a2, wid, fr, fq); store_tr(LnT, a2, wid, fr, fq); }
            __syncthreads();
            LAS bf16_t* t; t = Lc; Lc = Ln; Ln = t; t = LcT; LcT = LnT; LnT = t; t = Tc; Tc = Tn; Tn = t;
        }
    }
    LAS bf16_t* TF = T2;
    zero2(acc); mm64(TF, ATc, acc, wid, fr, fq); store_tr(ABc, acc, wid, fr, fq);
    zero2(acc); mm64(TF, XTc, acc, wid, fr, fq); store_tr(UBc, acc, wid, fr, fq);
    __syncthreads();
    {   const int rt = wid >> 1, ct0 = 2 * (wid & 1);
        bf16_t* RM = (bf16_t*)((unsigned char*)a.out + DO_RM) + (size_t)unit * 4096;
        zero2(acc); mm64(BHc, ABc, acc, wid, fr, fq);
#pragma unroll
        for (int cc = 0; cc < 2; ++cc)
#pragma unroll
            for (int g = 0; g < 4; ++g) RM[afrag_index(16 * rt + 4 * fq + g, 16 * (ct0 + cc) + fr)] = f2bf(acc[cc][g]);
        bf16_t* RN = (bf16_t*)(a.ws + WS_RN) + (size_t)unit * 4096;
        zero2(acc); mm64(VTc, KHc, acc, wid, fr, fq); mm64(UBc, BHc, acc, wid, fr, fq);
#pragma unroll
        for (int cc = 0; cc < 2; ++cc)
#pragma unroll
            for (int g = 0; g < 4; ++g) RN[nfrag_index(16 * rt + 4 * fq + g, 16 * (ct0 + cc) + fr)] = f2bf(acc[cc][g]);
        bf16_t* RR = (bf16_t*)((unsigned char*)a.out + DO_RR) + (size_t)unit * 4096;
#pragma unroll
        for (int cc = 0; cc < 2; ++cc)
#pragma unroll
            for (int g = 0; g < 4; ++g) acc[cc][g] = bf2f(RT[(16 * rt + 4 * fq + g) * LP + 16 * (ct0 + cc) + fr]);
        mm64(ARB, ABc, acc, wid, fr, fq);
#pragma unroll
        for (int cc = 0; cc < 2; ++cc)
#pragma unroll
            for (int g = 0; g < 4; ++g) RR[afrag_index(16 * rt + 4 * fq + g, 16 * (ct0 + cc) + fr)] = f2bf(acc[cc][g]);
        bf16_t* Y = (bf16_t*)(a.ws + (d ? WS_YB : WS_YRW));
        zero2(acc); mm64(ARB, UBc, acc, wid, fr, fq); mm64(ARK, VTc, acc, wid, fr, fq);
#pragma unroll
        for (int cc = 0; cc < 2; ++cc)
#pragma unroll
            for (int g = 0; g < 4; ++g) { const int ti = 16 * rt + 4 * fq + g, v = 16 * (ct0 + cc) + fr; Y[((size_t)b * SEQ + scan_tok(d, c, ti)) * RWW + h * 64 + v] = f2bf(acc[cc][g]); }
    }
    __syncthreads();
}

__device__ __forceinline__ void rwkv_state_pass(const Args& a, int task, int lane) {
    const int vg = task & 3, chain = task >> 2, h = chain % RWH, db = chain / RWH, b = db & 3, d = db >> 2;
    const int fr = lane & 15, fq = lane >> 4;
    const bf16_t* RM = (const bf16_t*)((const unsigned char*)a.out + DO_RM); const bf16_t* RR = (const bf16_t*)((const unsigned char*)a.out + DO_RR);
    const float* RG = (const float*)((const unsigned char*)a.out + DO_RG); const bf16_t* RN = (const bf16_t*)(a.ws + WS_RN);
    bf16_t* Y = (bf16_t*)(a.ws + (d ? WS_YB : WS_YRW));
    f32x4 S[4];
#pragma unroll
    for (int kt = 0; kt < 4; ++kt) S[kt] = (f32x4){0.f, 0.f, 0.f, 0.f};
#pragma unroll 1
    for (int c = 0; c < NCH; ++c) {
        const size_t unit = (size_t)chain * NCH + c;
        const bf16x8* mp = (const bf16x8*)(RM + unit * 4096) + lane; const bf16x8* rp = (const bf16x8*)(RR + unit * 4096) + lane;
        bf16x8 mf[4][2], rf[4][2];
#pragma unroll
        for (int t4 = 0; t4 < 4; ++t4)
#pragma unroll
            for (int s = 0; s < 2; ++s) { mf[t4][s] = mp[(t4 * 2 + s) * 64]; rf[t4][s] = rp[(t4 * 2 + s) * 64]; }
        const u32x4* np = (const u32x4*)(RN + unit * 4096 + (size_t)(vg * 64 + lane) * 16); const u32x4 n0 = np[0], n1 = np[1];
        f32x4 gm4[4];
#pragma unroll
        for (int kt = 0; kt < 4; ++kt) gm4[kt] = *(const f32x4*)(RG + unit * 64 + 16 * kt + 4 * fq);
        bf16x8 bs[2];
#pragma unroll
        for (int s = 0; s < 2; ++s) { u32x4 w; w.x = cvtpk(S[2 * s][0], S[2 * s][1]); w.y = cvtpk(S[2 * s][2], S[2 * s][3]); w.z = cvtpk(S[2 * s + 1][0], S[2 * s + 1][1]); w.w = cvtpk(S[2 * s + 1][2], S[2 * s + 1][3]); bs[s] = __builtin_bit_cast(bf16x8, w); }
#pragma unroll
        for (int tt = 0; tt < 4; ++tt) { f32x4 ya = (f32x4){0.f, 0.f, 0.f, 0.f};
            ya = __builtin_amdgcn_mfma_f32_16x16x32_bf16(rf[tt][0], bs[0], ya, 0, 0, 0); ya = __builtin_amdgcn_mfma_f32_16x16x32_bf16(rf[tt][1], bs[1], ya, 0, 0, 0);
#pragma unroll
            for (int g = 0; g < 4; ++g) { bf16_t* yp = Y + ((size_t)b * SEQ + scan_tok(d, c, 16 * tt + 4 * fq + g)) * RWW + h * 64 + 16 * vg + fr; *yp = f2bf(ya[g] + bf2f(*yp)); } }
        const float nv[16] = {bflo(n0.x), bfhi(n0.x), bflo(n0.y), bfhi(n0.y), bflo(n0.z), bfhi(n0.z), bflo(n0.w), bfhi(n0.w), bflo(n1.x), bfhi(n1.x), bflo(n1.y), bfhi(n1.y), bflo(n1.z), bfhi(n1.z), bflo(n1.w), bfhi(n1.w)};
#pragma unroll
        for (int kt = 0; kt < 4; ++kt) { f32x4 na;
#pragma unroll
            for (int g = 0; g < 4; ++g) na[g] = S[kt][g] * gm4[kt][g] + nv[kt * 4 + g];
            na = __builtin_amdgcn_mfma_f32_16x16x32_bf16(mf[kt][0], bs[0], na, 0, 0, 0); na = __builtin_amdgcn_mfma_f32_16x16x32_bf16(mf[kt][1], bs[1], na, 0, 0, 0);
            S[kt] = na; }
    }
}

__device__ __forceinline__ void rwkv_final_unit(const Args& a, LAS unsigned char* lds, int unit, int tid) {
    const int tc = unit & 127, h = (unit >> 7) % RWH, b = unit / (128 * RWH);
    const int wid = __builtin_amdgcn_readfirstlane(tid >> 6), lane = tid & 63, fr = lane & 15, fq = lane >> 4;
    const int i = tid >> 3, jq = tid & 7, ch0 = h * 64 + jq * 8;
    const bf16_t* P = (const bf16_t*)(a.ws + WS_P);
    const int s_cur = tc * 64 + i; const size_t tok = (size_t)b * SEQ + s_cur;
    LAS bf16_t *XA0 = RWBUF(0), *XA1 = RWBUF(1), *A2s0 = RWBUF(2), *A2s1 = RWBUF(3);
    LAS bf16_t *XG = (LAS bf16_t*)(lds + 4 * RB);
    LAS bf16_t *G2s = (LAS bf16_t*)(lds + 4 * RB + 64 * 136 * 2);
    LAS float *AP0 = (LAS float*)(lds + 8 * RB), *AP1 = (LAS float*)(lds + 8 * RB + 16384), *GP = (LAS float*)(lds + 8 * RB + 32768);
    float r_[2][8], k_[2][8], v_[2][8];
    {   float cur[8], nb[8], mu[8], tmp[8];
#pragma unroll
        for (int d = 0; d < 2; ++d) {
            const bool has = d ? (s_cur < SEQ - 1) : (s_cur > 0); const size_t tokp = has ? (d ? tok + 1 : tok - 1) : tok;
            unpack8(*(const u32x4*)(P + tok * PW + C_LA + jq * 8), cur); unpack8(*(const u32x4*)(P + tokp * PW + C_LA + jq * 8), nb); ld8f(a.in[I_MUA] + d * 64 + jq * 8, mu);
#pragma unroll
            for (int j = 0; j < 8; ++j) { const float sh = has ? nb[j] : 0.f; tmp[j] = cur[j] + (sh - cur[j]) * mu[j]; }
            *(LAS u32x4*)((d ? XA1 : XA0) + i * LP + jq * 8) = pack8(tmp); __builtin_amdgcn_sched_barrier(0);
            *(LAS u32x4*)((d ? A2s1 : A2s0) + i * LP + jq * 8) = *(const u32x4*)((const bf16_t*)(a.ws + WS_A2T) + ((size_t)d * 384 + h * 64 + i) * 64 + jq * 8);
            unpack8(*(const u32x4*)(P + tok * PW + C_PR + ch0), cur); unpack8(*(const u32x4*)(P + tokp * PW + C_PR + ch0), nb); ld8f(a.in[I_MURKV] + (d * 3 + 0) * 384 + ch0, mu);
#pragma unroll
            for (int j = 0; j < 8; ++j) { const float sh = has ? nb[j] : 0.f; r_[d][j] = cur[j] + (sh - cur[j]) * mu[j]; }
            __builtin_amdgcn_sched_barrier(0);
            unpack8(*(const u32x4*)(P + tok * PW + C_PK + ch0), cur); unpack8(*(const u32x4*)(P + tokp * PW + C_PK + ch0), nb); ld8f(a.in[I_MURKV] + (d * 3 + 1) * 384 + ch0, mu);
#pragma unroll
            for (int j = 0; j < 8; ++j) { const float sh = has ? nb[j] : 0.f; k_[d][j] = cur[j] + (sh - cur[j]) * mu[j]; }
            __builtin_amdgcn_sched_barrier(0);
            unpack8(*(const u32x4*)(P + tok * PW + C_PV + ch0), cur); unpack8(*(const u32x4*)(P + tokp * PW + C_PV + ch0), nb); ld8f(a.in[I_MURKV] + (d * 3 + 2) * 384 + ch0, mu);
#pragma unroll
            for (int j = 0; j < 8; ++j) { const float sh = has ? nb[j] : 0.f; v_[d][j] = cur[j] + (sh - cur[j]) * mu[j]; }
            __builtin_amdgcn_sched_barrier(0);
        }
#pragma unroll
        for (int q = 0; q < 2; ++q) {
            unpack8(*(const u32x4*)(P + tok * PW + C_LG + jq * 16 + q * 8), cur);
#pragma unroll
            for (int j = 0; j < 8; ++j) tmp[j] = sigmoidf_(cur[j]);
            *(LAS u32x4*)(XG + i * 136 + jq * 16 + q * 8) = pack8(tmp); __builtin_amdgcn_sched_barrier(0);
            *(LAS u32x4*)(G2s + i * 136 + jq * 16 + q * 8) = *(const u32x4*)((const bf16_t*)(a.ws + WS_G2T) + ((size_t)h * 64 + i) * 128 + jq * 16 + q * 8);
        }
    }
    __syncthreads();
    {   f32x4 acc[2]; const int rt = wid >> 1, ct0 = 2 * (wid & 1);
        zero2(acc); mm64(XA0, A2s0, acc, wid, fr, fq);
#pragma unroll
        for (int cc = 0; cc < 2; ++cc)
#pragma unroll
            for (int g = 0; g < 4; ++g) AP0[(16 * rt + 4 * fq + g) * 64 + 16 * (ct0 + cc) + fr] = acc[cc][g];
        zero2(acc); mm64(XA1, A2s1, acc, wid, fr, fq);
#pragma unroll
        for (int cc = 0; cc < 2; ++cc)
#pragma unroll
            for (int g = 0; g < 4; ++g) AP1[(16 * rt + 4 * fq + g) * 64 + 16 * (ct0 + cc) + fr] = acc[cc][g];
        zero2(acc);
#pragma unroll
        for (int s = 0; s < 4; ++s) { const bf16x8 af = *(const LAS bf16x8*)(XG + (16 * rt + fr) * 136 + 32 * s + 8 * fq);
#pragma unroll
            for (int cc = 0; cc < 2; ++cc) { const bf16x8 bfrag = *(const LAS bf16x8*)(G2s + (16 * (ct0 + cc) + fr) * 136 + 32 * s + 8 * fq); acc[cc] = __builtin_amdgcn_mfma_f32_16x16x32_bf16(af, bfrag, acc[cc], 0, 0, 0); } }
#pragma unroll
        for (int cc = 0; cc < 2; ++cc)
#pragma unroll
            for (int g = 0; g < 4; ++g) GP[(16 * rt + 4 * fq + g) * 64 + 16 * (ct0 + cc) + fr] = acc[cc][g];
    }
    __syncthreads();
    {   float bonus[8], rk[8], kaw[8], a0[8], ap[8];
#pragma unroll
        for (int j = 0; j < 8; ++j) bonus[j] = 0.f;
        ld8f(a.in[I_RK] + ch0, rk); ld8f(a.in[I_KA] + ch0, kaw);
#pragma unroll
        for (int d = 0; d < 2; ++d) {
            ld8f(a.in[I_A0] + d * 384 + ch0, a0);
            const LAS float* APd = d ? AP1 : AP0;
            { const f32x4 x0 = *(const LAS f32x4*)(APd + i * 64 + jq * 8), x1 = *(const LAS f32x4*)(APd + i * 64 + jq * 8 + 4); ap[0] = x0.x; ap[1] = x0.y; ap[2] = x0.z; ap[3] = x0.w; ap[4] = x1.x; ap[5] = x1.y; ap[6] = x1.z; ap[7] = x1.w; }
            float dot = 0.f;
#pragma unroll
            for (int j = 0; j < 8; ++j) { const float ahv = sigmoidf_(a0[j] + ap[j]); const float kp = k_[d][j] * (1.f + (ahv - 1.f) * kaw[j]); dot += r_[d][j] * kp * rk[j]; }
            dot += __shfl_xor(dot, 1); dot += __shfl_xor(dot, 2); dot += __shfl_xor(dot, 4);
#pragma unroll
            for (int j = 0; j < 8; ++j) bonus[j] += dot * v_[d][j];
        }
        float yf[8], yb[8], ys[8], lng[8], lnb[8], gg[8];
        bf16_t* YF = (bf16_t*)(a.ws + WS_YRW) + tok * RWW + ch0; const bf16_t* YBp = (const bf16_t*)(a.ws + WS_YB) + tok * RWW + ch0;
        unpack8(*(const u32x4*)YF, yf); unpack8(*(const u32x4*)YBp, yb); ld8f(a.in[I_LNG] + ch0, lng); ld8f(a.in[I_LNB] + ch0, lnb);
        { const f32x4 x0 = *(const LAS f32x4*)(GP + i * 64 + jq * 8), x1 = *(const LAS f32x4*)(GP + i * 64 + jq * 8 + 4); gg[0] = x0.x; gg[1] = x0.y; gg[2] = x0.z; gg[3] = x0.w; gg[4] = x1.x; gg[5] = x1.y; gg[6] = x1.z; gg[7] = x1.w; }
        float sm = 0.f;
#pragma unroll
        for (int j = 0; j < 8; ++j) { ys[j] = yf[j] + yb[j]; sm += ys[j]; }
        sm += __shfl_xor(sm, 1); sm += __shfl_xor(sm, 2); sm += __shfl_xor(sm, 4);
        const float mean = sm * (1.f / 64.f); float vs = 0.f;
#pragma unroll
        for (int j = 0; j < 8; ++j) { const float dd = ys[j] - mean; vs += dd * dd; }
        vs += __shfl_xor(vs, 1); vs += __shfl_xor(vs, 2); vs += __shfl_xor(vs, 4);
        const float rstd = 1.f / sqrtf(vs * (1.f / 64.f) + GN_EPS);
        float o[8];
#pragma unroll
        for (int j = 0; j < 8; ++j) o[j] = ((ys[j] - mean) * rstd * lng[j] + lnb[j] + bonus[j]) * gg[j];
        *(u32x4*)YF = pack8(o);
    }
    __syncthreads();
}
#ifndef ONE_LAUNCH
#define ONE_LAUNCH 1
#endif
constexpr int NPHASE = 12;
#ifndef FUSED_MASK
#define FUSED_MASK 0xfff
#endif
typedef const __attribute__((address_space(4))) Args* KArgP;
#if defined(__HIP_DEVICE_COMPILE__)
__device__ __forceinline__ void load_args(Args& a) {
    KArgP ap_ = (KArgP)__builtin_amdgcn_kernarg_segment_ptr(); asm volatile("" : "+s"(ap_));
#pragma unroll
    for (int i = 0; i < 30; ++i) a.in[i] = ap_->in[i];
    a.out = ap_->out; a.ws = ap_->ws; a.ph_lo = 0; a.ph_hi = 0;
}
#define PHASE_ARGS Args a; load_args(a); unsigned char* ws = a.ws; (void)ws
#else
#define PHASE_ARGS const Args a = a_in; unsigned char* ws = a.ws; (void)ws
#endif
template <int PHM> __global__ void __launch_bounds__(NTHR, 2) fwd_kernel(Args a_in) {
    extern __shared__ __attribute__((aligned(16))) unsigned char lds_raw[];
    LAS unsigned char* lds = (LAS unsigned char*)lds_raw;
    const int tid = threadIdx.x, lane = tid & 63, wave = __builtin_amdgcn_readfirstlane(tid >> 6);
    const int G = gridDim.x, bx = blockIdx.x;
    const int ph_lo = a_in.ph_lo, ph_hi = a_in.ph_hi;
#if ONE_LAUNCH
    cg::grid_group grid = cg::this_grid();
#define SEAM(k) do { if ((k) + 1 < ph_hi) grid.sync(); } while (0)
#else
#define SEAM(k) do { } while (0)
#endif
#define IN(k) (((PHM >> (k)) & 1) && ph_lo <= (k) && (k) < ph_hi)
    if (IN(0)) { PHASE_ARGS; phase_prologue(a, lds, wave, lane); SEAM(0); }
    if (IN(1)) { PHASE_ARGS;
        SchedIn S{16, 2048u, 2048u, (const char*)(ws + WS_XN), (const char*)(ws + WS_WIN), (const char*)(ws + WS_MEMN), (const char*)(ws + WS_WMKV), G, bx};
        EpiIn E{(bf16_t*)(ws + WS_P), (bf16_t*)(ws + WS_G), (bf16_t*)(ws + WS_MKV)};
        gm::gemm_phase<EpiIn, SchedIn>(lds, S, E);
        SEAM(1);
    }
    if (IN(2)) { PHASE_ARGS;
        for (int u = bx; u < NB * GROWS * NAH; u += G) na_unit(a, lds, u, tid);
        for (int u = bx; u < NB * MEMH * 16; u += G) mem_unit(a, lds, u, tid);
        for (int u = bx; u < 2 * NB * RWH * NCH; u += G) rwkv_chunk_unit(a, lds, u, tid);
        SEAM(2);
    }
    if (IN(3)) { PHASE_ARGS;
        if (wave == 0) for (int t = bx; t < 2 * NB * RWH * 4; t += G) rwkv_state_pass(a, t, lane);
        SEAM(3);
    }
    if (IN(4)) { PHASE_ARGS;
        for (int u = bx; u < NB * RWH * NCH; u += G) rwkv_final_unit(a, lds, u, tid);
        SEAM(4);
    }
    if (IN(5)) { PHASE_ARGS;
        const bf16_t* WBR = (const bf16_t*)(ws + WS_WBR);
        { SchedMerge S{6, 768u, 768u, (const char*)(ws + WS_YNA), (const char*)WBR, G, bx}; EpiMerge E{(const bf16_t*)(ws + WS_G), (bf16_t*)(ws + WS_MERGED), 0}; gm::gemm_phase<EpiMerge, SchedMerge>(lds, S, E); }
        VM_WAIT(); __syncthreads();
        { SchedMerge S{6, 768u, 768u, (const char*)(ws + WS_YRW), (const char*)(WBR + 1024 * 384), G, bx}; EpiMerge E{(const bf16_t*)(ws + WS_G), (bf16_t*)(ws + WS_MERGED), 1}; gm::gemm_phase<EpiMerge, SchedMerge>(lds, S, E); }
        VM_WAIT(); __syncthreads();
        { SchedMerge S{4, 512u, 512u, (const char*)(ws + WS_YMEM), (const char*)(WBR + 2 * 1024 * 384), G, bx}; EpiMerge E{(const bf16_t*)(ws + WS_G), (bf16_t*)(ws + WS_MERGED), 2}; gm::gemm_phase<EpiMerge, SchedMerge>(lds, S, E); }
        SEAM(5);
    }
    if (IN(6)) { PHASE_ARGS;
        SchedOut S{16, 2048u, 2048u, (const char*)(ws + WS_MERGED), (const char*)(ws + WS_WOUT), G, bx}; EpiOut E{a.in[I_X], a.out};
        gm::gemm_phase<EpiOut, SchedOut>(lds, S, E);
        SEAM(6);
    }
    if (IN(7)) { PHASE_ARGS;
        {
            const f32x4* src = (const f32x4*)a.in[I_WROUTER]; LAS f32x4* dst = (LAS f32x4*)lds;
            for (int q = tid; q < DM * NE / 4; q += NTHR) dst[q] = src[q];
            __syncthreads();
        }
        phase_norm_router(a, lds, wave, lane);
        SEAM(7);
    }
    if (IN(8)) { PHASE_ARGS;
        if (bx < NB * NE) topk_unit(a, lds, bx, tid);
        expert_convert(a, lds, wave, lane, bx * NWAVES + wave, G * NWAVES);
        SEAM(8);
    }
    if (IN(9)) { PHASE_ARGS;
        SchedMoe1 S{16, 2048u, 2048u, (const char*)(ws + WS_XN), (const char*)(ws + WS_WGU), (const int*)(ws + WS_TIDX), G, bx}; EpiMoe1 E{(bf16_t*)(ws + WS_ACT)};
        gm::gemm_phase<EpiMoe1, SchedMoe1>(lds, S, E);
        SEAM(9);
    }
    if (IN(10)) { PHASE_ARGS;
        SchedMoe2 S{32, 4096u, 4096u, (const char*)(ws + WS_ACT), (const char*)(ws + WS_WD), G, bx}; EpiMoe2 E{(bf16_t*)(ws + WS_YE), (const float*)(ws + WS_TVAL)};
        gm::gemm_phase<EpiMoe2, SchedMoe2>(lds, S, E);
        SEAM(10);
    }
    if (IN(11)) { PHASE_ARGS; phase_final(a, wave, lane); }
#undef IN
#undef SEAM
}

template <int PHM> static bool prep_kernel(int& per_cu) {
    if (hipFuncSetAttribute((const void*)fwd_kernel<PHM>, hipFuncAttributeMaxDynamicSharedMemorySize, LDS_BYTES) != hipSuccess) return false;
    int pc = 0; if (hipOccupancyMaxActiveBlocksPerMultiprocessor(&pc, (const void*)fwd_kernel<PHM>, NTHR, LDS_BYTES) != hipSuccess) pc = 0;
    (void)hipGetLastError(); if (pc < per_cu) per_cu = pc; return true;
}
template <int P> static void launch_phase(int grid, Args a, hipStream_t stream) { a.ph_lo = P; a.ph_hi = P + 1; hipLaunchKernelGGL(fwd_kernel<(1 << P)>, dim3(grid), dim3(NTHR), LDS_BYTES, stream, a); }
extern "C" void kernel_launch(void* const* d_in, const int* in_sizes, int n_in, void* d_out, int out_size, void* d_ws, size_t ws_size, hipStream_t stream) {
    static int grid = 0;
    if (grid == 0) {
        if (n_in != 30 || out_size != T * DM || ws_size < WS_END) { fprintf(stderr, "kernel_launch: unexpected sizes: n_in %d out %d ws %zu (need %zu)\n", n_in, out_size, ws_size, (size_t)WS_END); grid = -1; return; }
        int dev = 0, cus = 0, per_cu = 99; bool ok = true;
        if (hipGetDevice(&dev) != hipSuccess || hipDeviceGetAttribute(&cus, hipDeviceAttributeMultiprocessorCount, dev) != hipSuccess) ok = false;
#if ONE_LAUNCH
        ok = ok && prep_kernel<FUSED_MASK>(per_cu);
#else
        ok = ok && prep_kernel<1>(per_cu) && prep_kernel<2>(per_cu) && prep_kernel<4>(per_cu) && prep_kernel<8>(per_cu) && prep_kernel<16>(per_cu) && prep_kernel<32>(per_cu) && prep_kernel<64>(per_cu)
                && prep_kernel<128>(per_cu) && prep_kernel<256>(per_cu) && prep_kernel<512>(per_cu) && prep_kernel<1024>(per_cu) && prep_kernel<2048>(per_cu);
#endif
        if (!ok || per_cu < 1) { fprintf(stderr, "kernel_launch: set-up failed (ok %d, per_cu %d)\n", (int)ok, per_cu); grid = -1; return; }
        grid = cus;
        fprintf(stderr, "kernel_launch: grid %d, per_cu %d, ws %zu\n", grid, per_cu, ws_size);
    }
    if (grid < 0) return;
    Args a{};
    for (int i = 0; i < 30; ++i) a.in[i] = (const float*)d_in[i];
    a.out = (float*)d_out; a.ws = (unsigned char*)d_ws;
#if ONE_LAUNCH
    a.ph_lo = 0; a.ph_hi = NPHASE;
    void* args[] = {&a};
    hipError_t e = hipLaunchCooperativeKernel((const void*)fwd_kernel<FUSED_MASK>, dim3(grid), dim3(NTHR), args, LDS_BYTES, stream);
    if (e != hipSuccess) fprintf(stderr, "cooperative launch failed: %s\n", hipGetErrorString(e));
#else
    launch_phase<0>(grid, a, stream); launch_phase<1>(grid, a, stream); launch_phase<2>(grid, a, stream); launch_phase<3>(grid, a, stream); launch_phase<4>(grid, a, stream); launch_phase<5>(grid, a, stream);
    launch_phase<6>(grid, a, stream); launch_phase<7>(grid, a, stream); launch_phase<8>(grid, a, stream); launch_phase<9>(grid, a, stream); launch_phase<10>(grid, a, stream); launch_phase<11>(grid, a, stream);
#endif
}
```

```cpp
#include <hip/hip_runtime.h>
#include <hip/hip_cooperative_groups.h>
#include <cstdio>
#include <cstdint>
namespace cg = cooperative_groups;

#define LAS __attribute__((address_space(3)))
typedef unsigned short bf16_t;
typedef short bf16x8 __attribute__((ext_vector_type(8)));
typedef short s16x4 __attribute__((ext_vector_type(4)));
typedef float f32x4 __attribute__((ext_vector_type(4)));
typedef float f32x2 __attribute__((ext_vector_type(2)));
typedef unsigned u32x4 __attribute__((ext_vector_type(4)));
typedef unsigned u32x2 __attribute__((ext_vector_type(2)));
typedef __bf16 bf16x2_t __attribute__((ext_vector_type(2)));

constexpr int DM = 1024, NB = 4, SEQ = 8192, T = NB * SEQ, GRIDW = 64, GROWS = SEQ / GRIDW, NMEM = 256, HD = 64;
constexpr int NAH = 6, NAW = 384, RWH = 6, RWW = 384, MEMH = 4, MEMW = 256, NE = 16, CAP = 1024, FF = 2048;
constexpr int DIN = 5888, PW = 2816, GWD = 3072;
constexpr int C_NAQ = 0, C_NAK = 384, C_NAV = 768, C_PR = 1152, C_PK = 1536, C_PV = 1920, C_LW = 2304, C_LA = 2368, C_LG = 2432, C_MQ = 2560;
constexpr int NCH = SEQ / 64;
constexpr float RMS_EPS = 1e-6f, GN_EPS = 64e-5f;

constexpr size_t MiB = (size_t)1 << 20;
constexpr size_t WS_CTL = 0;
constexpr size_t WS_W2T = 1 * MiB;
constexpr size_t WS_A2T = WS_W2T + 98304;
constexpr size_t WS_G2T = WS_A2T + 98304;
constexpr size_t WS_AFF = 2 * MiB;
constexpr size_t WS_TIDX = 4 * MiB;
constexpr size_t WS_TVAL = WS_TIDX + 262144;
constexpr size_t WS_SLOT = 5 * MiB;
constexpr size_t WS_WIN = 8 * MiB;
constexpr size_t WS_WBR = 20 * MiB;
constexpr size_t WS_WOUT = 22 * MiB;
constexpr size_t WS_WMKV = 24 * MiB;
constexpr size_t WS_MEMN = 25 * MiB;
constexpr size_t WS_MKV = 27 * MiB;
constexpr size_t WS_XN = 28 * MiB;
constexpr size_t WS_YNA = WS_XN, WS_YMEM = WS_XN + 24 * MiB, WS_YRW = WS_XN + 40 * MiB;
constexpr size_t WS_P = 92 * MiB;
constexpr size_t WS_G = 268 * MiB;
constexpr size_t WS_RN = 460 * MiB;
constexpr size_t WS_YB = 508 * MiB;
constexpr size_t WS_MERGED = 460 * MiB;
constexpr size_t WS_WGU = 92 * MiB;
constexpr size_t WS_WD = 220 * MiB;
constexpr size_t WS_ACT = 284 * MiB;
constexpr size_t WS_YE = 92 * MiB;
constexpr size_t WS_END = 540 * MiB;
constexpr size_t DO_RM = 0;
constexpr size_t DO_RR = 48 * MiB;
constexpr size_t DO_RG = 96 * MiB;

__device__ __forceinline__ unsigned cvtpk(float lo, float hi) { f32x2 v = {lo, hi}; bf16x2_t b = __builtin_convertvector(v, bf16x2_t); return __builtin_bit_cast(unsigned, b); }
__device__ __forceinline__ bf16_t f2bf(float f) { return (bf16_t)(cvtpk(f, 0.f) & 0xffffu); }
__device__ __forceinline__ float bf2f(unsigned h) { return __uint_as_float(h << 16); }
__device__ __forceinline__ float bflo(unsigned w) { return __uint_as_float(w << 16); }
__device__ __forceinline__ float bfhi(unsigned w) { return __uint_as_float(w & 0xffff0000u); }
__device__ __forceinline__ float wave_sum(float v) {
#pragma unroll
    for (int o = 1; o < 64; o <<= 1) v += __shfl_xor(v, o);
    return v;
}
__device__ __forceinline__ float sigmoidf_(float x) { return 1.f / (1.f + __expf(-x)); }
#define LDS_WAIT() asm volatile("s_waitcnt lgkmcnt(0)" ::: "memory")
#define VM_WAIT() asm volatile("s_waitcnt vmcnt(0)" ::: "memory")
__device__ __forceinline__ void unpack8(const u32x4 w, float (&o)[8]) { o[0] = bflo(w.x); o[1] = bfhi(w.x); o[2] = bflo(w.y); o[3] = bfhi(w.y); o[4] = bflo(w.z); o[5] = bfhi(w.z); o[6] = bflo(w.w); o[7] = bfhi(w.w); }
__device__ __forceinline__ u32x4 pack8(const float (&o)[8]) { u32x4 w; w.x = cvtpk(o[0], o[1]); w.y = cvtpk(o[2], o[3]); w.z = cvtpk(o[4], o[5]); w.w = cvtpk(o[6], o[7]); return w; }
__device__ __forceinline__ void ld8f(const float* p, float (&o)[8]) { const f32x4 a = *(const f32x4*)p, b = *(const f32x4*)(p + 4); o[0] = a.x; o[1] = a.y; o[2] = a.z; o[3] = a.w; o[4] = b.x; o[5] = b.y; o[6] = b.z; o[7] = b.w; }

namespace gm {
constexpr int BM = 256, BK = 64, HALF = 128, HTB = HALF * BK * 2  , STAGE_BYTES = 8 * HTB, NXCD = 8, WGM = 8;
__device__ __forceinline__ int lds_byte(int r, int c) { const int st = (r >> 4) * 2 + (c >> 5), rr = r & 15, cc = c & 31, ob = rr * 64 + cc * 2; return st * 1024 + (ob ^ (((ob >> 9) & 1) << 5)); }
__device__ __forceinline__ void stage_rc(int b, int& R, int& C) { const int st = b / 1024, sb = b % 1024, swz = sb ^ (((sb >> 9) & 1) << 5); R = (st >> 1) * 16 + swz / 64; C = (st & 1) * 32 + (swz % 64) / 2; }
__device__ __forceinline__ int perm32(int rho) { const int n = rho >> 4, i = rho & 15; return 8 * (i >> 2) + 4 * n + (i & 3); }

struct GUnit { const char* A; const char* B; const int* gidx; int pm, pn, aux; };

__device__ __forceinline__ void tile_of(int L, int nM, int nN, int& pm, int& pn) {
    const int nwg = nM * nN; int wgid = L;
    { const int q = nwg / NXCD, r = nwg % NXCD, xcd = wgid % NXCD, off = wgid / NXCD; wgid = (xcd < r ? xcd * (q + 1) : r * (q + 1) + (xcd - r) * q) + off; }
    const int nig = WGM * nN, gid = wgid / nig, fm = gid * WGM, gsz = (nM - fm) < WGM ? (nM - fm) : WGM;
    pm = fm + ((wgid % nig) % gsz); pn = (wgid % nig) / gsz;
}

template <class Epi, class Sched>
__device__ __forceinline__ void gemm_phase(LAS unsigned char* lds, const Sched& S, const Epi& E) {
    const int tid = threadIdx.x, wid = __builtin_amdgcn_readfirstlane(tid >> 6), lane = tid & 63, wr = wid >> 2, wc = wid & 3, fr = lane & 15, fq = lane >> 4;
    const int nt = S.nt;
    const unsigned lda2 = S.lda2, ldb2 = S.ldb2;
    int RA[2]; unsigned C2[2]; unsigned voffA[2], voffB[2];
#pragma unroll
    for (int i = 0; i < 2; ++i) { int R, C; stage_rc(tid * 16 + i * 8192, R, C); const int Rb = Epi::PERM ? ((R & ~31) + perm32(R & 31)) : R;
        RA[i] = R; C2[i] = (unsigned)C * 2u; voffA[i] = (unsigned)R * lda2 + C2[i]; voffB[i] = (unsigned)Rb * ldb2 + C2[i]; }
    const size_t kstep = (size_t)(BK * 2);
    const size_t hstepA = (size_t)HALF * lda2, hstepB = (size_t)HALF * ldb2;
    const unsigned ldsw = (unsigned)wid * 1024u;
    const int aoff = lds_byte(wr * 64 + fr, fq * 8), boff = lds_byte(wc * 32 + fr, fq * 8);
#define PG8_SA(b, h) (((b) * 2 + (h)) * HTB)
#define PG8_SB(b, h) ((4 + (b) * 2 + (h)) * HTB)
#define PG8_STAGE(bufoff, gbase, voff) do { _Pragma("unroll") for (int _i = 0; _i < 2; ++_i) \
        __builtin_amdgcn_global_load_lds((const unsigned*)((const char*)(gbase) + (voff)[_i]), (LAS unsigned*)(lds + (bufoff) + ldsw + _i * 8192), 16, 0, 0); } while (0)
#define PG8_STAGE_A(bufoff, gbase, h, VO) do { if constexpr (Sched::GATHER) { PG8_STAGE(bufoff, gbase, (VO)[h]); } else { PG8_STAGE(bufoff, (gbase) + (h) * hstepA, voffA); } } while (0)
#define PG8_LDA(dst, b, h) do { _Pragma("unroll") for (int m = 0; m < 4; ++m) _Pragma("unroll") for (int k = 0; k < 2; ++k) dst[m][k] = *(const LAS bf16x8*)(lds + PG8_SA(b, h) + aoff + m * 2048 + k * 1024); } while (0)
#define PG8_LDB(dst, b, h) do { _Pragma("unroll") for (int n = 0; n < 2; ++n) _Pragma("unroll") for (int k = 0; k < 2; ++k) dst[n][k] = *(const LAS bf16x8*)(lds + PG8_SB(b, h) + boff + n * 2048 + k * 1024); } while (0)
#define PG8_MMA(ai, bj, At, Bt) do { __builtin_amdgcn_s_setprio(1); _Pragma("unroll") for (int m = 0; m < 4; ++m) _Pragma("unroll") for (int n = 0; n < 2; ++n) _Pragma("unroll") for (int k = 0; k < 2; ++k) \
        acc[ai][bj][m][n] = __builtin_amdgcn_mfma_f32_16x16x32_bf16(Bt[n][k], At[m][k], acc[ai][bj][m][n], 0, 0, 0); __builtin_amdgcn_s_setprio(0); } while (0)
#define PG8_WAIT_V(n) asm volatile("s_waitcnt vmcnt(" #n ")" ::: "memory")
#define PG8_WAIT_L(n) asm volatile("s_waitcnt lgkmcnt(" #n ")" ::: "memory")
#define PG8_BAR __builtin_amdgcn_s_barrier()
#define PG8_SCHED __builtin_amdgcn_sched_barrier(0)
    GUnit cur, nxt; int ui = 0;
    if (!S.next(0, cur)) return;
    f32x4 acc[2][2][4][2];
#pragma unroll
    for (int a = 0; a < 2; ++a)
#pragma unroll
        for (int b = 0; b < 2; ++b)
#pragma unroll
            for (int m = 0; m < 4; ++m)
#pragma unroll
                for (int n = 0; n < 2; ++n) acc[a][b][m][n] = (f32x4){0.f, 0.f, 0.f, 0.f};
    bf16x8 At[4][2], B0[2][2], B1[2][2];
    const char* cA = cur.A; const char* cB = cur.B;
    unsigned cvo[2][2], nvo[2][2];
    if constexpr (Sched::GATHER) {
#pragma unroll
        for (int h = 0; h < 2; ++h)
#pragma unroll
            for (int i = 0; i < 2; ++i) { cvo[h][i] = (unsigned)cur.gidx[h * HALF + RA[i]] * lda2 + C2[i]; nvo[h][i] = cvo[h][i]; }
    }
    PG8_STAGE(PG8_SB(0, 0), cB, voffB); PG8_STAGE(PG8_SB(0, 1), cB + hstepB, voffB); PG8_STAGE_A(PG8_SA(0, 0), cA, 0, cvo); PG8_STAGE_A(PG8_SA(0, 1), cA, 1, cvo);
    if (wr == 1) PG8_BAR;
    PG8_WAIT_V(2); PG8_BAR;
    PG8_STAGE(PG8_SB(1, 0), cB + kstep, voffB); PG8_STAGE_A(PG8_SA(1, 0), cA + kstep, 0, cvo); PG8_STAGE(PG8_SB(1, 1), cB + hstepB + kstep, voffB);
    PG8_WAIT_V(6); PG8_BAR;
    for (;;) {
        const bool has_next = S.next(ui + 1, nxt);
        const char* nA = has_next ? nxt.A : cA; const char* nB = has_next ? nxt.B : cB;
        int gi[2][2];
        if constexpr (Sched::GATHER) {
            const int* gp = has_next ? nxt.gidx : cur.gidx;
#pragma unroll
            for (int h = 0; h < 2; ++h)
#pragma unroll
                for (int i = 0; i < 2; ++i) gi[h][i] = gp[h * HALF + RA[i]];
        }
        for (int t = 0; t < nt; t += 2) {
            const bool last = (t == nt - 2);
            const char* a1 = cA + (size_t)(t + 1) * kstep;
            const char* a2 = last ? nA : cA + (size_t)(t + 2) * kstep; const char* b2 = last ? nB : cB + (size_t)(t + 2) * kstep;
            const char* a3 = a2 + kstep; const char* b3 = b2 + kstep;
            unsigned vo2[2][2];
            if constexpr (Sched::GATHER) {
                if (last) {
#pragma unroll
                    for (int h = 0; h < 2; ++h)
#pragma unroll
                        for (int i = 0; i < 2; ++i) nvo[h][i] = (unsigned)gi[h][i] * lda2 + C2[i];
                }
#pragma unroll
                for (int h = 0; h < 2; ++h)
#pragma unroll
                    for (int i = 0; i < 2; ++i) vo2[h][i] = last ? nvo[h][i] : cvo[h][i];
            }
            PG8_LDB(B0, 0, 0); PG8_LDB(B1, 0, 1); PG8_SCHED; PG8_LDA(At, 0, 0); PG8_STAGE_A(PG8_SA(1, 1), a1, 1, cvo);
            PG8_WAIT_V(8); PG8_WAIT_L(0); PG8_BAR; PG8_MMA(0, 0, At, B0); PG8_MMA(0, 1, At, B1); PG8_BAR; PG8_SCHED;
            PG8_LDA(At, 0, 1); PG8_STAGE(PG8_SB(0, 0), b2, voffB); PG8_STAGE(PG8_SB(0, 1), b2 + hstepB, voffB); PG8_STAGE_A(PG8_SA(0, 0), a2, 0, vo2);
            PG8_WAIT_V(8); PG8_WAIT_L(0); PG8_BAR; PG8_MMA(1, 0, At, B0); PG8_MMA(1, 1, At, B1); PG8_BAR; PG8_SCHED;
            PG8_LDB(B0, 1, 0); PG8_LDB(B1, 1, 1); PG8_SCHED; PG8_LDA(At, 1, 0); PG8_STAGE_A(PG8_SA(0, 1), a2, 1, vo2);
            PG8_WAIT_V(8); PG8_WAIT_L(0); PG8_BAR; PG8_MMA(0, 0, At, B0); PG8_MMA(0, 1, At, B1); PG8_BAR; PG8_SCHED;
            PG8_LDA(At, 1, 1); PG8_STAGE(PG8_SB(1, 0), b3, voffB); PG8_STAGE(PG8_SB(1, 1), b3 + hstepB, voffB); PG8_STAGE_A(PG8_SA(1, 0), a3, 0, vo2);
            PG8_WAIT_V(8); PG8_WAIT_L(0); PG8_BAR; PG8_MMA(1, 0, At, B0); PG8_MMA(1, 1, At, B1); PG8_BAR; PG8_SCHED;
        }
        if (wr == 0) PG8_BAR;
        E(acc, cur, wr, wc, fr, fq);
        if (!has_next) break;
#pragma unroll
        for (int a = 0; a < 2; ++a)
#pragma unroll
            for (int b = 0; b < 2; ++b)
#pragma unroll
                for (int m = 0; m < 4; ++m)
#pragma unroll
                    for (int n = 0; n < 2; ++n) acc[a][b][m][n] = (f32x4){0.f, 0.f, 0.f, 0.f};
        cur = nxt; cA = nA; cB = nB; ++ui;
        if constexpr (Sched::GATHER) {
#pragma unroll
            for (int h = 0; h < 2; ++h)
#pragma unroll
                for (int i = 0; i < 2; ++i) cvo[h][i] = nvo[h][i];
        }
        if (wr == 1) PG8_BAR;
    }
    PG8_WAIT_V(0);
    PG8_BAR;
#undef PG8_SA
#undef PG8_SB
#undef PG8_STAGE
#undef PG8_STAGE_A
#undef PG8_LDA
#undef PG8_LDB
#undef PG8_MMA
#undef PG8_WAIT_V
#undef PG8_WAIT_L
#undef PG8_BAR
#undef PG8_SCHED
}
}
using gm::GUnit;
struct SchedIn {
    static constexpr bool GATHER = false;
    int nt; unsigned lda2, ldb2; const char* XN; const char* WT; const char* MEMN; const char* WMKV; int G, c;
    __device__ __forceinline__ bool next(int i, GUnit& u) const {
        int L = i * G + c; u.gidx = nullptr;
        if (L < 128 * 23) { int pm, pn; gm::tile_of(L, 128, 23, pm, pn); u.A = XN + (size_t)pm * 256 * 2048; u.B = WT + (size_t)pn * 256 * 2048; u.pm = pm; u.pn = pn; u.aux = 0; return true; }
        L -= 128 * 23;
        if (L < 8) { const int pm = L >> 1, pn = L & 1; u.A = MEMN + (size_t)pm * 256 * 2048; u.B = WMKV + (size_t)pn * 256 * 2048; u.pm = pm; u.pn = pn; u.aux = 1; return true; }
        return false;
    }
};
struct EpiIn {
    static constexpr bool PERM = true;
    bf16_t* P; bf16_t* Gt; bf16_t* MKV;
    __device__ __forceinline__ void operator()(const f32x4 (&acc)[2][2][4][2], const GUnit& u, int wr, int wc, int fr, int fq) const {
        const int row0 = u.pm * 256 + wr * 64 + fr;
        bf16_t* base; int ldc, colt; bool sig = false;
        if (u.aux == 1) { base = MKV; ldc = 512; colt = u.pn * 256; }
        else if (u.pn < 11) { base = P; ldc = PW; colt = u.pn * 256; }
        else { base = Gt; ldc = GWD; colt = (u.pn - 11) * 256; sig = true; }
        const int col0 = colt + wc * 32 + 8 * fq;
#pragma unroll
        for (int ai = 0; ai < 2; ++ai)
#pragma unroll
            for (int m = 0; m < 4; ++m) { bf16_t* rowp = base + (size_t)(row0 + ai * 128 + m * 16) * ldc + col0;
#pragma unroll
                for (int bj = 0; bj < 2; ++bj) { f32x4 v0 = acc[ai][bj][m][0], v1 = acc[ai][bj][m][1];
                    if (sig) {
#pragma unroll
                        for (int j = 0; j < 4; ++j) { v0[j] = sigmoidf_(v0[j]); v1[j] = sigmoidf_(v1[j]); } }
                    u32x4 w; w.x = cvtpk(v0[0], v0[1]); w.y = cvtpk(v0[2], v0[3]); w.z = cvtpk(v1[0], v1[1]); w.w = cvtpk(v1[2], v1[3]);
                    *(u32x4*)(rowp + bj * 128) = w; } }
    }
};
struct SchedMerge {
    static constexpr bool GATHER = false;
    int nt; unsigned lda2, ldb2; const char* Y; const char* WT; int G, c;
    __device__ __forceinline__ bool next(int i, GUnit& u) const {
        const int L = i * G + c; u.gidx = nullptr; if (L >= 512) return false;
        int pm, pn; gm::tile_of(L, 128, 4, pm, pn); u.A = Y + (size_t)pm * 256 * lda2; u.B = WT + (size_t)pn * 256 * ldb2; u.pm = pm; u.pn = pn; u.aux = 0; return true;
    }
};
struct EpiMerge {
    static constexpr bool PERM = true;
    const bf16_t* Gt; bf16_t* MG; int pass;
    __device__ __forceinline__ void operator()(const f32x4 (&acc)[2][2][4][2], const GUnit& u, int wr, int wc, int fr, int fq) const {
        const int row0 = u.pm * 256 + wr * 64 + fr, col0 = u.pn * 256 + wc * 32 + 8 * fq;
#pragma unroll
        for (int ai = 0; ai < 2; ++ai)
#pragma unroll
            for (int m = 0; m < 4; ++m) { const size_t row = (size_t)(row0 + ai * 128 + m * 16);
#pragma unroll
                for (int bj = 0; bj < 2; ++bj) {
                    const u32x4 g = *(const u32x4*)(Gt + row * GWD + pass * 1024 + col0 + bj * 128);
                    bf16_t* mp = MG + row * DM + col0 + bj * 128;
                    float o[8];
                    const f32x4 v0 = acc[ai][bj][m][0], v1 = acc[ai][bj][m][1];
                    o[0] = bflo(g.x) * v0[0]; o[1] = bfhi(g.x) * v0[1]; o[2] = bflo(g.y) * v0[2]; o[3] = bfhi(g.y) * v0[3];
                    o[4] = bflo(g.z) * v1[0]; o[5] = bfhi(g.z) * v1[1]; o[6] = bflo(g.w) * v1[2]; o[7] = bfhi(g.w) * v1[3];
                    if (pass > 0) { const u32x4 p = *(const u32x4*)mp;
                        o[0] += bflo(p.x); o[1] += bfhi(p.x); o[2] += bflo(p.y); o[3] += bfhi(p.y); o[4] += bflo(p.z); o[5] += bfhi(p.z); o[6] += bflo(p.w); o[7] += bfhi(p.w); }
                    u32x4 w; w.x = cvtpk(o[0], o[1]); w.y = cvtpk(o[2], o[3]); w.z = cvtpk(o[4], o[5]); w.w = cvtpk(o[6], o[7]);
                    *(u32x4*)mp = w; } }
    }
};
struct SchedOut {
    static constexpr bool GATHER = false;
    int nt; unsigned lda2, ldb2; const char* A; const char* WT; int G, c;
    __device__ __forceinline__ bool next(int i, GUnit& u) const {
        const int L = i * G + c; u.gidx = nullptr; if (L >= 512) return false;
        int pm, pn; gm::tile_of(L, 128, 4, pm, pn); u.A = A + (size_t)pm * 256 * lda2; u.B = WT + (size_t)pn * 256 * ldb2; u.pm = pm; u.pn = pn; u.aux = 0; return true;
    }
};
struct EpiOut {
    static constexpr bool PERM = false;
    const float* X; float* O;
    __device__ __forceinline__ void operator()(const f32x4 (&acc)[2][2][4][2], const GUnit& u, int wr, int wc, int fr, int fq) const {
        const int row0 = u.pm * 256 + wr * 64 + fr, col0 = u.pn * 256 + wc * 32 + 4 * fq;
#pragma unroll
        for (int ai = 0; ai < 2; ++ai)
#pragma unroll
            for (int m = 0; m < 4; ++m) { const size_t off = (size_t)(row0 + ai * 128 + m * 16) * DM + col0;
#pragma unroll
                for (int bj = 0; bj < 2; ++bj)
#pragma unroll
                    for (int n = 0; n < 2; ++n) { const f32x4 xv = *(const f32x4*)(X + off + bj * 128 + n * 16); *(f32x4*)(O + off + bj * 128 + n * 16) = xv + acc[ai][bj][m][n]; } }
    }
};
struct SchedMoe1 {
    static constexpr bool GATHER = true;
    int nt; unsigned lda2, ldb2; const char* XN2; const char* WGU; const int* TIDX; int G, c;
    __device__ __forceinline__ bool next(int i, GUnit& u) const {
        const int L = i * G + c; if (L >= NE * 256) return false;
        const int e = L >> 8; int pm, pn; gm::tile_of(L & 255, 16, 16, pm, pn);
        u.A = XN2; u.gidx = TIDX + e * 4096 + pm * 256; u.B = WGU + ((size_t)e * 4096 + (size_t)pn * 256) * 2048; u.pm = e * 16 + pm; u.pn = pn; u.aux = 0; return true;
    }
};
struct EpiMoe1 {
    static constexpr bool PERM = true;
    bf16_t* ACT;
    __device__ __forceinline__ void operator()(const f32x4 (&acc)[2][2][4][2], const GUnit& u, int wr, int wc, int fr, int fq) const {
        const int row0 = u.pm * 256 + wr * 64 + fr, col0 = u.pn * 128 + wc * 32 + 8 * fq;
#pragma unroll
        for (int ai = 0; ai < 2; ++ai)
#pragma unroll
            for (int m = 0; m < 4; ++m) { bf16_t* rowp = ACT + (size_t)(row0 + ai * 128 + m * 16) * FF + col0;
                float o[8];
#pragma unroll
                for (int n = 0; n < 2; ++n)
#pragma unroll
                    for (int j = 0; j < 4; ++j) { const float g = acc[ai][0][m][n][j], up = acc[ai][1][m][n][j]; o[n * 4 + j] = g * sigmoidf_(g) * up; }
                u32x4 w; w.x = cvtpk(o[0], o[1]); w.y = cvtpk(o[2], o[3]); w.z = cvtpk(o[4], o[5]); w.w = cvtpk(o[6], o[7]);
                *(u32x4*)rowp = w; }
    }
};
struct SchedMoe2 {
    static constexpr bool GATHER = false;
    int nt; unsigned lda2, ldb2; const char* ACT; const char* WD; int G, c;
    __device__ __forceinline__ bool next(int i, GUnit& u) const {
        const int L = i * G + c; u.gidx = nullptr; if (L >= NE * 64) return false;
        const int e = L >> 6; int pm, pn; gm::tile_of(L & 63, 16, 4, pm, pn);
        u.A = ACT + ((size_t)e * 4096 + (size_t)pm * 256) * 4096; u.B = WD + ((size_t)e * 1024 + (size_t)pn * 256) * 4096; u.pm = e * 16 + pm; u.pn = pn; u.aux = 0; return true;
    }
};
struct EpiMoe2 {
    static constexpr bool PERM = true;
    bf16_t* YE; const float* TVAL;
    __device__ __forceinline__ void operator()(const f32x4 (&acc)[2][2][4][2], const GUnit& u, int wr, int wc, int fr, int fq) const {
        const int row0 = u.pm * 256 + wr * 64 + fr, col0 = u.pn * 256 + wc * 32 + 8 * fq;
#pragma unroll
        for (int ai = 0; ai < 2; ++ai)
#pragma unroll
            for (int m = 0; m < 4; ++m) { const int row = row0 + ai * 128 + m * 16; const float tv = TVAL[row]; bf16_t* rowp = YE + (size_t)row * DM + col0;
#pragma unroll
                for (int bj = 0; bj < 2; ++bj) { const f32x4 v0 = acc[ai][bj][m][0] * tv, v1 = acc[ai][bj][m][1] * tv;
                    u32x4 w; w.x = cvtpk(v0[0], v0[1]); w.y = cvtpk(v0[2], v0[3]); w.z = cvtpk(v1[0], v1[1]); w.w = cvtpk(v1[2], v1[3]);
                    *(u32x4*)(rowp + bj * 128) = w; } }
    }
};
constexpr int NWAVES = 8, NTHR = 512;
constexpr int LDS_BYTES = 147456;
struct Args { const float* in[30]; float* out; unsigned char* ws; int ph_lo, ph_hi; };
enum { I_X = 0, I_MEM, I_NMIXG, I_NMEMG, I_WIN, I_RPB, I_MURKV, I_MUW, I_MUA, I_W0, I_W2, I_A0, I_A2, I_KK, I_KA, I_RK, I_G2, I_LNG, I_LNB, I_WMKV, I_WBNA, I_WBRW, I_WBMEM, I_WOUT,
       I_NFFNG, I_WROUTER, I_WEG, I_WEU, I_WED, I_NFING };

__device__ __forceinline__ void transpose_item(const float* __restrict__ W, int N, bf16_t* __restrict__ WT, int ldw, int drow0, int k0, int n0, LAS float* scr, int lane) {
#pragma unroll 8
    for (int i = 0; i < 32; ++i) { const int kk = 2 * i + (lane >> 5); scr[kk * 33 + (lane & 31)] = W[(size_t)(k0 + kk) * N + n0 + (lane & 31)]; }
    LDS_WAIT(); asm volatile("" ::: "memory");
    const int c = lane & 7;
#pragma unroll
    for (int j = 0; j < 4; ++j) { const int n = (lane >> 3) + 8 * j; const LAS float* s = scr + (8 * c) * 33 + n;
        u32x4 o; o.x = cvtpk(s[0 * 33], s[1 * 33]); o.y = cvtpk(s[2 * 33], s[3 * 33]); o.z = cvtpk(s[4 * 33], s[5 * 33]); o.w = cvtpk(s[6 * 33], s[7 * 33]);
        *(u32x4*)(WT + (size_t)(drow0 + n) * ldw + k0 + 8 * c) = o; }
    LDS_WAIT(); asm volatile("" ::: "memory");
}
__device__ __forceinline__ bool tr_matrix(int& it, const float* W, int K, int N, bf16_t* WT, LAS float* scr, int lane) {
    const int nblk = N / 32, items = (K / 64) * nblk;
    if (it < items) { const int kb = it / nblk, nb = it % nblk; transpose_item(W, N, WT, K, 32 * nb, 64 * kb, 32 * nb, scr, lane); return true; }
    it -= items; return false;
}
__device__ __forceinline__ void rms_row_to_bf16(const float* __restrict__ xrow, const float* __restrict__ g, bf16_t* __restrict__ orow, int lane) {
    const f32x4* xr = (const f32x4*)xrow + lane; const f32x4* gr = (const f32x4*)g + lane;
    f32x4 v[4]; float s = 0.f;
#pragma unroll
    for (int j = 0; j < 4; ++j) { v[j] = xr[64 * j]; s += (v[j].x * v[j].x + v[j].y * v[j].y) + (v[j].z * v[j].z + v[j].w * v[j].w); }
    const float rstd = 1.f / sqrtf(wave_sum(s) * (1.f / DM) + RMS_EPS);
    unsigned long long* o8 = (unsigned long long*)orow + lane;
#pragma unroll
    for (int j = 0; j < 4; ++j) { const f32x4 gg = gr[64 * j];
        o8[64 * j] = (unsigned long long)cvtpk(v[j].x * rstd * gg.x, v[j].y * rstd * gg.y) | ((unsigned long long)cvtpk(v[j].z * rstd * gg.z, v[j].w * rstd * gg.w) << 32); }
}
__device__ __forceinline__ void phase_prologue(const Args& a, LAS unsigned char* lds, int wave, int lane) {
    unsigned char* ws = a.ws;
    LAS float* scr = (LAS float*)(lds + wave * 16384);
    const int gw = blockIdx.x * NWAVES + wave, NGW = gridDim.x * NWAVES;
    constexpr int NITEMS = 16 * 184 + 192 + 192 + 128 + 512 + 256 + 12 * 4 + 24;
    for (int it0 = gw; it0 < NITEMS; it0 += NGW) {
        int it = it0;
        if (tr_matrix(it, a.in[I_WIN], DM, DIN, (bf16_t*)(ws + WS_WIN), scr, lane)) continue;
        if (tr_matrix(it, a.in[I_WBNA], NAW, DM, (bf16_t*)(ws + WS_WBR), scr, lane)) continue;
        if (tr_matrix(it, a.in[I_WBRW], RWW, DM, (bf16_t*)(ws + WS_WBR) + 1024 * 384, scr, lane)) continue;
        if (tr_matrix(it, a.in[I_WBMEM], MEMW, DM, (bf16_t*)(ws + WS_WBR) + 2 * 1024 * 384, scr, lane)) continue;
        if (tr_matrix(it, a.in[I_WOUT], DM, DM, (bf16_t*)(ws + WS_WOUT), scr, lane)) continue;
        if (tr_matrix(it, a.in[I_WMKV], DM, 512, (bf16_t*)(ws + WS_WMKV), scr, lane)) continue;
        if (tr_matrix(it, a.in[I_W2], 64, 384, (bf16_t*)(ws + WS_W2T), scr, lane)) continue;
        if (tr_matrix(it, a.in[I_W2] + 64 * 384, 64, 384, (bf16_t*)(ws + WS_W2T) + 384 * 64, scr, lane)) continue;
        if (tr_matrix(it, a.in[I_A2], 64, 384, (bf16_t*)(ws + WS_A2T), scr, lane)) continue;
        if (tr_matrix(it, a.in[I_A2] + 64 * 384, 64, 384, (bf16_t*)(ws + WS_A2T) + 384 * 64, scr, lane)) continue;
        tr_matrix(it, a.in[I_G2], 128, 384, (bf16_t*)(ws + WS_G2T), scr, lane);
    }
    for (int m = gw; m < T; m += NGW) rms_row_to_bf16(a.in[I_X] + (size_t)m * DM, a.in[I_NMIXG], (bf16_t*)(ws + WS_XN) + (size_t)m * DM, lane);
    for (int m = gw; m < NB * NMEM; m += NGW) rms_row_to_bf16(a.in[I_MEM] + (size_t)m * DM, a.in[I_NMEMG], (bf16_t*)(ws + WS_MEMN) + (size_t)m * DM, lane);
}

template <int CTRL> __device__ __forceinline__ float dppf(float v) { return __int_as_float(__builtin_amdgcn_update_dpp(0, __float_as_int(v), CTRL, 0xf, 0xf, true)); }
__device__ __forceinline__ float sum8(float v) { v += dppf<0xB1>(v); v += dppf<0x4E>(v); v += dppf<0x141>(v); return v; }
__device__ __forceinline__ float dot8(const float (&q)[8], const u32x4 t4) {
    return q[0] * bflo(t4.x) + q[1] * bfhi(t4.x) + q[2] * bflo(t4.y) + q[3] * bfhi(t4.y) + q[4] * bflo(t4.z) + q[5] * bfhi(t4.z) + q[6] * bflo(t4.w) + q[7] * bfhi(t4.w);
}
__device__ __forceinline__ void axpy8(float (&o)[8], float p, const u32x4 t4) {
    o[0] += p * bflo(t4.x); o[1] += p * bfhi(t4.x); o[2] += p * bflo(t4.y); o[3] += p * bfhi(t4.y); o[4] += p * bflo(t4.z); o[5] += p * bfhi(t4.z); o[6] += p * bflo(t4.w); o[7] += p * bfhi(t4.w);
}
typedef short v4i16_t __attribute__((ext_vector_type(4)));
__device__ __forceinline__ s16x4 tr_read(const LAS unsigned char* p) { return __builtin_bit_cast(s16x4, __builtin_amdgcn_ds_read_tr16_b64_v4i16((LAS v4i16_t*)p)); }
constexpr int KPITCH = 144, VPITCH = 136;
__device__ __forceinline__ void na_unit(const Args& a, LAS unsigned char* lds, int unit, int tid) {
    const int h = unit % NAH, r = (unit / NAH) % GROWS, b = unit / (NAH * GROWS);
    const bf16_t* P = (const bf16_t*)(a.ws + WS_P);
    const int rs = min(max(r - 4, 0), GROWS - 8);
    LAS unsigned char* Ks = lds; LAS unsigned char* Vs = lds + 512 * KPITCH; LAS float* RPB = (LAS float*)(lds + 512 * KPITCH + 512 * VPITCH);
    const int wave = __builtin_amdgcn_readfirstlane(tid >> 6), lane = tid & 63, fr = lane & 15, fq = lane >> 4;
    {   const int key = tid; const size_t tok = (size_t)b * SEQ + (size_t)(rs + (key >> 6)) * GRIDW + (key & 63);
        const u32x4* kp = (const u32x4*)(P + tok * PW + C_NAK + h * 64); const u32x4* vp = (const u32x4*)(P + tok * PW + C_NAV + h * 64);
#pragma unroll
        for (int c8 = 0; c8 < 8; ++c8) { *(LAS u32x4*)(Ks + key * KPITCH + c8 * 16) = kp[c8]; const u32x4 v = vp[c8];
            *(LAS u32x2*)(Vs + key * VPITCH + c8 * 16) = (u32x2){v.x, v.y}; *(LAS u32x2*)(Vs + key * VPITCH + c8 * 16 + 8) = (u32x2){v.z, v.w}; }
        if (tid < 15 * 31) RPB[tid] = a.in[I_RPB][h * 15 * 31 + tid];
    }
    const int qt = wave & 3, kh = wave >> 2, w0 = 16 * qt, cbase = (qt == 0) ? 0 : (qt == 1) ? 8 : (qt == 2) ? 24 : 32;
    const size_t qtok = (size_t)b * SEQ + (size_t)r * GRIDW + w0 + fr;
    bf16x8 qf[2];
#pragma unroll
    for (int s = 0; s < 2; ++s) qf[s] = *(const bf16x8*)(P + qtok * PW + C_NAQ + h * 64 + 32 * s + 8 * fq);
    __syncthreads();
    f32x4 sc[8];
#pragma unroll
    for (int tl = 0; tl < 8; ++tl) { const int i = 4 * kh + (tl >> 1), hf = tl & 1; sc[tl] = (f32x4){0.f, 0.f, 0.f, 0.f};
#pragma unroll
        for (int s = 0; s < 2; ++s) { const bf16x8 af = *(const LAS bf16x8*)(Ks + (i * 64 + cbase + 16 * hf + fr) * KPITCH + (32 * s + 8 * fq) * 2); sc[tl] = __builtin_amdgcn_mfma_f32_16x16x32_bf16(af, qf[s], sc[tl], 0, 0, 0); } }
    const int w = w0 + fr, cs = min(max(w - 8, 0), GRIDW - 16);
    float mx = -1e30f;
#pragma unroll
    for (int tl = 0; tl < 8; ++tl) { const int i = 4 * kh + (tl >> 1), hf = tl & 1;
#pragma unroll
        for (int g = 0; g < 4; ++g) { const int c = cbase + 16 * hf + 4 * fq + g; const bool valid = (c >= cs) && (c < cs + 16); const int co = min(max(c - w + 15, 0), 30);
            const float v = valid ? (sc[tl][g] * 0.125f + RPB[(rs + i - r + 7) * 31 + co]) : -1e30f; sc[tl][g] = v; mx = fmaxf(mx, v); } }
    mx = fmaxf(mx, __shfl_xor(mx, 16)); mx = fmaxf(mx, __shfl_xor(mx, 32));
    float l = 0.f;
#pragma unroll
    for (int tl = 0; tl < 8; ++tl)
#pragma unroll
        for (int g = 0; g < 4; ++g) { const float p = (sc[tl][g] > -1e29f) ? __expf(sc[tl][g] - mx) : 0.f; sc[tl][g] = p; l += p; }
    l += __shfl_xor(l, 16); l += __shfl_xor(l, 32);
    f32x4 o[4];
#pragma unroll
    for (int dt = 0; dt < 4; ++dt) o[dt] = (f32x4){0.f, 0.f, 0.f, 0.f};
#pragma unroll
    for (int ii = 0; ii < 4; ++ii) { const int i = 4 * kh + ii;
        u32x4 pw; pw.x = cvtpk(sc[2 * ii][0], sc[2 * ii][1]); pw.y = cvtpk(sc[2 * ii][2], sc[2 * ii][3]); pw.z = cvtpk(sc[2 * ii + 1][0], sc[2 * ii + 1][1]); pw.w = cvtpk(sc[2 * ii + 1][2], sc[2 * ii + 1][3]);
        const bf16x8 pb = __builtin_bit_cast(bf16x8, pw);
        const LAS unsigned char* vb = Vs + (i * 64 + cbase + 4 * fq + (fr >> 2)) * VPITCH + 8 * (fr & 3);
#pragma unroll
        for (int dt = 0; dt < 4; ++dt) { const s16x4 lo = tr_read(vb + dt * 32), hi = tr_read(vb + 16 * VPITCH + dt * 32);
            const bf16x8 af = (bf16x8){lo[0], lo[1], lo[2], lo[3], hi[0], hi[1], hi[2], hi[3]};
            o[dt] = __builtin_amdgcn_mfma_f32_16x16x32_bf16(af, pb, o[dt], 0, 0, 0); } }
    __syncthreads();
    LAS float* X = (LAS float*)lds + (qt * 64 + lane) * 20;
    if (kh == 1) { X[0] = mx; X[1] = l;
#pragma unroll
        for (int dt = 0; dt < 4; ++dt) *(LAS f32x4*)(X + 4 + 4 * dt) = o[dt]; }
    __syncthreads();
    if (kh == 0) { const float m1 = X[0], l1 = X[1]; const float mt = fmaxf(mx, m1), f0 = __expf(mx - mt), f1 = __expf(m1 - mt); const float il = 1.f / (l * f0 + l1 * f1);
        bf16_t* yp = (bf16_t*)(a.ws + WS_YNA) + qtok * NAW + h * 64 + 4 * fq;
#pragma unroll
        for (int dt = 0; dt < 4; ++dt) { const f32x4 o1 = *(const LAS f32x4*)(X + 4 + 4 * dt); const f32x4 ov = (o[dt] * f0 + o1 * f1) * il;
            *(u32x2*)(yp + 16 * dt) = (u32x2){cvtpk(ov[0], ov[1]), cvtpk(ov[2], ov[3])}; } }
    __syncthreads();
}
__device__ __forceinline__ void mem_unit(const Args& a, LAS unsigned char* lds, int unit, int tid) {
    const int qb = unit & 15, mh = (unit >> 4) & 3, b = unit >> 6;
    const bf16_t* MKV = (const bf16_t*)(a.ws + WS_MKV); const bf16_t* P = (const bf16_t*)(a.ws + WS_P);
    LAS unsigned char* Ks = lds; LAS unsigned char* Vs = lds + 256 * KPITCH;
    const int wave = __builtin_amdgcn_readfirstlane(tid >> 6), lane = tid & 63, fr = lane & 15, fq = lane >> 4;
    {   const int key = tid >> 1, hf = tid & 1; const bf16_t* src = MKV + (size_t)(b * NMEM + key) * 512 + mh * 64 + hf * 32;
#pragma unroll
        for (int c4 = 0; c4 < 4; ++c4) { *(LAS u32x4*)(Ks + key * KPITCH + hf * 64 + c4 * 16) = *(const u32x4*)(src + c4 * 8); const u32x4 v = *(const u32x4*)(src + 256 + c4 * 8);
            *(LAS u32x2*)(Vs + key * VPITCH + hf * 64 + c4 * 16) = (u32x2){v.x, v.y}; *(LAS u32x2*)(Vs + key * VPITCH + hf * 64 + c4 * 16 + 8) = (u32x2){v.z, v.w}; }
    }
    __syncthreads();
#pragma unroll 1
    for (int tile = 0; tile < 4; ++tile) {
        const size_t qtok = (size_t)b * SEQ + (size_t)qb * 512 + (wave * 4 + tile) * 16 + fr;
        bf16x8 qf[2];
#pragma unroll
        for (int s = 0; s < 2; ++s) qf[s] = *(const bf16x8*)(P + qtok * PW + C_MQ + mh * 64 + 32 * s + 8 * fq);
        f32x4 sc[16];
#pragma unroll
        for (int kt = 0; kt < 16; ++kt) { sc[kt] = (f32x4){0.f, 0.f, 0.f, 0.f};
#pragma unroll
            for (int s = 0; s < 2; ++s) { const bf16x8 af = *(const LAS bf16x8*)(Ks + (16 * kt + fr) * KPITCH + (32 * s + 8 * fq) * 2); sc[kt] = __builtin_amdgcn_mfma_f32_16x16x32_bf16(af, qf[s], sc[kt], 0, 0, 0); } }
        float mx = -1e30f;
#pragma unroll
        for (int kt = 0; kt < 16; ++kt)
#pragma unroll
            for (int g = 0; g < 4; ++g) mx = fmaxf(mx, sc[kt][g]);
        mx = fmaxf(mx, __shfl_xor(mx, 16)); mx = fmaxf(mx, __shfl_xor(mx, 32));
        float l = 0.f;
#pragma unroll
        for (int kt = 0; kt < 16; ++kt)
#pragma unroll
            for (int g = 0; g < 4; ++g) { const float p = __expf((sc[kt][g] - mx) * 0.125f); sc[kt][g] = p; l += p; }
        l += __shfl_xor(l, 16); l += __shfl_xor(l, 32);
        f32x4 o[4];
#pragma unroll
        for (int dt = 0; dt < 4; ++dt) o[dt] = (f32x4){0.f, 0.f, 0.f, 0.f};
#pragma unroll
        for (int ks = 0; ks < 8; ++ks) {
            u32x4 pw; pw.x = cvtpk(sc[2 * ks][0], sc[2 * ks][1]); pw.y = cvtpk(sc[2 * ks][2], sc[2 * ks][3]); pw.z = cvtpk(sc[2 * ks + 1][0], sc[2 * ks + 1][1]); pw.w = cvtpk(sc[2 * ks + 1][2], sc[2 * ks + 1][3]);
            const bf16x8 pb = __builtin_bit_cast(bf16x8, pw);
            const LAS unsigned char* vb = Vs + (32 * ks + 4 * fq + (fr >> 2)) * VPITCH + 8 * (fr & 3);
#pragma unroll
            for (int dt = 0; dt < 4; ++dt) { const s16x4 lo = tr_read(vb + dt * 32), hi = tr_read(vb + 16 * VPITCH + dt * 32);
                const bf16x8 af = (bf16x8){lo[0], lo[1], lo[2], lo[3], hi[0], hi[1], hi[2], hi[3]};
                o[dt] = __builtin_amdgcn_mfma_f32_16x16x32_bf16(af, pb, o[dt], 0, 0, 0); } }
        const float il = 1.f / l;
        bf16_t* yp = (bf16_t*)(a.ws + WS_YMEM) + qtok * MEMW + mh * 64 + 4 * fq;
#pragma unroll
        for (int dt = 0; dt < 4; ++dt) { const f32x4 ov = o[dt] * il; *(u32x2*)(yp + 16 * dt) = (u32x2){cvtpk(ov[0], ov[1]), cvtpk(ov[2], ov[3])}; }
    }
    __syncthreads();
}

__device__ __forceinline__ void phase_norm_router(const Args& a, LAS unsigned char* lds, int wave, int lane) {
    const int gw = blockIdx.x * NWAVES + wave, NGW = gridDim.x * NWAVES;
    const float* x1 = a.out; const float* g = a.in[I_NFFNG]; const LAS float* wr = (const LAS float*)lds;
    bf16_t* XN2 = (bf16_t*)(a.ws + WS_XN); float* AFF = (float*)(a.ws + WS_AFF);
    for (int m = gw; m < T; m += NGW) {
        const f32x4* xr = (const f32x4*)(x1 + (size_t)m * DM) + lane; const f32x4* gr = (const f32x4*)g + lane;
        f32x4 v[4]; float s = 0.f;
#pragma unroll
        for (int j = 0; j < 4; ++j) { v[j] = xr[64 * j]; s += (v[j].x * v[j].x + v[j].y * v[j].y) + (v[j].z * v[j].z + v[j].w * v[j].w); }
        const float rstd = 1.f / sqrtf(wave_sum(s) * (1.f / DM) + RMS_EPS);
        unsigned long long* o8 = (unsigned long long*)(XN2 + (size_t)m * DM) + lane;
        float lg[16];
#pragma unroll
        for (int e = 0; e < 16; ++e) lg[e] = 0.f;
#pragma unroll 1
        for (int j = 0; j < 4; ++j) { const f32x4 gg = gr[64 * j]; f32x4 hh; hh.x = v[j].x * rstd * gg.x; hh.y = v[j].y * rstd * gg.y; hh.z = v[j].z * rstd * gg.z; hh.w = v[j].w * rstd * gg.w;
            o8[64 * j] = (unsigned long long)cvtpk(hh.x, hh.y) | ((unsigned long long)cvtpk(hh.z, hh.w) << 32);
            const int d0 = 4 * (64 * j + lane);
#pragma unroll
            for (int dd = 0; dd < 4; ++dd) { const LAS f32x4* wp = (const LAS f32x4*)(wr + (d0 + dd) * NE); const float hv = hh[dd];
#pragma unroll
                for (int e4 = 0; e4 < 4; ++e4) { const f32x4 wv = wp[e4]; lg[e4 * 4] += hv * wv.x; lg[e4 * 4 + 1] += hv * wv.y; lg[e4 * 4 + 2] += hv * wv.z; lg[e4 * 4 + 3] += hv * wv.w; } } }
#pragma unroll
        for (int e = 0; e < 16; ++e) lg[e] = wave_sum(lg[e]);
        float mxv = lg[0];
#pragma unroll
        for (int e = 1; e < 16; ++e) mxv = fmaxf(mxv, lg[e]);
        float se = 0.f;
#pragma unroll
        for (int e = 0; e < 16; ++e) { lg[e] = expf(lg[e] - mxv); se += lg[e]; }
        const float inv = 1.f / se;
        if (lane < 4) { f32x4 ov;
            if (lane == 0) ov = (f32x4){lg[0], lg[1], lg[2], lg[3]}; else if (lane == 1) ov = (f32x4){lg[4], lg[5], lg[6], lg[7]};
            else if (lane == 2) ov = (f32x4){lg[8], lg[9], lg[10], lg[11]}; else ov = (f32x4){lg[12], lg[13], lg[14], lg[15]};
            *(f32x4*)(AFF + (size_t)m * NE + lane * 4) = ov * inv; }
    }
}

__device__ __forceinline__ unsigned block_sum_u32(unsigned v, LAS unsigned* red, int tid) {
    unsigned s = v;
#pragma unroll
    for (int o = 1; o < 64; o <<= 1) s += __shfl_xor(s, o);
    if ((tid & 63) == 0) red[tid >> 6] = s;
    __syncthreads();
    unsigned t = 0;
#pragma unroll
    for (int w = 0; w < 8; ++w) t += red[w];
    __syncthreads();
    return t;
}
__device__ __forceinline__ unsigned block_excl_scan(unsigned v, LAS unsigned* red, int tid) {
    const int lane = tid & 63, wv = tid >> 6;
    unsigned inc = v;
#pragma unroll
    for (int o = 1; o < 64; o <<= 1) { const unsigned n = __shfl_up(inc, o); if (lane >= o) inc += n; }
    if (lane == 63) red[wv] = inc;
    __syncthreads();
    unsigned base = 0;
#pragma unroll
    for (int w = 0; w < 8; ++w) if (w < wv) base += red[w];
    __syncthreads();
    return base + inc - v;
}
__device__ __forceinline__ void topk_unit(const Args& a, LAS unsigned char* lds, int unit, int tid) {
    const int e = unit & 15, b = unit >> 4;
    const float* AFF = (const float*)(a.ws + WS_AFF);
    int* TIDX = (int*)(a.ws + WS_TIDX); float* TVAL = (float*)(a.ws + WS_TVAL); int* SLOT = (int*)(a.ws + WS_SLOT);
    LAS unsigned* red = (LAS unsigned*)lds;
    unsigned key[16];
#pragma unroll
    for (int j = 0; j < 16; ++j) key[j] = __float_as_uint(AFF[((size_t)b * SEQ + tid * 16 + j) * NE + e]);
    unsigned prefix = 0;
    for (int bit = 30; bit >= 0; --bit) {
        const unsigned cand = prefix | (1u << bit); unsigned c = 0;
#pragma unroll
        for (int j = 0; j < 16; ++j) c += (key[j] >= cand) ? 1u : 0u;
        const unsigned tot = block_sum_u32(c, red, tid);
        if (tot >= (unsigned)CAP) prefix = cand;
    }
    unsigned cg_ = 0, ce = 0;
#pragma unroll
    for (int j = 0; j < 16; ++j) { cg_ += (key[j] > prefix) ? 1u : 0u; ce += (key[j] == prefix) ? 1u : 0u; }
    const unsigned ngt = block_sum_u32(cg_, red, tid);
    const unsigned need = (unsigned)CAP - ngt;
    unsigned erank = block_excl_scan(ce, red, tid);
    unsigned sel = 0, nsel = 0;
#pragma unroll
    for (int j = 0; j < 16; ++j) { bool s = key[j] > prefix; if (key[j] == prefix) { s = erank < need; ++erank; } if (s) { sel |= 1u << j; ++nsel; } }
    unsigned pos = block_excl_scan(nsel, red, tid);
#pragma unroll
    for (int j = 0; j < 16; ++j) { const int tok = b * SEQ + tid * 16 + j; int slot = -1;
        if (sel & (1u << j)) { slot = e * 4096 + b * 1024 + (int)pos; ++pos; TIDX[slot] = tok; TVAL[slot] = __uint_as_float(key[j]); }
        SLOT[(size_t)tok * NE + e] = slot; }
}

__device__ __forceinline__ void expert_convert(const Args& a, LAS unsigned char* lds, int wave, int lane, int gw, int NGW) {
    LAS float* scr = (LAS float*)(lds + 4096 + wave * 16384);
    bf16_t* WGU = (bf16_t*)(a.ws + WS_WGU); bf16_t* WD = (bf16_t*)(a.ws + WS_WD);
    constexpr int PER_E = 3072, NIT = NE * PER_E;
    for (int it0 = gw; it0 < NIT; it0 += NGW) {
        const int e = it0 / PER_E; int it = it0 % PER_E;
        if (it < 2048) { const int up = it >> 10; it &= 1023; const int kb = it >> 6, nb = it & 63, n0 = 32 * nb;
            const float* W = a.in[up ? I_WEU : I_WEG] + (size_t)e * DM * FF;
            transpose_item(W, FF, WGU + (size_t)e * 4096 * 1024, 1024, 256 * (n0 >> 7) + (up ? 128 : 0) + (n0 & 127), 64 * kb, n0, scr, lane); }
        else { it -= 2048; const int kb = it >> 5, nb = it & 31;
            transpose_item(a.in[I_WED] + (size_t)e * FF * DM, DM, WD + (size_t)e * 1024 * 2048, 2048, 32 * nb, 64 * kb, 32 * nb, scr, lane); }
    }
}

__device__ __forceinline__ void phase_final(const Args& a, int wave, int lane) {
    const int gw = blockIdx.x * NWAVES + wave, NGW = gridDim.x * NWAVES;
    float* x1 = a.out; const float* g = a.in[I_NFING]; const int* SLOT = (const int*)(a.ws + WS_SLOT); const bf16_t* YE = (const bf16_t*)(a.ws + WS_YE);
    for (int m = gw; m < T; m += NGW) {
        f32x4* xr = (f32x4*)(x1 + (size_t)m * DM) + lane; const f32x4* gr = (const f32x4*)g + lane;
        f32x4 v[4];
#pragma unroll
        for (int j = 0; j < 4; ++j) v[j] = xr[64 * j];
        const int myslot = (lane < NE) ? SLOT[(size_t)m * NE + lane] : -1;
        for (int e = 0; e < NE; ++e) { const int sl = __shfl(myslot, e);
            if (sl >= 0) { const u32x2* yp = (const u32x2*)(YE + (size_t)sl * DM) + lane;
#pragma unroll
                for (int j = 0; j < 4; ++j) { const u32x2 y2 = yp[64 * j]; v[j].x += bflo(y2.x); v[j].y += bfhi(y2.x); v[j].z += bflo(y2.y); v[j].w += bfhi(y2.y); } } }
        float s = 0.f;
#pragma unroll
        for (int j = 0; j < 4; ++j) s += (v[j].x * v[j].x + v[j].y * v[j].y) + (v[j].z * v[j].z + v[j].w * v[j].w);
        const float rstd = 1.f / sqrtf(wave_sum(s) * (1.f / DM) + RMS_EPS);
#pragma unroll
        for (int j = 0; j < 4; ++j) { const f32x4 gg = gr[64 * j]; xr[64 * j] = v[j] * rstd * gg; }
    }
}
constexpr int LP = 72;
constexpr int RB = 64 * LP * 2;
#define RWBUF(n) ((LAS bf16_t*)(lds + (n) * RB))

__device__ __forceinline__ void mm64(const LAS bf16_t* A, const LAS bf16_t* Bt, f32x4 (&acc)[2], int wid, int fr, int fq) {
    const int rt = wid >> 1, ct0 = 2 * (wid & 1);
#pragma unroll
    for (int s = 0; s < 2; ++s) {
        const bf16x8 af = *(const LAS bf16x8*)(A + (16 * rt + fr) * LP + 32 * s + 8 * fq);
#pragma unroll
        for (int c = 0; c < 2; ++c) { const bf16x8 bfrag = *(const LAS bf16x8*)(Bt + (16 * (ct0 + c) + fr) * LP + 32 * s + 8 * fq);
            acc[c] = __builtin_amdgcn_mfma_f32_16x16x32_bf16(af, bfrag, acc[c], 0, 0, 0); }
    }
}
__device__ __forceinline__ void zero2(f32x4 (&acc)[2]) { acc[0] = (f32x4){0.f, 0.f, 0.f, 0.f}; acc[1] = acc[0]; }
template <int MASK> __device__ __forceinline__ void mask2(f32x4 (&acc)[2], int wid, int fr, int fq) {
    if (MASK == 0) return;
    const int rt = wid >> 1, ct0 = 2 * (wid & 1);
#pragma unroll
    for (int c = 0; c < 2; ++c)
#pragma unroll
        for (int g = 0; g < 4; ++g) { const int row = 16 * rt + 4 * fq + g, col = 16 * (ct0 + c) + fr; const bool keep = (MASK == 1) ? (row > col) : (row >= col); if (!keep) acc[c][g] = 0.f; }
}
__device__ __forceinline__ void store_rm(LAS bf16_t* D, const f32x4 (&acc)[2], int wid, int fr, int fq) {
    const int rt = wid >> 1, ct0 = 2 * (wid & 1);
#pragma unroll
    for (int c = 0; c < 2; ++c)
#pragma unroll
        for (int g = 0; g < 4; ++g) D[(16 * rt + 4 * fq + g) * LP + 16 * (ct0 + c) + fr] = f2bf(acc[c][g]);
}
__device__ __forceinline__ void store_tr(LAS bf16_t* D, const f32x4 (&acc)[2], int wid, int fr, int fq) {
    const int rt = wid >> 1, ct0 = 2 * (wid & 1);
#pragma unroll
    for (int c = 0; c < 2; ++c) { u32x2 w; w.x = cvtpk(acc[c][0], acc[c][1]); w.y = cvtpk(acc[c][2], acc[c][3]); *(LAS u32x2*)(D + (16 * (ct0 + c) + fr) * LP + 16 * rt + 4 * fq) = w; }
}
__device__ __forceinline__ int afrag_index(int row, int k) {
    const int tile = row >> 4, fr = row & 15, s = k >> 5, j = 4 * ((k >> 4) & 1) + (k & 3), fq = (k >> 2) & 3;
    return ((tile * 2 + s) * 64 + fq * 16 + fr) * 8 + j;
}
__device__ __forceinline__ int nfrag_index(int v, int k) { const int vg = v >> 4, fr = v & 15, kt = k >> 4, fq = (k >> 2) & 3, reg = k & 3; return ((vg * 64 + fq * 16 + fr) * 16) + kt * 4 + reg; }

__device__ __forceinline__ int scan_tok(int d, int c, int i) { const int p = 64 * c + i; return d ? (SEQ - 1 - p) : p; }

__device__ __forceinline__ void rwkv_chunk_unit(const Args& a, LAS unsigned char* lds, int unit, int tid) {
    const int c = unit & 127, h = (unit >> 7) % RWH, db = unit / (128 * RWH), b = db & 3, d = db >> 2;
    const int wid = __builtin_amdgcn_readfirstlane(tid >> 6), lane = tid & 63, fr = lane & 15, fq = lane >> 4;
    const int i = tid >> 3, jq = tid & 7, ch0 = h * 64 + jq * 8;
    const bf16_t* P = (const bf16_t*)(a.ws + WS_P);
    const int s_cur = scan_tok(d, c, i); const bool has_prev = !(c == 0 && i == 0); const int s_prev = d ? s_cur + 1 : s_cur - 1;
    const size_t tok = (size_t)b * SEQ + s_cur, tokp = (size_t)b * SEQ + (has_prev ? s_prev : s_cur);
    LAS bf16_t *AT = RWBUF(0), *RT = RWBUF(1), *BT = RWBUF(2), *KT = RWBUF(3), *ATc = RWBUF(4), *VTc = RWBUF(5), *KHc = RWBUF(6), *BHc = RWBUF(7);
    LAS bf16_t *L0 = RWBUF(8), *L0T = RWBUF(9), *AAK = RWBUF(10), *ARB = RWBUF(11), *ARK = RWBUF(12), *T2 = RWBUF(13);
    LAS bf16_t *XTc = RWBUF(2), *L1 = RWBUF(3), *L1T = RWBUF(0), *T1 = RWBUF(10), *ABc = RWBUF(8), *UBc = RWBUF(9);
    LAS bf16_t *X1 = RWBUF(8), *X2 = RWBUF(9), *W2s = RWBUF(10), *A2s = RWBUF(11);
    LAS float *WPf = (LAS float*)(lds + 12 * RB), *APf = (LAS float*)(lds + 0 * RB), *Ef = (LAS float*)(lds + 2 * RB), *TOT = (LAS float*)(lds + 4 * RB);
    float pr[8], pk[8], pv[8], tmp[8], mu[8];
    {   float cur[8], prv[8];
        unpack8(*(const u32x4*)(P + tok * PW + C_LW + jq * 8), cur); unpack8(*(const u32x4*)(P + tokp * PW + C_LW + jq * 8), prv); ld8f(a.in[I_MUW] + d * 64 + jq * 8, mu);
#pragma unroll
        for (int j = 0; j < 8; ++j) { const float sh = has_prev ? prv[j] : 0.f; tmp[j] = tanhf(cur[j] + (sh - cur[j]) * mu[j]); }
        *(LAS u32x4*)(X1 + i * LP + jq * 8) = pack8(tmp);
        unpack8(*(const u32x4*)(P + tok * PW + C_LA + jq * 8), cur); unpack8(*(const u32x4*)(P + tokp * PW + C_LA + jq * 8), prv); ld8f(a.in[I_MUA] + d * 64 + jq * 8, mu);
#pragma unroll
        for (int j = 0; j < 8; ++j) { const float sh = has_prev ? prv[j] : 0.f; tmp[j] = cur[j] + (sh - cur[j]) * mu[j]; }
        *(LAS u32x4*)(X2 + i * LP + jq * 8) = pack8(tmp);
        *(LAS u32x4*)(W2s + i * LP + jq * 8) = *(const u32x4*)((const bf16_t*)(a.ws + WS_W2T) + ((size_t)d * 384 + h * 64 + i) * 64 + jq * 8);
        *(LAS u32x4*)(A2s + i * LP + jq * 8) = *(const u32x4*)((const bf16_t*)(a.ws + WS_A2T) + ((size_t)d * 384 + h * 64 + i) * 64 + jq * 8);
        unpack8(*(const u32x4*)(P + tok * PW + C_PR + ch0), cur); unpack8(*(const u32x4*)(P + tokp * PW + C_PR + ch0), prv); ld8f(a.in[I_MURKV] + (d * 3 + 0) * 384 + ch0, mu);
#pragma unroll
        for (int j = 0; j < 8; ++j) { const float sh = has_prev ? prv[j] : 0.f; pr[j] = cur[j] + (sh - cur[j]) * mu[j]; }
        unpack8(*(const u32x4*)(P + tok * PW + C_PK + ch0), cur); unpack8(*(const u32x4*)(P + tokp * PW + C_PK + ch0), prv); ld8f(a.in[I_MURKV] + (d * 3 + 1) * 384 + ch0, mu);
#pragma unroll
        for (int j = 0; j < 8; ++j) { const float sh = has_prev ? prv[j] : 0.f; pk[j] = cur[j] + (sh - cur[j]) * mu[j]; }
        unpack8(*(const u32x4*)(P + tok * PW + C_PV + ch0), cur); unpack8(*(const u32x4*)(P + tokp * PW + C_PV + ch0), prv); ld8f(a.in[I_MURKV] + (d * 3 + 2) * 384 + ch0, mu);
#pragma unroll
        for (int j = 0; j < 8; ++j) { const float sh = has_prev ? prv[j] : 0.f; pv[j] = cur[j] + (sh - cur[j]) * mu[j]; }
    }
    __syncthreads();
    {   f32x4 acc[2]; const int rt = wid >> 1, ct0 = 2 * (wid & 1);
        zero2(acc); mm64(X1, W2s, acc, wid, fr, fq);
#pragma unroll
        for (int cc = 0; cc < 2; ++cc)
#pragma unroll
            for (int g = 0; g < 4; ++g) WPf[(16 * rt + 4 * fq + g) * 64 + 16 * (ct0 + cc) + fr] = acc[cc][g];
        zero2(acc); mm64(X2, A2s, acc, wid, fr, fq);
#pragma unroll
        for (int cc = 0; cc < 2; ++cc)
#pragma unroll
            for (int g = 0; g < 4; ++g) APf[(16 * rt + 4 * fq + g) * 64 + 16 * (ct0 + cc) + fr] = acc[cc][g];
    }
    __syncthreads();
    float ev[8], ah[8], kk[8], kp[8];
    {   float w0[8], a0[8], kkw[8], kaw[8], wp[8], ap[8];
        ld8f(a.in[I_W0] + d * 384 + ch0, w0); ld8f(a.in[I_A0] + d * 384 + ch0, a0); ld8f(a.in[I_KK] + ch0, kkw); ld8f(a.in[I_KA] + ch0, kaw);
        { const f32x4 x0 = *(const LAS f32x4*)(WPf + i * 64 + jq * 8), x1 = *(const LAS f32x4*)(WPf + i * 64 + jq * 8 + 4); wp[0] = x0.x; wp[1] = x0.y; wp[2] = x0.z; wp[3] = x0.w; wp[4] = x1.x; wp[5] = x1.y; wp[6] = x1.z; wp[7] = x1.w; }
        { const f32x4 x0 = *(const LAS f32x4*)(APf + i * 64 + jq * 8), x1 = *(const LAS f32x4*)(APf + i * 64 + jq * 8 + 4); ap[0] = x0.x; ap[1] = x0.y; ap[2] = x0.z; ap[3] = x0.w; ap[4] = x1.x; ap[5] = x1.y; ap[6] = x1.z; ap[7] = x1.w; }
        float ss = 0.f;
#pragma unroll
        for (int j = 0; j < 8; ++j) {
            const float z = -(w0[j] + wp[j]);
            const float sp = (z > 20.f) ? z : log1pf(__expf(z));
            ev[j] = __expf(-sp - 0.5f);
            ah[j] = sigmoidf_(a0[j] + ap[j]);
            kk[j] = pk[j] * kkw[j]; ss += kk[j] * kk[j];
            kp[j] = pk[j] * (1.f + (ah[j] - 1.f) * kaw[j]);
        }
        ss += __shfl_xor(ss, 1); ss += __shfl_xor(ss, 2); ss += __shfl_xor(ss, 4);
        const float inv = 1.f / fmaxf(sqrtf(ss), 1e-12f);
#pragma unroll
        for (int j = 0; j < 8; ++j) kk[j] *= inv;
    }
    __syncthreads();
    *(LAS f32x4*)(Ef + i * 64 + jq * 8) = (f32x4){ev[0], ev[1], ev[2], ev[3]}; *(LAS f32x4*)(Ef + i * 64 + jq * 8 + 4) = (f32x4){ev[4], ev[5], ev[6], ev[7]};
    __syncthreads();
    {
        const int j = tid & 63, tq = tid >> 6; float run = 0.f;
#pragma unroll
        for (int s = 0; s < 8; ++s) { run += Ef[(tq * 8 + s) * 64 + j]; Ef[(tq * 8 + s) * 64 + j] = run; }
        TOT[tq * 64 + j] = run;
    }
    __syncthreads();
    float G[8], G63[8];
    {   const f32x4 x0 = *(const LAS f32x4*)(Ef + i * 64 + jq * 8), x1 = *(const LAS f32x4*)(Ef + i * 64 + jq * 8 + 4);
        G[0] = x0.x; G[1] = x0.y; G[2] = x0.z; G[3] = x0.w; G[4] = x1.x; G[5] = x1.y; G[6] = x1.z; G[7] = x1.w;
#pragma unroll
        for (int j = 0; j < 8; ++j) G63[j] = 0.f;
        const int tq = i >> 3;
#pragma unroll
        for (int q = 0; q < 8; ++q) { const f32x4 t0 = *(const LAS f32x4*)(TOT + q * 64 + jq * 8), t1 = *(const LAS f32x4*)(TOT + q * 64 + jq * 8 + 4);
            const float tt[8] = {t0.x, t0.y, t0.z, t0.w, t1.x, t1.y, t1.z, t1.w};
#pragma unroll
            for (int j = 0; j < 8; ++j) { G63[j] += tt[j]; if (q < tq) G[j] += tt[j]; } }
    }
    __syncthreads();
    {   float at[8], rt_[8], bt[8], kt[8], bh[8], kh[8];
#pragma unroll
        for (int j = 0; j < 8; ++j) {
            const float gi = __expf(-G[j]), gpi = __expf(-(G[j] - ev[j])), ig = __expf(G[j]), gc = __expf(-(G63[j] - G[j]));
            const float bb = kk[j] * ah[j];
            at[j] = -kk[j] * gpi; rt_[j] = pr[j] * gi; bt[j] = bb * ig; kt[j] = kp[j] * ig; bh[j] = bb * gc; kh[j] = kp[j] * gc;
        }
        *(LAS u32x4*)(AT + i * LP + jq * 8) = pack8(at); *(LAS u32x4*)(RT + i * LP + jq * 8) = pack8(rt_);
        *(LAS u32x4*)(BT + i * LP + jq * 8) = pack8(bt); *(LAS u32x4*)(KT + i * LP + jq * 8) = pack8(kt);
#pragma unroll
        for (int j = 0; j < 8; ++j) { const int cj = jq * 8 + j; ATc[cj * LP + i] = f2bf(at[j]); VTc[cj * LP + i] = f2bf(pv[j]); KHc[cj * LP + i] = f2bf(kh[j]); BHc[cj * LP + i] = f2bf(bh[j]); }
        if (i == 0) { float* RG = (float*)((unsigned char*)a.out + DO_RG) + (size_t)unit * 64 + jq * 8;
            *(f32x4*)RG = (f32x4){__expf(-G63[0]), __expf(-G63[1]), __expf(-G63[2]), __expf(-G63[3])}; *(f32x4*)(RG + 4) = (f32x4){__expf(-G63[4]), __expf(-G63[5]), __expf(-G63[6]), __expf(-G63[7])}; }
    }
    __syncthreads();
    f32x4 acc[2];
    zero2(acc); mm64(AT, BT, acc, wid, fr, fq); mask2<1>(acc, wid, fr, fq); store_rm(L0, acc, wid, fr, fq); store_tr(L0T, acc, wid, fr, fq);
    zero2(acc); mm64(AT, KT, acc, wid, fr, fq); mask2<1>(acc, wid, fr, fq); store_rm(AAK, acc, wid, fr, fq);
    zero2(acc); mm64(RT, BT, acc, wid, fr, fq); mask2<2>(acc, wid, fr, fq); store_rm(ARB, acc, wid, fr, fq);
    zero2(acc); mm64(RT, KT, acc, wid, fr, fq); mask2<2>(acc, wid, fr, fq); store_rm(ARK, acc, wid, fr, fq);
    __syncthreads();
    zero2(acc); mm64(AAK, VTc, acc, wid, fr, fq); store_tr(XTc, acc, wid, fr, fq);
    zero2(acc); mm64(L0, L0T, acc, wid, fr, fq); store_rm(L1, acc, wid, fr, fq); store_tr(L1T, acc, wid, fr, fq);
    __syncthreads();
    {   const int rt = wid >> 1, ct0 = 2 * (wid & 1);
#pragma unroll
        for (int cc = 0; cc < 2; ++cc)
#pragma unroll
            for (int g = 0; g < 4; ++g) { const int row = 16 * rt + 4 * fq + g, col = 16 * (ct0 + cc) + fr; const float v = bf2f(L0[row * LP + col]) + (row == col ? 1.f : 0.f); T1[row * LP + col] = f2bf(v); }
    }
    __syncthreads();
    {   LAS bf16_t *Lc = L1, *LcT = L1T, *Ln = L0, *LnT = L0T, *Tc = T1, *Tn = T2;
        const int rt = wid >> 1, ct0 = 2 * (wid & 1);
#pragma unroll 1
        for (int p = 1; p <= 5; ++p) {
#pragma unroll
            for (int cc = 0; cc < 2; ++cc)
#pragma unroll
                for (int g = 0; g < 4; ++g) acc[cc][g] = bf2f(Tc[(16 * rt + 4 * fq + g) * LP + 16 * (ct0 + cc) + fr]);
            mm64(Tc, LcT, acc, wid, fr, fq); store_rm(Tn, acc, wid, fr, fq);
            if (p < 5) { f32x4 a2[2]; zero2(a2); mm64(Lc, LcT, a2, wid, fr, fq); store_rm(Ln, a2, wid, fr, fq); store_tr(LnT, a2, wid, fr, fq); }
            __syncthreads();
            LAS bf16_t* t; t = Lc; Lc = Ln; Ln = t; t = LcT; LcT = LnT; LnT = t; t = Tc; Tc = Tn; Tn = t;
        }
    }
    LAS bf16_t* TF = T2;
    zero2(acc); mm64(TF, ATc, acc, wid, fr, fq); store_tr(ABc, acc, wid, fr, fq);
    zero2(acc); mm64(TF, XTc, acc, wid, fr, fq); store_tr(UBc, acc, wid, fr, fq);
    __syncthreads();
    {   const int rt = wid >> 1, ct0 = 2 * (wid & 1);
        bf16_t* RM = (bf16_t*)((unsigned char*)a.out + DO_RM) + (size_t)unit * 4096;
        zero2(acc); mm64(BHc, ABc, acc, wid, fr, fq);
#pragma unroll
        for (int cc = 0; cc < 2; ++cc)
#pragma unroll
            for (int g = 0; g < 4; ++g) RM[afrag_index(16 * rt + 4 * fq + g, 16 * (ct0 + cc) + fr)] = f2bf(acc[cc][g]);
        bf16_t* RN = (bf16_t*)(a.ws + WS_RN) + (size_t)unit * 4096;
        zero2(acc); mm64(VTc, KHc, acc, wid, fr, fq); mm64(UBc, BHc, acc, wid, fr, fq);
#pragma unroll
        for (int cc = 0; cc < 2; ++cc)
#pragma unroll
            for (int g = 0; g < 4; ++g) RN[nfrag_index(16 * rt + 4 * fq + g, 16 * (ct0 + cc) + fr)] = f2bf(acc[cc][g]);
        bf16_t* RR = (bf16_t*)((unsigned char*)a.out + DO_RR) + (size_t)unit * 4096;
#pragma unroll
        for (int cc = 0; cc < 2; ++cc)
#pragma unroll
            for (int g = 0; g < 4; ++g) acc[cc][g] = bf2f(RT[(16 * rt + 4 * fq + g) * LP + 16 * (ct0 + cc) + fr]);
        mm64(ARB, ABc, acc, wid, fr, fq);
#pragma unroll
        for (int cc = 0; cc < 2; ++cc)
#pragma unroll
            for (int g = 0; g < 4; ++g) RR[afrag_index(16 * rt + 4 * fq + g, 16 * (ct0 + cc) + fr)] = f2bf(acc[cc][g]);
        bf16_t* Y = (bf16_t*)(a.ws + (d ? WS_YB : WS_YRW));
        zero2(acc); mm64(ARB, UBc, acc, wid, fr, fq); mm64(ARK, VTc, acc, wid, fr, fq);
#pragma unroll
        for (int cc = 0; cc < 2; ++cc)
#pragma unroll
            for (int g = 0; g < 4; ++g) { const int ti = 16 * rt + 4 * fq + g, v = 16 * (ct0 + cc) + fr; Y[((size_t)b * SEQ + scan_tok(d, c, ti)) * RWW + h * 64 + v] = f2bf(acc[cc][g]); }
    }
    __syncthreads();
}

constexpr int R2_SLOT = 33792, R2_MF = 0, R2_RF = 8192, R2_NF = 16384, R2_YL = 24576, R2_GM = 32768;
__device__ __forceinline__ void r2_issue(const Args& a, LAS unsigned char* lds, int chain, int c, int q, int lane, int h, int b, int d) {
    LAS unsigned char* slot = lds + (c & 3) * R2_SLOT; const size_t unit = (size_t)chain * NCH + c;
    const unsigned char* RM = (const unsigned char*)a.out + DO_RM + unit * 8192; const unsigned char* RR = (const unsigned char*)a.out + DO_RR + unit * 8192;
    const unsigned char* RN = a.ws + WS_RN + unit * 8192; const unsigned char* Y = a.ws + (d ? WS_YB : WS_YRW);
#pragma unroll
    for (int pp = 0; pp < 2; ++pp) { const int p = q + 4 * pp;
        __builtin_amdgcn_global_load_lds((const unsigned*)(RM + p * 1024 + lane * 16), (LAS unsigned*)(slot + R2_MF + p * 1024), 16, 0, 0);
        __builtin_amdgcn_global_load_lds((const unsigned*)(RR + p * 1024 + lane * 16), (LAS unsigned*)(slot + R2_RF + p * 1024), 16, 0, 0);
        __builtin_amdgcn_global_load_lds((const unsigned*)(RN + p * 1024 + lane * 16), (LAS unsigned*)(slot + R2_NF + p * 1024), 16, 0, 0);
        const int L = p * 64 + lane, t = L >> 3, ch = L & 7;
        __builtin_amdgcn_global_load_lds((const unsigned*)(Y + (((size_t)b * SEQ + scan_tok(d, c, t)) * RWW + h * 64) * 2 + ch * 16), (LAS unsigned*)(slot + R2_YL + p * 1024), 16, 0, 0); }
    if (q == 0) __builtin_amdgcn_global_load_lds((const unsigned*)((const unsigned char*)a.out + DO_RG + unit * 256 + lane * 16), (LAS unsigned*)(slot + R2_GM), 16, 0, 0);
}
template <bool DRY> __device__ __forceinline__ void rwkv_state_wg(const Args& a, LAS unsigned char* lds, int chain, int tid) {
    const int wave = __builtin_amdgcn_readfirstlane(tid >> 6), lane = tid & 63, fr = lane & 15, fq = lane >> 4;
    const int h = chain % RWH, db = chain / RWH, b = db & 3, d = db >> 2;
    if (wave >= 4) {
        const int q = wave - 4;
        r2_issue(a, lds, chain, 0, q, lane, h, b, d); r2_issue(a, lds, chain, 1, q, lane, h, b, d);
#pragma unroll 1
        for (int c = 0; c < NCH; ++c) {
            if (c + 2 < NCH) { r2_issue(a, lds, chain, c + 2, q, lane, h, b, d); asm volatile("s_waitcnt vmcnt(16)" ::: "memory"); }
            else asm volatile("s_waitcnt vmcnt(0)" ::: "memory");
            __builtin_amdgcn_s_barrier();
        }
    } else {
        const int vg = wave;
        bf16_t* Y = (bf16_t*)(a.ws + (d ? WS_YB : WS_YRW));
        f32x4 S[4];
#pragma unroll
        for (int kt = 0; kt < 4; ++kt) S[kt] = (f32x4){0.f, 0.f, 0.f, 0.f};
#pragma unroll 1
        for (int c = 0; c < NCH; ++c) {
            asm volatile("s_waitcnt lgkmcnt(0)" ::: "memory");
            __builtin_amdgcn_s_barrier();
            asm volatile("" ::: "memory");
            const LAS unsigned char* slot = lds + (c & 3) * R2_SLOT;
            bf16x8 mf[4][2], rf[4][2];
#pragma unroll
            for (int t4 = 0; t4 < 4; ++t4)
#pragma unroll
                for (int s = 0; s < 2; ++s) { mf[t4][s] = *(const LAS bf16x8*)(slot + R2_MF + ((t4 * 2 + s) * 64 + lane) * 16); rf[t4][s] = *(const LAS bf16x8*)(slot + R2_RF + ((t4 * 2 + s) * 64 + lane) * 16); }
            const u32x4 n0 = *(const LAS u32x4*)(slot + R2_NF + (vg * 64 + lane) * 32), n1 = *(const LAS u32x4*)(slot + R2_NF + (vg * 64 + lane) * 32 + 16);
            f32x4 gm4[4];
#pragma unroll
            for (int kt = 0; kt < 4; ++kt) gm4[kt] = *(const LAS f32x4*)(slot + R2_GM + (16 * kt + 4 * fq) * 4);
            bf16x8 bs[2];
#pragma unroll
            for (int s = 0; s < 2; ++s) { u32x4 w; w.x = cvtpk(S[2 * s][0], S[2 * s][1]); w.y = cvtpk(S[2 * s][2], S[2 * s][3]); w.z = cvtpk(S[2 * s + 1][0], S[2 * s + 1][1]); w.w = cvtpk(S[2 * s + 1][2], S[2 * s + 1][3]); bs[s] = __builtin_bit_cast(bf16x8, w); }
#pragma unroll
            for (int tt = 0; tt < 4; ++tt) { f32x4 ya = (f32x4){0.f, 0.f, 0.f, 0.f};
                ya = __builtin_amdgcn_mfma_f32_16x16x32_bf16(rf[tt][0], bs[0], ya, 0, 0, 0); ya = __builtin_amdgcn_mfma_f32_16x16x32_bf16(rf[tt][1], bs[1], ya, 0, 0, 0);
#pragma unroll
                for (int g = 0; g < 4; ++g) { const int t = 16 * tt + 4 * fq + g; const float yl = bf2f(*(const LAS bf16_t*)(slot + R2_YL + t * 128 + (16 * vg + fr) * 2));
                    const float yv = ya[g] + yl; if (!DRY || yv == 12345.678f) Y[((size_t)b * SEQ + scan_tok(d, c, t)) * RWW + h * 64 + 16 * vg + fr] = f2bf(yv); } }
            const float nv[16] = {bflo(n0.x), bfhi(n0.x), bflo(n0.y), bfhi(n0.y), bflo(n0.z), bfhi(n0.z), bflo(n0.w), bfhi(n0.w), bflo(n1.x), bfhi(n1.x), bflo(n1.y), bfhi(n1.y), bflo(n1.z), bfhi(n1.z), bflo(n1.w), bfhi(n1.w)};
#pragma unroll
            for (int kt = 0; kt < 4; ++kt) { f32x4 na;
#pragma unroll
                for (int g = 0; g < 4; ++g) na[g] = S[kt][g] * gm4[kt][g] + nv[kt * 4 + g];
                na = __builtin_amdgcn_mfma_f32_16x16x32_bf16(mf[kt][0], bs[0], na, 0, 0, 0); na = __builtin_amdgcn_mfma_f32_16x16x32_bf16(mf[kt][1], bs[1], na, 0, 0, 0);
                S[kt] = na; }
        }
    }
    asm volatile("s_waitcnt vmcnt(0) lgkmcnt(0)" ::: "memory");
    __syncthreads();
}

__device__ __forceinline__ void rwkv_final_unit(const Args& a, LAS unsigned char* lds, int unit, int tid) {
    const int tc = unit & 127, h = (unit >> 7) % RWH, b = unit / (128 * RWH);
    const int wid = __builtin_amdgcn_readfirstlane(tid >> 6), lane = tid & 63, fr = lane & 15, fq = lane >> 4;
    const int i = tid >> 3, jq = tid & 7, ch0 = h * 64 + jq * 8;
    const bf16_t* P = (const bf16_t*)(a.ws + WS_P);
    const int s_cur = tc * 64 + i; const size_t tok = (size_t)b * SEQ + s_cur;
    LAS bf16_t *XA0 = RWBUF(0), *XA1 = RWBUF(1), *A2s0 = RWBUF(2), *A2s1 = RWBUF(3);
    LAS bf16_t *XG = (LAS bf16_t*)(lds + 4 * RB);
    LAS bf16_t *G2s = (LAS bf16_t*)(lds + 4 * RB + 64 * 136 * 2);
    LAS float *AP0 = (LAS float*)(lds + 8 * RB), *AP1 = (LAS float*)(lds + 8 * RB + 16384), *GP = (LAS float*)(lds + 8 * RB + 32768);
    float r_[2][8], k_[2][8], v_[2][8];
    {   float cur[8], nb[8], mu[8], tmp[8];
#pragma unroll
        for (int d = 0; d < 2; ++d) {
            const bool has = d ? (s_cur < SEQ - 1) : (s_cur > 0); const size_t tokp = has ? (d ? tok + 1 : tok - 1) : tok;
            unpack8(*(const u32x4*)(P + tok * PW + C_LA + jq * 8), cur); unpack8(*(const u32x4*)(P + tokp * PW + C_LA + jq * 8), nb); ld8f(a.in[I_MUA] + d * 64 + jq * 8, mu);
#pragma unroll
            for (int j = 0; j < 8; ++j) { const float sh = has ? nb[j] : 0.f; tmp[j] = cur[j] + (sh - cur[j]) * mu[j]; }
            *(LAS u32x4*)((d ? XA1 : XA0) + i * LP + jq * 8) = pack8(tmp); __builtin_amdgcn_sched_barrier(0);
            *(LAS u32x4*)((d ? A2s1 : A2s0) + i * LP + jq * 8) = *(const u32x4*)((const bf16_t*)(a.ws + WS_A2T) + ((size_t)d * 384 + h * 64 + i) * 64 + jq * 8);
            unpack8(*(const u32x4*)(P + tok * PW + C_PR + ch0), cur); unpack8(*(const u32x4*)(P + tokp * PW + C_PR + ch0), nb); ld8f(a.in[I_MURKV] + (d * 3 + 0) * 384 + ch0, mu);
#pragma unroll
            for (int j = 0; j < 8; ++j) { const float sh = has ? nb[j] : 0.f; r_[d][j] = cur[j] + (sh - cur[j]) * mu[j]; }
            __builtin_amdgcn_sched_barrier(0);
            unpack8(*(const u32x4*)(P + tok * PW + C_PK + ch0), cur); unpack8(*(const u32x4*)(P + tokp * PW + C_PK + ch0), nb); ld8f(a.in[I_MURKV] + (d * 3 + 1) * 384 + ch0, mu);
#pragma unroll
            for (int j = 0; j < 8; ++j) { const float sh = has ? nb[j] : 0.f; k_[d][j] = cur[j] + (sh - cur[j]) * mu[j]; }
            __builtin_amdgcn_sched_barrier(0);
            unpack8(*(const u32x4*)(P + tok * PW + C_PV + ch0), cur); unpack8(*(const u32x4*)(P + tokp * PW + C_PV + ch0), nb); ld8f(a.in[I_MURKV] + (d * 3 + 2) * 384 + ch0, mu);
#pragma unroll
            for (int j = 0; j < 8; ++j) { const float sh = has ? nb[j] : 0.f; v_[d][j] = cur[j] + (sh - cur[j]) * mu[j]; }
            __builtin_amdgcn_sched_barrier(0);
        }
#pragma unroll
        for (int q = 0; q < 2; ++q) {
            unpack8(*(const u32x4*)(P + tok * PW + C_LG + jq * 16 + q * 8), cur);
#pragma unroll
            for (int j = 0; j < 8; ++j) tmp[j] = sigmoidf_(cur[j]);
            *(LAS u32x4*)(XG + i * 136 + jq * 16 + q * 8) = pack8(tmp); __builtin_amdgcn_sched_barrier(0);
            *(LAS u32x4*)(G2s + i * 136 + jq * 16 + q * 8) = *(const u32x4*)((const bf16_t*)(a.ws + WS_G2T) + ((size_t)h * 64 + i) * 128 + jq * 16 + q * 8);
        }
    }
    __syncthreads();
    {   f32x4 acc[2]; const int rt = wid >> 1, ct0 = 2 * (wid & 1);
        zero2(acc); mm64(XA0, A2s0, acc, wid, fr, fq);
#pragma unroll
        for (int cc = 0; cc < 2; ++cc)
#pragma unroll
            for (int g = 0; g < 4; ++g) AP0[(16 * rt + 4 * fq + g) * 64 + 16 * (ct0 + cc) + fr] = acc[cc][g];
        zero2(acc); mm64(XA1, A2s1, acc, wid, fr, fq);
#pragma unroll
        for (int cc = 0; cc < 2; ++cc)
#pragma unroll
            for (int g = 0; g < 4; ++g) AP1[(16 * rt + 4 * fq + g) * 64 + 16 * (ct0 + cc) + fr] = acc[cc][g];
        zero2(acc);
#pragma unroll
        for (int s = 0; s < 4; ++s) { const bf16x8 af = *(const LAS bf16x8*)(XG + (16 * rt + fr) * 136 + 32 * s + 8 * fq);
#pragma unroll
            for (int cc = 0; cc < 2; ++cc) { const bf16x8 bfrag = *(const LAS bf16x8*)(G2s + (16 * (ct0 + cc) + fr) * 136 + 32 * s + 8 * fq); acc[cc] = __builtin_amdgcn_mfma_f32_16x16x32_bf16(af, bfrag, acc[cc], 0, 0, 0); } }
#pragma unroll
        for (int cc = 0; cc < 2; ++cc)
#pragma unroll
            for (int g = 0; g < 4; ++g) GP[(16 * rt + 4 * fq + g) * 64 + 16 * (ct0 + cc) + fr] = acc[cc][g];
    }
    __syncthreads();
    {   float bonus[8], rk[8], kaw[8], a0[8], ap[8];
#pragma unroll
        for (int j = 0; j < 8; ++j) bonus[j] = 0.f;
        ld8f(a.in[I_RK] + ch0, rk); ld8f(a.in[I_KA] + ch0, kaw);
#pragma unroll
        for (int d = 0; d < 2; ++d) {
            ld8f(a.in[I_A0] + d * 384 + ch0, a0);
            const LAS float* APd = d ? AP1 : AP0;
            { const f32x4 x0 = *(const LAS f32x4*)(APd + i * 64 + jq * 8), x1 = *(const LAS f32x4*)(APd + i * 64 + jq * 8 + 4); ap[0] = x0.x; ap[1] = x0.y; ap[2] = x0.z; ap[3] = x0.w; ap[4] = x1.x; ap[5] = x1.y; ap[6] = x1.z; ap[7] = x1.w; }
            float dot = 0.f;
#pragma unroll
            for (int j = 0; j < 8; ++j) { const float ahv = sigmoidf_(a0[j] + ap[j]); const float kp = k_[d][j] * (1.f + (ahv - 1.f) * kaw[j]); dot += r_[d][j] * kp * rk[j]; }
            dot += __shfl_xor(dot, 1); dot += __shfl_xor(dot, 2); dot += __shfl_xor(dot, 4);
#pragma unroll
            for (int j = 0; j < 8; ++j) bonus[j] += dot * v_[d][j];
        }
        float yf[8], yb[8], ys[8], lng[8], lnb[8], gg[8];
        bf16_t* YF = (bf16_t*)(a.ws + WS_YRW) + tok * RWW + ch0; const bf16_t* YBp = (const bf16_t*)(a.ws + WS_YB) + tok * RWW + ch0;
        unpack8(*(const u32x4*)YF, yf); unpack8(*(const u32x4*)YBp, yb); ld8f(a.in[I_LNG] + ch0, lng); ld8f(a.in[I_LNB] + ch0, lnb);
        { const f32x4 x0 = *(const LAS f32x4*)(GP + i * 64 + jq * 8), x1 = *(const LAS f32x4*)(GP + i * 64 + jq * 8 + 4); gg[0] = x0.x; gg[1] = x0.y; gg[2] = x0.z; gg[3] = x0.w; gg[4] = x1.x; gg[5] = x1.y; gg[6] = x1.z; gg[7] = x1.w; }
        float sm = 0.f;
#pragma unroll
        for (int j = 0; j < 8; ++j) { ys[j] = yf[j] + yb[j]; sm += ys[j]; }
        sm += __shfl_xor(sm, 1); sm += __shfl_xor(sm, 2); sm += __shfl_xor(sm, 4);
        const float mean = sm * (1.f / 64.f); float vs = 0.f;
#pragma unroll
        for (int j = 0; j < 8; ++j) { const float dd = ys[j] - mean; vs += dd * dd; }
        vs += __shfl_xor(vs, 1); vs += __shfl_xor(vs, 2); vs += __shfl_xor(vs, 4);
        const float rstd = 1.f / sqrtf(vs * (1.f / 64.f) + GN_EPS);
        float o[8];
#pragma unroll
        for (int j = 0; j < 8; ++j) o[j] = ((ys[j] - mean) * rstd * lng[j] + lnb[j] + bonus[j]) * gg[j];
        *(u32x4*)YF = pack8(o);
    }
    __syncthreads();
}
#ifndef ONE_LAUNCH
#define ONE_LAUNCH 1
#endif
constexpr int NPHASE = 12;
#ifndef REPMASK
#define REPMASK 0
#endif
#define NREP(k) (1 + ((REPMASK >> (k)) & 1))
#ifndef FUSED_MASK
#define FUSED_MASK 0xfff
#endif
#define XB_TMO      128
#define XB_XCNT(j)  (256  + 64 * (j))
#define XB_XSUB(j)  (1280 + 64 * (j))
#define XB_XGEN(j)  (2304 + 64 * (j))
#define XB_TOP      3328
#define XB_TOPGEN   3392
#define XCD_BAR_WORDS 3456
#define XB_SPIN_CAP (1u << 22)
__device__ __forceinline__ unsigned xb_ld(unsigned* p)              { return __hip_atomic_load(p, __ATOMIC_RELAXED, __HIP_MEMORY_SCOPE_AGENT); }
__device__ __forceinline__ unsigned xb_add(unsigned* p, unsigned v) { return __hip_atomic_fetch_add(p, v, __ATOMIC_RELAXED, __HIP_MEMORY_SCOPE_AGENT); }
__device__ __forceinline__ unsigned xb_xcc_id() { return (unsigned)__builtin_amdgcn_s_getreg((3 << 11) | 20) & 0xFu; }
#define XB_SPIN(cond, bar) do { unsigned _sp = 0; while (cond) { __builtin_amdgcn_s_sleep(1); \
    if ((++_sp & 255u) == 0u) { if (xb_ld(&(bar)[XB_TMO])) break; if (_sp > XB_SPIN_CAP) { atomicAdd(&(bar)[XB_TMO], 1u); break; } } } } while (0)
struct XcdBarrier { unsigned* bar; unsigned x; volatile LAS unsigned* st; };
__device__ __forceinline__ XcdBarrier xcd_barrier_post(unsigned* bar, volatile LAS unsigned* st) {
    XcdBarrier b; b.bar = bar; b.x = xb_xcc_id(); b.st = st;
    if (threadIdx.x == 0) (void)xb_add(&bar[XB_XCNT(b.x)], 1u);
    return b;
}
__device__ __forceinline__ void xcd_barrier_complete(unsigned* bar, unsigned x, unsigned& nloc, unsigned& nx) {
    const unsigned G = gridDim.x * gridDim.y * gridDim.z;
    unsigned sum, cnt, mine, sp = 0u;
    for (;;) {
        sum = 0u; cnt = 0u; mine = 0u;
#pragma unroll
        for (unsigned j = 0; j < 16; ++j) { const unsigned c = xb_ld(&bar[XB_XCNT(j)]); sum += c; cnt += (c > 0u) ? 1u : 0u; mine = (j == x) ? c : mine; }
        if (sum == G) break;
        __builtin_amdgcn_s_sleep(1);
        if ((++sp & 255u) == 0u) { if (xb_ld(&bar[XB_TMO])) break; if (sp > XB_SPIN_CAP) { atomicAdd(&bar[XB_TMO], 1u); break; } }
    }
    nloc = mine > 0u ? mine : 1u; nx = cnt > 0u ? cnt : 1u;
}
__device__ __forceinline__ void xcd_barrier(const XcdBarrier& b) {
    asm volatile("s_waitcnt vmcnt(0)" ::: "memory");
    __syncthreads();
    if (threadIdx.x == 0) {
        unsigned* bar = b.bar;
        __builtin_amdgcn_s_waitcnt(0);
        unsigned nloc = b.st[0], nx = b.st[1];
        if (nloc == 0u) { xcd_barrier_complete(bar, b.x, nloc, nx); b.st[0] = nloc; b.st[1] = nx; }
        const unsigned old = xb_add(&bar[XB_XSUB(b.x)], 1u);
        const unsigned gen = old / nloc;
        if (old + 1u == (gen + 1u) * nloc) {
            __builtin_amdgcn_fence(__ATOMIC_RELEASE, "agent");
            asm volatile("s_waitcnt vmcnt(0)" ::: "memory");
            const unsigned og = xb_add(&bar[XB_TOP], 1u);
            const unsigned tg = og / nx;
            if (og + 1u == (tg + 1u) * nx) xb_add(&bar[XB_TOPGEN], 1u);
            else XB_SPIN(xb_ld(&bar[XB_TOPGEN]) == tg, bar);
            __builtin_amdgcn_fence(__ATOMIC_ACQUIRE, "agent");
            xb_add(&bar[XB_XGEN(b.x)], 1u);
            asm volatile("s_waitcnt vmcnt(0)" ::: "memory");
        } else {
            XB_SPIN(xb_ld(&bar[XB_XGEN(b.x)]) == gen, bar);
            __builtin_amdgcn_fence(__ATOMIC_ACQUIRE, "agent");
            asm volatile("s_waitcnt vmcnt(0)" ::: "memory");
        }
    }
    __syncthreads();
}
typedef const __attribute__((address_space(4))) Args* KArgP;
#if defined(__HIP_DEVICE_COMPILE__)
__device__ __forceinline__ void load_args(Args& a) {
    KArgP ap_ = (KArgP)__builtin_amdgcn_kernarg_segment_ptr(); asm volatile("" : "+s"(ap_));
#pragma unroll
    for (int i = 0; i < 30; ++i) a.in[i] = ap_->in[i];
    a.out = ap_->out; a.ws = ap_->ws; a.ph_lo = 0; a.ph_hi = 0;
}
#define PHASE_ARGS Args a; load_args(a); unsigned char* ws = a.ws; (void)ws
#else
#define PHASE_ARGS const Args a = a_in; unsigned char* ws = a.ws; (void)ws
#endif
template <int PHM> __global__ void __launch_bounds__(NTHR, 2) fwd_kernel(Args a_in) {
    extern __shared__ __attribute__((aligned(16))) unsigned char lds_raw[];
    LAS unsigned char* lds = (LAS unsigned char*)lds_raw;
    const int tid = threadIdx.x, lane = tid & 63, wave = __builtin_amdgcn_readfirstlane(tid >> 6);
    const int G = gridDim.x, bx = blockIdx.x;
    const int ph_lo = a_in.ph_lo, ph_hi = a_in.ph_hi;
#if ONE_LAUNCH
    cg::grid_group grid = cg::this_grid();
    volatile LAS unsigned* xst = (volatile LAS unsigned*)(lds + LDS_BYTES - 64);
    if (tid < 2) xst[tid] = 0u;
    __syncthreads();
    XcdBarrier xbar = xcd_barrier_post((unsigned*)a_in.ws, xst);
#define SEAM(k) do { if ((k) + 1 < ph_hi) { if ((k) == 0) grid.sync(); else xcd_barrier(xbar); } } while (0)
#else
#define SEAM(k) do { } while (0)
#endif
#define IN(k) (((PHM >> (k)) & 1) && ph_lo <= (k) && (k) < ph_hi)
    if (IN(0)) { PHASE_ARGS; for (int rep = 0; rep < NREP(0); ++rep) phase_prologue(a, lds, wave, lane); SEAM(0); }
    if (IN(1)) { PHASE_ARGS;
        SchedIn S{16, 2048u, 2048u, (const char*)(ws + WS_XN), (const char*)(ws + WS_WIN), (const char*)(ws + WS_MEMN), (const char*)(ws + WS_WMKV), G, bx};
        EpiIn E{(bf16_t*)(ws + WS_P), (bf16_t*)(ws + WS_G), (bf16_t*)(ws + WS_MKV)};
        for (int rep = 0; rep < NREP(1); ++rep) gm::gemm_phase<EpiIn, SchedIn>(lds, S, E);
        SEAM(1);
    }
    if (IN(2)) { PHASE_ARGS;
        for (int rep = 0; rep < NREP(12); ++rep) for (int u = bx; u < NB * GROWS * NAH; u += G) na_unit(a, lds, u, tid);
        for (int rep = 0; rep < NREP(13); ++rep) for (int u = bx; u < NB * MEMH * 16; u += G) mem_unit(a, lds, u, tid);
        for (int rep = 0; rep < NREP(14); ++rep) for (int u = bx; u < 2 * NB * RWH * NCH; u += G) rwkv_chunk_unit(a, lds, u, tid);
        SEAM(2);
    }
    if (IN(3)) { PHASE_ARGS;
        for (int ch = bx; ch < 2 * NB * RWH; ch += G) { if (NREP(3) > 1) rwkv_state_wg<true>(a, lds, ch, tid); rwkv_state_wg<false>(a, lds, ch, tid); }
        SEAM(3);
    }
    if (IN(4)) { PHASE_ARGS;
        for (int u = bx; u < NB * RWH * NCH; u += G) rwkv_final_unit(a, lds, u, tid);
        SEAM(4);
    }
    if (IN(5)) { PHASE_ARGS;
        const bf16_t* WBR = (const bf16_t*)(ws + WS_WBR);
        { SchedMerge S{6, 768u, 768u, (const char*)(ws + WS_YNA), (const char*)WBR, G, bx}; EpiMerge E{(const bf16_t*)(ws + WS_G), (bf16_t*)(ws + WS_MERGED), 0}; gm::gemm_phase<EpiMerge, SchedMerge>(lds, S, E); }
        VM_WAIT(); __syncthreads();
        { SchedMerge S{6, 768u, 768u, (const char*)(ws + WS_YRW), (const char*)(WBR + 1024 * 384), G, bx}; EpiMerge E{(const bf16_t*)(ws + WS_G), (bf16_t*)(ws + WS_MERGED), 1}; gm::gemm_phase<EpiMerge, SchedMerge>(lds, S, E); }
        VM_WAIT(); __syncthreads();
        { SchedMerge S{4, 512u, 512u, (const char*)(ws + WS_YMEM), (const char*)(WBR + 2 * 1024 * 384), G, bx}; EpiMerge E{(const bf16_t*)(ws + WS_G), (bf16_t*)(ws + WS_MERGED), 2}; gm::gemm_phase<EpiMerge, SchedMerge>(lds, S, E); }
        SEAM(5);
    }
    if (IN(6)) { PHASE_ARGS;
        SchedOut S{16, 2048u, 2048u, (const char*)(ws + WS_MERGED), (const char*)(ws + WS_WOUT), G, bx}; EpiOut E{a.in[I_X], a.out};
        for (int rep = 0; rep < NREP(6); ++rep) gm::gemm_phase<EpiOut, SchedOut>(lds, S, E);
        SEAM(6);
    }
    if (IN(7)) { PHASE_ARGS;
        {
            const f32x4* src = (const f32x4*)a.in[I_WROUTER]; LAS f32x4* dst = (LAS f32x4*)lds;
            for (int q = tid; q < DM * NE / 4; q += NTHR) dst[q] = src[q];
            __syncthreads();
        }
        for (int rep = 0; rep < NREP(7); ++rep) phase_norm_router(a, lds, wave, lane);
        SEAM(7);
    }
    if (IN(8)) { PHASE_ARGS;
        if (bx < NB * NE) topk_unit(a, lds, bx, tid);
        for (int rep = 0; rep < NREP(8); ++rep) expert_convert(a, lds, wave, lane, bx * NWAVES + wave, G * NWAVES);
        SEAM(8);
    }
    if (IN(9)) { PHASE_ARGS;
        SchedMoe1 S{16, 2048u, 2048u, (const char*)(ws + WS_XN), (const char*)(ws + WS_WGU), (const int*)(ws + WS_TIDX), G, bx}; EpiMoe1 E{(bf16_t*)(ws + WS_ACT)};
        for (int rep = 0; rep < NREP(9); ++rep) gm::gemm_phase<EpiMoe1, SchedMoe1>(lds, S, E);
        SEAM(9);
    }
    if (IN(10)) { PHASE_ARGS;
        SchedMoe2 S{32, 4096u, 4096u, (const char*)(ws + WS_ACT), (const char*)(ws + WS_WD), G, bx}; EpiMoe2 E{(bf16_t*)(ws + WS_YE), (const float*)(ws + WS_TVAL)};
        for (int rep = 0; rep < NREP(10); ++rep) gm::gemm_phase<EpiMoe2, SchedMoe2>(lds, S, E);
        SEAM(10);
    }
    if (IN(11)) { PHASE_ARGS; phase_final(a, wave, lane); }
#undef IN
#undef SEAM
}

template <int PHM> static bool prep_kernel(int& per_cu) {
    if (hipFuncSetAttribute((const void*)fwd_kernel<PHM>, hipFuncAttributeMaxDynamicSharedMemorySize, LDS_BYTES) != hipSuccess) return false;
    int pc = 0; if (hipOccupancyMaxActiveBlocksPerMultiprocessor(&pc, (const void*)fwd_kernel<PHM>, NTHR, LDS_BYTES) != hipSuccess) pc = 0;
    (void)hipGetLastError(); if (pc < per_cu) per_cu = pc; return true;
}
template <int P> static void launch_phase(int grid, Args a, hipStream_t stream) { a.ph_lo = P; a.ph_hi = P + 1; hipLaunchKernelGGL(fwd_kernel<(1 << P)>, dim3(grid), dim3(NTHR), LDS_BYTES, stream, a); }
extern "C" void kernel_launch(void* const* d_in, const int* in_sizes, int n_in, void* d_out, int out_size, void* d_ws, size_t ws_size, hipStream_t stream) {
    static int grid = 0;
    if (grid == 0) {
        if (n_in != 30 || out_size != T * DM || ws_size < WS_END) { fprintf(stderr, "kernel_launch: unexpected sizes: n_in %d out %d ws %zu (need %zu)\n", n_in, out_size, ws_size, (size_t)WS_END); grid = -1; return; }
        int dev = 0, cus = 0, per_cu = 99; bool ok = true;
        if (hipGetDevice(&dev) != hipSuccess || hipDeviceGetAttribute(&cus, hipDeviceAttributeMultiprocessorCount, dev) != hipSuccess) ok = false;
#if ONE_LAUNCH
        ok = ok && prep_kernel<FUSED_MASK>(per_cu);
#else
        ok = ok && prep_kernel<1>(per_cu) && prep_kernel<2>(per_cu) && prep_kernel<4>(per_cu) && prep_kernel<8>(per_cu) && prep_kernel<16>(per_cu) && prep_kernel<32>(per_cu) && prep_kernel<64>(per_cu)
                && prep_kernel<128>(per_cu) && prep_kernel<256>(per_cu) && prep_kernel<512>(per_cu) && prep_kernel<1024>(per_cu) && prep_kernel<2048>(per_cu);
#endif
        if (!ok || per_cu < 1) { fprintf(stderr, "kernel_launch: set-up failed (ok %d, per_cu %d)\n", (int)ok, per_cu); grid = -1; return; }
        grid = cus;
        fprintf(stderr, "kernel_launch: grid %d, per_cu %d, ws %zu\n", grid, per_cu, ws_size);
    }
    if (grid < 0) return;
    if (hipMemsetAsync(d_ws, 0, 16384, stream) != hipSuccess) { fprintf(stderr, "kernel_launch: memset failed\n"); return; }
    Args a{};
    for (int i = 0; i < 30; ++i) a.in[i] = (const float*)d_in[i];
    a.out = (float*)d_out; a.ws = (unsigned char*)d_ws;
#if ONE_LAUNCH
    a.ph_lo = 0; a.ph_hi = NPHASE;
    void* args[] = {&a};
    hipError_t e = hipLaunchCooperativeKernel((const void*)fwd_kernel<FUSED_MASK>, dim3(grid), dim3(NTHR), args, LDS_BYTES, stream);
    if (e != hipSuccess) fprintf(stderr, "cooperative launch failed: %s\n", hipGetErrorString(e));
#else
    launch_phase<0>(grid, a, stream); launch_phase<1>(grid, a, stream); launch_phase<2>(grid, a, stream); launch_phase<3>(grid, a, stream); launch_phase<4>(grid, a, stream); launch_phase<5>(grid, a, stream);
    launch_phase<6>(grid, a, stream); launch_phase<7>(grid, a, stream); launch_phase<8>(grid, a, stream); launch_phase<9>(grid, a, stream); launch_phase<10>(grid, a, stream); launch_phase<11>(grid, a, stream);
#endif
}
```

```cpp
#include <hip/hip_runtime.h>
#include <hip/hip_cooperative_groups.h>
#include <cstdio>
#include <cstdint>
namespace cg = cooperative_groups;

#define LAS __attribute__((address_space(3)))
typedef unsigned short bf16_t;
typedef short bf16x8 __attribute__((ext_vector_type(8)));
typedef short s16x4 __attribute__((ext_vector_type(4)));
typedef float f32x4 __attribute__((ext_vector_type(4)));
typedef float f32x2 __attribute__((ext_vector_type(2)));
typedef unsigned u32x4 __attribute__((ext_vector_type(4)));
typedef unsigned u32x2 __attribute__((ext_vector_type(2)));
typedef __bf16 bf16x2_t __attribute__((ext_vector_type(2)));

constexpr int DM = 1024, NB = 4, SEQ = 8192, T = NB * SEQ, GRIDW = 64, GROWS = SEQ / GRIDW, NMEM = 256, HD = 64;
constexpr int NAH = 6, NAW = 384, RWH = 6, RWW = 384, MEMH = 4, MEMW = 256, NE = 16, CAP = 1024, FF = 2048;
constexpr int DIN = 5888, PW = 2816, GWD = 3072;
constexpr int C_NAQ = 0, C_NAK = 384, C_NAV = 768, C_PR = 1152, C_PK = 1536, C_PV = 1920, C_LW = 2304, C_LA = 2368, C_LG = 2432, C_MQ = 2560;
constexpr int NCH = SEQ / 64;
constexpr float RMS_EPS = 1e-6f, GN_EPS = 64e-5f;

constexpr size_t MiB = (size_t)1 << 20;
constexpr size_t WS_CTL = 0;
constexpr size_t WS_W2T = 1 * MiB;
constexpr size_t WS_A2T = WS_W2T + 98304;
constexpr size_t WS_G2T = WS_A2T + 98304;
constexpr size_t WS_AFF = 2 * MiB;
constexpr size_t WS_TIDX = 4 * MiB;
constexpr size_t WS_TVAL = WS_TIDX + 262144;
constexpr size_t WS_SLOT = 5 * MiB;
constexpr size_t WS_WIN = 8 * MiB;
constexpr size_t WS_WBR = 20 * MiB;
constexpr size_t WS_WOUT = 22 * MiB;
constexpr size_t WS_WMKV = 24 * MiB;
constexpr size_t WS_MEMN = 25 * MiB;
constexpr size_t WS_MKV = 27 * MiB;
constexpr size_t WS_XN = 28 * MiB;
constexpr size_t WS_YNA = WS_XN, WS_YMEM = WS_XN + 24 * MiB, WS_YRW = WS_XN + 40 * MiB;
constexpr size_t WS_P = 92 * MiB;
constexpr size_t WS_G = 268 * MiB;
constexpr size_t WS_RN = 460 * MiB;
constexpr size_t WS_YB = 508 * MiB;
constexpr size_t WS_MERGED = 460 * MiB;
constexpr size_t WS_WGU = 92 * MiB;
constexpr size_t WS_WD = 220 * MiB;
constexpr size_t WS_ACT = 284 * MiB;
constexpr size_t WS_YE = 92 * MiB;
constexpr size_t WS_END = 540 * MiB;
constexpr size_t DO_RM = 0;
constexpr size_t DO_RR = 48 * MiB;
constexpr size_t DO_RG = 96 * MiB;

__device__ __forceinline__ unsigned cvtpk(float lo, float hi) { f32x2 v = {lo, hi}; bf16x2_t b = __builtin_convertvector(v, bf16x2_t); return __builtin_bit_cast(unsigned, b); }
__device__ __forceinline__ bf16_t f2bf(float f) { return (bf16_t)(cvtpk(f, 0.f) & 0xffffu); }
__device__ __forceinline__ float bf2f(unsigned h) { return __uint_as_float(h << 16); }
__device__ __forceinline__ float bflo(unsigned w) { return __uint_as_float(w << 16); }
__device__ __forceinline__ float bfhi(unsigned w) { return __uint_as_float(w & 0xffff0000u); }
__device__ __forceinline__ float wave_sum(float v) {
#pragma unroll
    for (int o = 1; o < 64; o <<= 1) v += __shfl_xor(v, o);
    return v;
}
__device__ __forceinline__ float sigmoidf_(float x) { return 1.f / (1.f + __expf(-x)); }
#define LDS_WAIT() asm volatile("s_waitcnt lgkmcnt(0)" ::: "memory")
#define VM_WAIT() asm volatile("s_waitcnt vmcnt(0)" ::: "memory")
__device__ __forceinline__ void unpack8(const u32x4 w, float (&o)[8]) { o[0] = bflo(w.x); o[1] = bfhi(w.x); o[2] = bflo(w.y); o[3] = bfhi(w.y); o[4] = bflo(w.z); o[5] = bfhi(w.z); o[6] = bflo(w.w); o[7] = bfhi(w.w); }
__device__ __forceinline__ u32x4 pack8(const float (&o)[8]) { u32x4 w; w.x = cvtpk(o[0], o[1]); w.y = cvtpk(o[2], o[3]); w.z = cvtpk(o[4], o[5]); w.w = cvtpk(o[6], o[7]); return w; }
__device__ __forceinline__ void ld8f(const float* p, float (&o)[8]) { const f32x4 a = *(const f32x4*)p, b = *(const f32x4*)(p + 4); o[0] = a.x; o[1] = a.y; o[2] = a.z; o[3] = a.w; o[4] = b.x; o[5] = b.y; o[6] = b.z; o[7] = b.w; }

#ifndef PROBE_SEG
#define PROBE_SEG 0
#endif
struct SegT { unsigned long long acc, t0; };
#define SEG_T0(id) do { if (PROBE_SEG == (id)) { sg.t0 = __builtin_amdgcn_s_memrealtime(); } } while (0)
#define SEG_T1(id) do { if (PROBE_SEG == (id)) { sg.acc += __builtin_amdgcn_s_memrealtime() - sg.t0; } } while (0)
#define SEG_SPIN() do { if (PROBE_SEG != 0) { const unsigned long long te_ = __builtin_amdgcn_s_memrealtime() + sg.acc; while (__builtin_amdgcn_s_memrealtime() < te_) __builtin_amdgcn_s_sleep(4); sg.acc = 0ull; } } while (0)
namespace gm {
constexpr int BM = 256, BK = 64, HALF = 128, HTB = HALF * BK * 2  , STAGE_BYTES = 8 * HTB, NXCD = 8, WGM = 8;
__device__ __forceinline__ int lds_byte(int r, int c) { const int st = (r >> 4) * 2 + (c >> 5), rr = r & 15, cc = c & 31, ob = rr * 64 + cc * 2; return st * 1024 + (ob ^ (((ob >> 9) & 1) << 5)); }
__device__ __forceinline__ void stage_rc(int b, int& R, int& C) { const int st = b / 1024, sb = b % 1024, swz = sb ^ (((sb >> 9) & 1) << 5); R = (st >> 1) * 16 + swz / 64; C = (st & 1) * 32 + (swz % 64) / 2; }
__device__ __forceinline__ int perm32(int rho) { const int n = rho >> 4, i = rho & 15; return 8 * (i >> 2) + 4 * n + (i & 3); }

struct GUnit { const char* A; const char* B; const int* gidx; int pm, pn, aux; };

__device__ __forceinline__ void tile_of(int L, int nM, int nN, int& pm, int& pn) {
    const int nwg = nM * nN; int wgid = L;
    { const int q = nwg / NXCD, r = nwg % NXCD, xcd = wgid % NXCD, off = wgid / NXCD; wgid = (xcd < r ? xcd * (q + 1) : r * (q + 1) + (xcd - r) * q) + off; }
    const int nig = WGM * nN, gid = wgid / nig, fm = gid * WGM, gsz = (nM - fm) < WGM ? (nM - fm) : WGM;
    pm = fm + ((wgid % nig) % gsz); pn = (wgid % nig) / gsz;
}

template <class Epi, class Sched>
__device__ __forceinline__ void gemm_phase(LAS unsigned char* lds, const Sched& S, const Epi& E) {
    const int tid = threadIdx.x, wid = __builtin_amdgcn_readfirstlane(tid >> 6), lane = tid & 63, wr = wid >> 2, wc = wid & 3, fr = lane & 15, fq = lane >> 4;
    const int nt = S.nt;
    const unsigned lda2 = S.lda2, ldb2 = S.ldb2;
    int RA[2]; unsigned C2[2]; unsigned voffA[2], voffB[2];
#pragma unroll
    for (int i = 0; i < 2; ++i) { int R, C; stage_rc(tid * 16 + i * 8192, R, C); const int Rb = Epi::PERM ? ((R & ~31) + perm32(R & 31)) : R;
        RA[i] = R; C2[i] = (unsigned)C * 2u; voffA[i] = (unsigned)R * lda2 + C2[i]; voffB[i] = (unsigned)Rb * ldb2 + C2[i]; }
    const size_t kstep = (size_t)(BK * 2);
    const size_t hstepA = (size_t)HALF * lda2, hstepB = (size_t)HALF * ldb2;
    const unsigned ldsw = (unsigned)wid * 1024u;
    const int aoff = lds_byte(wr * 64 + fr, fq * 8), boff = lds_byte(wc * 32 + fr, fq * 8);
#define PG8_SA(b, h) (((b) * 2 + (h)) * HTB)
#define PG8_SB(b, h) ((4 + (b) * 2 + (h)) * HTB)
#define PG8_STAGE(bufoff, gbase, voff) do { _Pragma("unroll") for (int _i = 0; _i < 2; ++_i) \
        __builtin_amdgcn_global_load_lds((const unsigned*)((const char*)(gbase) + (voff)[_i]), (LAS unsigned*)(lds + (bufoff) + ldsw + _i * 8192), 16, 0, 0); } while (0)
#define PG8_STAGE_A(bufoff, gbase, h, VO) do { if constexpr (Sched::GATHER) { PG8_STAGE(bufoff, gbase, (VO)[h]); } else { PG8_STAGE(bufoff, (gbase) + (h) * hstepA, voffA); } } while (0)
#define PG8_LDA(dst, b, h) do { _Pragma("unroll") for (int m = 0; m < 4; ++m) _Pragma("unroll") for (int k = 0; k < 2; ++k) dst[m][k] = *(const LAS bf16x8*)(lds + PG8_SA(b, h) + aoff + m * 2048 + k * 1024); } while (0)
#define PG8_LDB(dst, b, h) do { _Pragma("unroll") for (int n = 0; n < 2; ++n) _Pragma("unroll") for (int k = 0; k < 2; ++k) dst[n][k] = *(const LAS bf16x8*)(lds + PG8_SB(b, h) + boff + n * 2048 + k * 1024); } while (0)
#define PG8_MMA(ai, bj, At, Bt) do { __builtin_amdgcn_s_setprio(1); _Pragma("unroll") for (int m = 0; m < 4; ++m) _Pragma("unroll") for (int n = 0; n < 2; ++n) _Pragma("unroll") for (int k = 0; k < 2; ++k) \
        acc[ai][bj][m][n] = __builtin_amdgcn_mfma_f32_16x16x32_bf16(Bt[n][k], At[m][k], acc[ai][bj][m][n], 0, 0, 0); __builtin_amdgcn_s_setprio(0); } while (0)
#define PG8_WAIT_V(n) asm volatile("s_waitcnt vmcnt(" #n ")" ::: "memory")
#define PG8_WAIT_L(n) asm volatile("s_waitcnt lgkmcnt(" #n ")" ::: "memory")
#define PG8_BAR __builtin_amdgcn_s_barrier()
#define PG8_SCHED __builtin_amdgcn_sched_barrier(0)
    GUnit cur, nxt; int ui = 0;
    if (!S.next(0, cur)) return;
    f32x4 acc[2][2][4][2];
#pragma unroll
    for (int a = 0; a < 2; ++a)
#pragma unroll
        for (int b = 0; b < 2; ++b)
#pragma unroll
            for (int m = 0; m < 4; ++m)
#pragma unroll
                for (int n = 0; n < 2; ++n) acc[a][b][m][n] = (f32x4){0.f, 0.f, 0.f, 0.f};
    bf16x8 At[4][2], B0[2][2], B1[2][2];
    const char* cA = cur.A; const char* cB = cur.B;
    unsigned cvo[2][2], nvo[2][2];
    if constexpr (Sched::GATHER) {
#pragma unroll
        for (int h = 0; h < 2; ++h)
#pragma unroll
            for (int i = 0; i < 2; ++i) { cvo[h][i] = (unsigned)cur.gidx[h * HALF + RA[i]] * lda2 + C2[i]; nvo[h][i] = cvo[h][i]; }
    }
    PG8_STAGE(PG8_SB(0, 0), cB, voffB); PG8_STAGE(PG8_SB(0, 1), cB + hstepB, voffB); PG8_STAGE_A(PG8_SA(0, 0), cA, 0, cvo); PG8_STAGE_A(PG8_SA(0, 1), cA, 1, cvo);
    if (wr == 1) PG8_BAR;
    PG8_WAIT_V(2); PG8_BAR;
    PG8_STAGE(PG8_SB(1, 0), cB + kstep, voffB); PG8_STAGE_A(PG8_SA(1, 0), cA + kstep, 0, cvo); PG8_STAGE(PG8_SB(1, 1), cB + hstepB + kstep, voffB);
    PG8_WAIT_V(6); PG8_BAR;
    for (;;) {
        const bool has_next = S.next(ui + 1, nxt);
        const char* nA = has_next ? nxt.A : cA; const char* nB = has_next ? nxt.B : cB;
        int gi[2][2];
        if constexpr (Sched::GATHER) {
            const int* gp = has_next ? nxt.gidx : cur.gidx;
#pragma unroll
            for (int h = 0; h < 2; ++h)
#pragma unroll
                for (int i = 0; i < 2; ++i) gi[h][i] = gp[h * HALF + RA[i]];
        }
        for (int t = 0; t < nt; t += 2) {
            const bool last = (t == nt - 2);
            const char* a1 = cA + (size_t)(t + 1) * kstep;
            const char* a2 = last ? nA : cA + (size_t)(t + 2) * kstep; const char* b2 = last ? nB : cB + (size_t)(t + 2) * kstep;
            const char* a3 = a2 + kstep; const char* b3 = b2 + kstep;
            unsigned vo2[2][2];
            if constexpr (Sched::GATHER) {
                if (last) {
#pragma unroll
                    for (int h = 0; h < 2; ++h)
#pragma unroll
                        for (int i = 0; i < 2; ++i) nvo[h][i] = (unsigned)gi[h][i] * lda2 + C2[i];
                }
#pragma unroll
                for (int h = 0; h < 2; ++h)
#pragma unroll
                    for (int i = 0; i < 2; ++i) vo2[h][i] = last ? nvo[h][i] : cvo[h][i];
            }
            PG8_LDB(B0, 0, 0); PG8_LDB(B1, 0, 1); PG8_SCHED; PG8_LDA(At, 0, 0); PG8_STAGE_A(PG8_SA(1, 1), a1, 1, cvo);
            PG8_WAIT_V(8); PG8_WAIT_L(0); PG8_BAR; PG8_MMA(0, 0, At, B0); PG8_MMA(0, 1, At, B1); PG8_BAR; PG8_SCHED;
            PG8_LDA(At, 0, 1); PG8_STAGE(PG8_SB(0, 0), b2, voffB); PG8_STAGE(PG8_SB(0, 1), b2 + hstepB, voffB); PG8_STAGE_A(PG8_SA(0, 0), a2, 0, vo2);
            PG8_WAIT_V(8); PG8_WAIT_L(0); PG8_BAR; PG8_MMA(1, 0, At, B0); PG8_MMA(1, 1, At, B1); PG8_BAR; PG8_SCHED;
            PG8_LDB(B0, 1, 0); PG8_LDB(B1, 1, 1); PG8_SCHED; PG8_LDA(At, 1, 0); PG8_STAGE_A(PG8_SA(0, 1), a2, 1, vo2);
            PG8_WAIT_V(8); PG8_WAIT_L(0); PG8_BAR; PG8_MMA(0, 0, At, B0); PG8_MMA(0, 1, At, B1); PG8_BAR; PG8_SCHED;
            PG8_LDA(At, 1, 1); PG8_STAGE(PG8_SB(1, 0), b3, voffB); PG8_STAGE(PG8_SB(1, 1), b3 + hstepB, voffB); PG8_STAGE_A(PG8_SA(1, 0), a3, 0, vo2);
            PG8_WAIT_V(8); PG8_WAIT_L(0); PG8_BAR; PG8_MMA(1, 0, At, B0); PG8_MMA(1, 1, At, B1); PG8_BAR; PG8_SCHED;
        }
        if (wr == 0) PG8_BAR;
        E(acc, cur, wr, wc, fr, fq);
        if (!has_next) break;
#pragma unroll
        for (int a = 0; a < 2; ++a)
#pragma unroll
            for (int b = 0; b < 2; ++b)
#pragma unroll
                for (int m = 0; m < 4; ++m)
#pragma unroll
                    for (int n = 0; n < 2; ++n) acc[a][b][m][n] = (f32x4){0.f, 0.f, 0.f, 0.f};
        cur = nxt; cA = nA; cB = nB; ++ui;
        if constexpr (Sched::GATHER) {
#pragma unroll
            for (int h = 0; h < 2; ++h)
#pragma unroll
                for (int i = 0; i < 2; ++i) cvo[h][i] = nvo[h][i];
        }
        if (wr == 1) PG8_BAR;
    }
    PG8_WAIT_V(0);
    PG8_BAR;
#undef PG8_SA
#undef PG8_SB
#undef PG8_STAGE
#undef PG8_STAGE_A
#undef PG8_LDA
#undef PG8_LDB
#undef PG8_MMA
#undef PG8_WAIT_V
#undef PG8_WAIT_L
#undef PG8_BAR
#undef PG8_SCHED
}
}
using gm::GUnit;
struct SchedIn {
    static constexpr bool GATHER = false;
    int nt; unsigned lda2, ldb2; const char* XN; const char* WT; const char* MEMN; const char* WMKV; int G, c;
    __device__ __forceinline__ bool next(int i, GUnit& u) const {
        int L = i * G + c; u.gidx = nullptr;
        if (L < 128 * 23) { int pm, pn; gm::tile_of(L, 128, 23, pm, pn); u.A = XN + (size_t)pm * 256 * 2048; u.B = WT + (size_t)pn * 256 * 2048; u.pm = pm; u.pn = pn; u.aux = 0; return true; }
        L -= 128 * 23;
        if (L < 8) { const int pm = L >> 1, pn = L & 1; u.A = MEMN + (size_t)pm * 256 * 2048; u.B = WMKV + (size_t)pn * 256 * 2048; u.pm = pm; u.pn = pn; u.aux = 1; return true; }
        return false;
    }
};
struct EpiIn {
    static constexpr bool PERM = true;
    bf16_t* P; bf16_t* Gt; bf16_t* MKV;
    __device__ __forceinline__ void operator()(const f32x4 (&acc)[2][2][4][2], const GUnit& u, int wr, int wc, int fr, int fq) const {
        const int row0 = u.pm * 256 + wr * 64 + fr;
        bf16_t* base; int ldc, colt; bool sig = false;
        if (u.aux == 1) { base = MKV; ldc = 512; colt = u.pn * 256; }
        else if (u.pn < 11) { base = P; ldc = PW; colt = u.pn * 256; }
        else { base = Gt; ldc = GWD; colt = (u.pn - 11) * 256; sig = true; }
        const int col0 = colt + wc * 32 + 8 * fq;
#pragma unroll
        for (int ai = 0; ai < 2; ++ai)
#pragma unroll
            for (int m = 0; m < 4; ++m) { bf16_t* rowp = base + (size_t)(row0 + ai * 128 + m * 16) * ldc + col0;
#pragma unroll
                for (int bj = 0; bj < 2; ++bj) { f32x4 v0 = acc[ai][bj][m][0], v1 = acc[ai][bj][m][1];
                    if (sig) {
#pragma unroll
                        for (int j = 0; j < 4; ++j) { v0[j] = sigmoidf_(v0[j]); v1[j] = sigmoidf_(v1[j]); } }
                    u32x4 w; w.x = cvtpk(v0[0], v0[1]); w.y = cvtpk(v0[2], v0[3]); w.z = cvtpk(v1[0], v1[1]); w.w = cvtpk(v1[2], v1[3]);
                    *(u32x4*)(rowp + bj * 128) = w; } }
    }
};
struct SchedMerge {
    static constexpr bool GATHER = false;
    int nt; unsigned lda2, ldb2; const char* Y; const char* WT; int G, c;
    __device__ __forceinline__ bool next(int i, GUnit& u) const {
        const int L = i * G + c; u.gidx = nullptr; if (L >= 512) return false;
        int pm, pn; gm::tile_of(L, 128, 4, pm, pn); u.A = Y + (size_t)pm * 256 * lda2; u.B = WT + (size_t)pn * 256 * ldb2; u.pm = pm; u.pn = pn; u.aux = 0; return true;
    }
};
struct EpiMerge {
    static constexpr bool PERM = true;
    const bf16_t* Gt; bf16_t* MG; int pass;
    __device__ __forceinline__ void operator()(const f32x4 (&acc)[2][2][4][2], const GUnit& u, int wr, int wc, int fr, int fq) const {
        const int row0 = u.pm * 256 + wr * 64 + fr, col0 = u.pn * 256 + wc * 32 + 8 * fq;
#pragma unroll
        for (int ai = 0; ai < 2; ++ai)
#pragma unroll
            for (int m = 0; m < 4; ++m) { const size_t row = (size_t)(row0 + ai * 128 + m * 16);
#pragma unroll
                for (int bj = 0; bj < 2; ++bj) {
                    const u32x4 g = *(const u32x4*)(Gt + row * GWD + pass * 1024 + col0 + bj * 128);
                    bf16_t* mp = MG + row * DM + col0 + bj * 128;
                    float o[8];
                    const f32x4 v0 = acc[ai][bj][m][0], v1 = acc[ai][bj][m][1];
                    o[0] = bflo(g.x) * v0[0]; o[1] = bfhi(g.x) * v0[1]; o[2] = bflo(g.y) * v0[2]; o[3] = bfhi(g.y) * v0[3];
                    o[4] = bflo(g.z) * v1[0]; o[5] = bfhi(g.z) * v1[1]; o[6] = bflo(g.w) * v1[2]; o[7] = bfhi(g.w) * v1[3];
                    if (pass > 0) { const u32x4 p = *(const u32x4*)mp;
                        o[0] += bflo(p.x); o[1] += bfhi(p.x); o[2] += bflo(p.y); o[3] += bfhi(p.y); o[4] += bflo(p.z); o[5] += bfhi(p.z); o[6] += bflo(p.w); o[7] += bfhi(p.w); }
                    u32x4 w; w.x = cvtpk(o[0], o[1]); w.y = cvtpk(o[2], o[3]); w.z = cvtpk(o[4], o[5]); w.w = cvtpk(o[6], o[7]);
                    *(u32x4*)mp = w; } }
    }
};
struct SchedOut {
    static constexpr bool GATHER = false;
    int nt; unsigned lda2, ldb2; const char* A; const char* WT; int G, c;
    __device__ __forceinline__ bool next(int i, GUnit& u) const {
        const int L = i * G + c; u.gidx = nullptr; if (L >= 512) return false;
        int pm, pn; gm::tile_of(L, 128, 4, pm, pn); u.A = A + (size_t)pm * 256 * lda2; u.B = WT + (size_t)pn * 256 * ldb2; u.pm = pm; u.pn = pn; u.aux = 0; return true;
    }
};
struct EpiOut {
    static constexpr bool PERM = false;
    const float* X; float* O;
    __device__ __forceinline__ void operator()(const f32x4 (&acc)[2][2][4][2], const GUnit& u, int wr, int wc, int fr, int fq) const {
        const int row0 = u.pm * 256 + wr * 64 + fr, col0 = u.pn * 256 + wc * 32 + 4 * fq;
#pragma unroll
        for (int ai = 0; ai < 2; ++ai)
#pragma unroll
            for (int m = 0; m < 4; ++m) { const size_t off = (size_t)(row0 + ai * 128 + m * 16) * DM + col0;
#pragma unroll
                for (int bj = 0; bj < 2; ++bj)
#pragma unroll
                    for (int n = 0; n < 2; ++n) { const f32x4 xv = *(const f32x4*)(X + off + bj * 128 + n * 16); *(f32x4*)(O + off + bj * 128 + n * 16) = xv + acc[ai][bj][m][n]; } }
    }
};
struct SchedMoe1 {
    static constexpr bool GATHER = true;
    int nt; unsigned lda2, ldb2; const char* XN2; const char* WGU; const int* TIDX; int G, c;
    __device__ __forceinline__ bool next(int i, GUnit& u) const {
        const int L = i * G + c; if (L >= NE * 256) return false;
        const int e = L >> 8; int pm, pn; gm::tile_of(L & 255, 16, 16, pm, pn);
        u.A = XN2; u.gidx = TIDX + e * 4096 + pm * 256; u.B = WGU + ((size_t)e * 4096 + (size_t)pn * 256) * 2048; u.pm = e * 16 + pm; u.pn = pn; u.aux = 0; return true;
    }
};
struct EpiMoe1 {
    static constexpr bool PERM = true;
    bf16_t* ACT;
    __device__ __forceinline__ void operator()(const f32x4 (&acc)[2][2][4][2], const GUnit& u, int wr, int wc, int fr, int fq) const {
        const int row0 = u.pm * 256 + wr * 64 + fr, col0 = u.pn * 128 + wc * 32 + 8 * fq;
#pragma unroll
        for (int ai = 0; ai < 2; ++ai)
#pragma unroll
            for (int m = 0; m < 4; ++m) { bf16_t* rowp = ACT + (size_t)(row0 + ai * 128 + m * 16) * FF + col0;
                float o[8];
#pragma unroll
                for (int n = 0; n < 2; ++n)
#pragma unroll
                    for (int j = 0; j < 4; ++j) { const float g = acc[ai][0][m][n][j], up = acc[ai][1][m][n][j]; o[n * 4 + j] = g * sigmoidf_(g) * up; }
                u32x4 w; w.x = cvtpk(o[0], o[1]); w.y = cvtpk(o[2], o[3]); w.z = cvtpk(o[4], o[5]); w.w = cvtpk(o[6], o[7]);
                *(u32x4*)rowp = w; }
    }
};
struct SchedMoe2 {
    static constexpr bool GATHER = false;
    int nt; unsigned lda2, ldb2; const char* ACT; const char* WD; int G, c;
    __device__ __forceinline__ bool next(int i, GUnit& u) const {
        const int L = i * G + c; u.gidx = nullptr; if (L >= NE * 64) return false;
        const int e = L >> 6; int pm, pn; gm::tile_of(L & 63, 16, 4, pm, pn);
        u.A = ACT + ((size_t)e * 4096 + (size_t)pm * 256) * 4096; u.B = WD + ((size_t)e * 1024 + (size_t)pn * 256) * 4096; u.pm = e * 16 + pm; u.pn = pn; u.aux = 0; return true;
    }
};
struct EpiMoe2 {
    static constexpr bool PERM = true;
    bf16_t* YE; const float* TVAL;
    __device__ __forceinline__ void operator()(const f32x4 (&acc)[2][2][4][2], const GUnit& u, int wr, int wc, int fr, int fq) const {
        const int row0 = u.pm * 256 + wr * 64 + fr, col0 = u.pn * 256 + wc * 32 + 8 * fq;
#pragma unroll
        for (int ai = 0; ai < 2; ++ai)
#pragma unroll
            for (int m = 0; m < 4; ++m) { const int row = row0 + ai * 128 + m * 16; const float tv = TVAL[row]; bf16_t* rowp = YE + (size_t)row * DM + col0;
#pragma unroll
                for (int bj = 0; bj < 2; ++bj) { const f32x4 v0 = acc[ai][bj][m][0] * tv, v1 = acc[ai][bj][m][1] * tv;
                    u32x4 w; w.x = cvtpk(v0[0], v0[1]); w.y = cvtpk(v0[2], v0[3]); w.z = cvtpk(v1[0], v1[1]); w.w = cvtpk(v1[2], v1[3]);
                    *(u32x4*)(rowp + bj * 128) = w; } }
    }
};
constexpr int NWAVES = 8, NTHR = 512;
constexpr int LDS_BYTES = 147456;
struct Args { const float* in[30]; float* out; unsigned char* ws; int ph_lo, ph_hi; };
enum { I_X = 0, I_MEM, I_NMIXG, I_NMEMG, I_WIN, I_RPB, I_MURKV, I_MUW, I_MUA, I_W0, I_W2, I_A0, I_A2, I_KK, I_KA, I_RK, I_G2, I_LNG, I_LNB, I_WMKV, I_WBNA, I_WBRW, I_WBMEM, I_WOUT,
       I_NFFNG, I_WROUTER, I_WEG, I_WEU, I_WED, I_NFING };

__device__ __forceinline__ void transpose_item(const float* __restrict__ W, int N, bf16_t* __restrict__ WT, int ldw, int drow0, int k0, int n0, LAS float* scr, int lane) {
#pragma unroll 8
    for (int i = 0; i < 32; ++i) { const int kk = 2 * i + (lane >> 5); scr[kk * 33 + (lane & 31)] = W[(size_t)(k0 + kk) * N + n0 + (lane & 31)]; }
    LDS_WAIT(); asm volatile("" ::: "memory");
    const int c = lane & 7;
#pragma unroll
    for (int j = 0; j < 4; ++j) { const int n = (lane >> 3) + 8 * j; const LAS float* s = scr + (8 * c) * 33 + n;
        u32x4 o; o.x = cvtpk(s[0 * 33], s[1 * 33]); o.y = cvtpk(s[2 * 33], s[3 * 33]); o.z = cvtpk(s[4 * 33], s[5 * 33]); o.w = cvtpk(s[6 * 33], s[7 * 33]);
        *(u32x4*)(WT + (size_t)(drow0 + n) * ldw + k0 + 8 * c) = o; }
    LDS_WAIT(); asm volatile("" ::: "memory");
}
__device__ __forceinline__ bool tr_matrix(int& it, const float* W, int K, int N, bf16_t* WT, LAS float* scr, int lane) {
    const int nblk = N / 32, items = (K / 64) * nblk;
    if (it < items) { const int kb = it / nblk, nb = it % nblk; transpose_item(W, N, WT, K, 32 * nb, 64 * kb, 32 * nb, scr, lane); return true; }
    it -= items; return false;
}
__device__ __forceinline__ void rms_row_to_bf16(const float* __restrict__ xrow, const float* __restrict__ g, bf16_t* __restrict__ orow, int lane) {
    const f32x4* xr = (const f32x4*)xrow + lane; const f32x4* gr = (const f32x4*)g + lane;
    f32x4 v[4]; float s = 0.f;
#pragma unroll
    for (int j = 0; j < 4; ++j) { v[j] = xr[64 * j]; s += (v[j].x * v[j].x + v[j].y * v[j].y) + (v[j].z * v[j].z + v[j].w * v[j].w); }
    const float rstd = 1.f / sqrtf(wave_sum(s) * (1.f / DM) + RMS_EPS);
    unsigned long long* o8 = (unsigned long long*)orow + lane;
#pragma unroll
    for (int j = 0; j < 4; ++j) { const f32x4 gg = gr[64 * j];
        o8[64 * j] = (unsigned long long)cvtpk(v[j].x * rstd * gg.x, v[j].y * rstd * gg.y) | ((unsigned long long)cvtpk(v[j].z * rstd * gg.z, v[j].w * rstd * gg.w) << 32); }
}
__device__ __forceinline__ void phase_prologue(const Args& a, LAS unsigned char* lds, int wave, int lane) {
    unsigned char* ws = a.ws;
    LAS float* scr = (LAS float*)(lds + wave * 16384);
    const int gw = blockIdx.x * NWAVES + wave, NGW = gridDim.x * NWAVES;
    constexpr int NITEMS = 16 * 184 + 192 + 192 + 128 + 512 + 256 + 12 * 4 + 24;
    for (int it0 = gw; it0 < NITEMS; it0 += NGW) {
        int it = it0;
        if (tr_matrix(it, a.in[I_WIN], DM, DIN, (bf16_t*)(ws + WS_WIN), scr, lane)) continue;
        if (tr_matrix(it, a.in[I_WBNA], NAW, DM, (bf16_t*)(ws + WS_WBR), scr, lane)) continue;
        if (tr_matrix(it, a.in[I_WBRW], RWW, DM, (bf16_t*)(ws + WS_WBR) + 1024 * 384, scr, lane)) continue;
        if (tr_matrix(it, a.in[I_WBMEM], MEMW, DM, (bf16_t*)(ws + WS_WBR) + 2 * 1024 * 384, scr, lane)) continue;
        if (tr_matrix(it, a.in[I_WOUT], DM, DM, (bf16_t*)(ws + WS_WOUT), scr, lane)) continue;
        if (tr_matrix(it, a.in[I_WMKV], DM, 512, (bf16_t*)(ws + WS_WMKV), scr, lane)) continue;
        if (tr_matrix(it, a.in[I_W2], 64, 384, (bf16_t*)(ws + WS_W2T), scr, lane)) continue;
        if (tr_matrix(it, a.in[I_W2] + 64 * 384, 64, 384, (bf16_t*)(ws + WS_W2T) + 384 * 64, scr, lane)) continue;
        if (tr_matrix(it, a.in[I_A2], 64, 384, (bf16_t*)(ws + WS_A2T), scr, lane)) continue;
        if (tr_matrix(it, a.in[I_A2] + 64 * 384, 64, 384, (bf16_t*)(ws + WS_A2T) + 384 * 64, scr, lane)) continue;
        tr_matrix(it, a.in[I_G2], 128, 384, (bf16_t*)(ws + WS_G2T), scr, lane);
    }
    for (int m = gw; m < T; m += NGW) rms_row_to_bf16(a.in[I_X] + (size_t)m * DM, a.in[I_NMIXG], (bf16_t*)(ws + WS_XN) + (size_t)m * DM, lane);
    for (int m = gw; m < NB * NMEM; m += NGW) rms_row_to_bf16(a.in[I_MEM] + (size_t)m * DM, a.in[I_NMEMG], (bf16_t*)(ws + WS_MEMN) + (size_t)m * DM, lane);
}

template <int CTRL> __device__ __forceinline__ float dppf(float v) { return __int_as_float(__builtin_amdgcn_update_dpp(0, __float_as_int(v), CTRL, 0xf, 0xf, true)); }
__device__ __forceinline__ float sum8(float v) { v += dppf<0xB1>(v); v += dppf<0x4E>(v); v += dppf<0x141>(v); return v; }
__device__ __forceinline__ float dot8(const float (&q)[8], const u32x4 t4) {
    return q[0] * bflo(t4.x) + q[1] * bfhi(t4.x) + q[2] * bflo(t4.y) + q[3] * bfhi(t4.y) + q[4] * bflo(t4.z) + q[5] * bfhi(t4.z) + q[6] * bflo(t4.w) + q[7] * bfhi(t4.w);
}
__device__ __forceinline__ void axpy8(float (&o)[8], float p, const u32x4 t4) {
    o[0] += p * bflo(t4.x); o[1] += p * bfhi(t4.x); o[2] += p * bflo(t4.y); o[3] += p * bfhi(t4.y); o[4] += p * bflo(t4.z); o[5] += p * bfhi(t4.z); o[6] += p * bflo(t4.w); o[7] += p * bfhi(t4.w);
}
typedef short v4i16_t __attribute__((ext_vector_type(4)));
__device__ __forceinline__ s16x4 tr_read(const LAS unsigned char* p) { return __builtin_bit_cast(s16x4, __builtin_amdgcn_ds_read_tr16_b64_v4i16((LAS v4i16_t*)p)); }
constexpr int KPITCH = 144, VPITCH = 136;
__device__ __forceinline__ void na_unit(const Args& a, LAS unsigned char* lds, int unit, int tid, SegT& sg) {
    const int h = unit % NAH, r = (unit / NAH) % GROWS, b = unit / (NAH * GROWS);
    const bf16_t* P = (const bf16_t*)(a.ws + WS_P);
    const int rs = min(max(r - 4, 0), GROWS - 8);
    LAS unsigned char* Ks = lds; LAS unsigned char* Vs = lds + 512 * KPITCH; LAS float* RPB = (LAS float*)(lds + 512 * KPITCH + 512 * VPITCH);
    const int wave = __builtin_amdgcn_readfirstlane(tid >> 6), lane = tid & 63, fr = lane & 15, fq = lane >> 4;
    {   const int key = tid; const size_t tok = (size_t)b * SEQ + (size_t)(rs + (key >> 6)) * GRIDW + (key & 63);
        const u32x4* kp = (const u32x4*)(P + tok * PW + C_NAK + h * 64); const u32x4* vp = (const u32x4*)(P + tok * PW + C_NAV + h * 64);
#pragma unroll
        for (int c8 = 0; c8 < 8; ++c8) { *(LAS u32x4*)(Ks + key * KPITCH + c8 * 16) = kp[c8]; const u32x4 v = vp[c8];
            *(LAS u32x2*)(Vs + key * VPITCH + c8 * 16) = (u32x2){v.x, v.y}; *(LAS u32x2*)(Vs + key * VPITCH + c8 * 16 + 8) = (u32x2){v.z, v.w}; }
        if (tid < 15 * 31) RPB[tid] = a.in[I_RPB][h * 15 * 31 + tid];
    }
    const int qt = wave & 3, kh = wave >> 2, w0 = 16 * qt, cbase = (qt == 0) ? 0 : (qt == 1) ? 8 : (qt == 2) ? 24 : 32;
    const size_t qtok = (size_t)b * SEQ + (size_t)r * GRIDW + w0 + fr;
    bf16x8 qf[2];
#pragma unroll
    for (int s = 0; s < 2; ++s) qf[s] = *(const bf16x8*)(P + qtok * PW + C_NAQ + h * 64 + 32 * s + 8 * fq);
    __syncthreads();
    f32x4 sc[8];
#pragma unroll
    for (int tl = 0; tl < 8; ++tl) { const int i = 4 * kh + (tl >> 1), hf = tl & 1; sc[tl] = (f32x4){0.f, 0.f, 0.f, 0.f};
#pragma unroll
        for (int s = 0; s < 2; ++s) { const bf16x8 af = *(const LAS bf16x8*)(Ks + (i * 64 + cbase + 16 * hf + fr) * KPITCH + (32 * s + 8 * fq) * 2); sc[tl] = __builtin_amdgcn_mfma_f32_16x16x32_bf16(af, qf[s], sc[tl], 0, 0, 0); } }
    const int w = w0 + fr, cs = min(max(w - 8, 0), GRIDW - 16);
    float mx = -1e30f;
#pragma unroll
    for (int tl = 0; tl < 8; ++tl) { const int i = 4 * kh + (tl >> 1), hf = tl & 1;
#pragma unroll
        for (int g = 0; g < 4; ++g) { const int c = cbase + 16 * hf + 4 * fq + g; const bool valid = (c >= cs) && (c < cs + 16); const int co = min(max(c - w + 15, 0), 30);
            const float v = valid ? (sc[tl][g] * 0.125f + RPB[(rs + i - r + 7) * 31 + co]) : -1e30f; sc[tl][g] = v; mx = fmaxf(mx, v); } }
    mx = fmaxf(mx, __shfl_xor(mx, 16)); mx = fmaxf(mx, __shfl_xor(mx, 32));
    float l = 0.f;
#pragma unroll
    for (int tl = 0; tl < 8; ++tl)
#pragma unroll
        for (int g = 0; g < 4; ++g) { const float p = (sc[tl][g] > -1e29f) ? __expf(sc[tl][g] - mx) : 0.f; sc[tl][g] = p; l += p; }
    l += __shfl_xor(l, 16); l += __shfl_xor(l, 32);
    f32x4 o[4];
#pragma unroll
    for (int dt = 0; dt < 4; ++dt) o[dt] = (f32x4){0.f, 0.f, 0.f, 0.f};
#pragma unroll
    for (int ii = 0; ii < 4; ++ii) { const int i = 4 * kh + ii;
        u32x4 pw; pw.x = cvtpk(sc[2 * ii][0], sc[2 * ii][1]); pw.y = cvtpk(sc[2 * ii][2], sc[2 * ii][3]); pw.z = cvtpk(sc[2 * ii + 1][0], sc[2 * ii + 1][1]); pw.w = cvtpk(sc[2 * ii + 1][2], sc[2 * ii + 1][3]);
        const bf16x8 pb = __builtin_bit_cast(bf16x8, pw);
        const LAS unsigned char* vb = Vs + (i * 64 + cbase + 4 * fq + (fr >> 2)) * VPITCH + 8 * (fr & 3);
#pragma unroll
        for (int dt = 0; dt < 4; ++dt) { const s16x4 lo = tr_read(vb + dt * 32), hi = tr_read(vb + 16 * VPITCH + dt * 32);
            const bf16x8 af = (bf16x8){lo[0], lo[1], lo[2], lo[3], hi[0], hi[1], hi[2], hi[3]};
            o[dt] = __builtin_amdgcn_mfma_f32_16x16x32_bf16(af, pb, o[dt], 0, 0, 0); } }
    __syncthreads();
    LAS float* X = (LAS float*)lds + (qt * 64 + lane) * 20;
    if (kh == 1) { X[0] = mx; X[1] = l;
#pragma unroll
        for (int dt = 0; dt < 4; ++dt) *(LAS f32x4*)(X + 4 + 4 * dt) = o[dt]; }
    __syncthreads();
    if (kh == 0) { const float m1 = X[0], l1 = X[1]; const float mt = fmaxf(mx, m1), f0 = __expf(mx - mt), f1 = __expf(m1 - mt); const float il = 1.f / (l * f0 + l1 * f1);
        bf16_t* yp = (bf16_t*)(a.ws + WS_YNA) + qtok * NAW + h * 64 + 4 * fq;
#pragma unroll
        for (int dt = 0; dt < 4; ++dt) { const f32x4 o1 = *(const LAS f32x4*)(X + 4 + 4 * dt); const f32x4 ov = (o[dt] * f0 + o1 * f1) * il;
            *(u32x2*)(yp + 16 * dt) = (u32x2){cvtpk(ov[0], ov[1]), cvtpk(ov[2], ov[3])}; } }
    __syncthreads();
}
__device__ __forceinline__ void mem_unit(const Args& a, LAS unsigned char* lds, int unit, int tid) {
    const int qb = unit & 15, mh = (unit >> 4) & 3, b = unit >> 6;
    const bf16_t* MKV = (const bf16_t*)(a.ws + WS_MKV); const bf16_t* P = (const bf16_t*)(a.ws + WS_P);
    LAS unsigned char* Ks = lds; LAS unsigned char* Vs = lds + 256 * KPITCH;
    const int wave = __builtin_amdgcn_readfirstlane(tid >> 6), lane = tid & 63, fr = lane & 15, fq = lane >> 4;
    {   const int key = tid >> 1, hf = tid & 1; const bf16_t* src = MKV + (size_t)(b * NMEM + key) * 512 + mh * 64 + hf * 32;
#pragma unroll
        for (int c4 = 0; c4 < 4; ++c4) { *(LAS u32x4*)(Ks + key * KPITCH + hf * 64 + c4 * 16) = *(const u32x4*)(src + c4 * 8); const u32x4 v = *(const u32x4*)(src + 256 + c4 * 8);
            *(LAS u32x2*)(Vs + key * VPITCH + hf * 64 + c4 * 16) = (u32x2){v.x, v.y}; *(LAS u32x2*)(Vs + key * VPITCH + hf * 64 + c4 * 16 + 8) = (u32x2){v.z, v.w}; }
    }
    __syncthreads();
#pragma unroll 1
    for (int tile = 0; tile < 4; ++tile) {
        const size_t qtok = (size_t)b * SEQ + (size_t)qb * 512 + (wave * 4 + tile) * 16 + fr;
        bf16x8 qf[2];
#pragma unroll
        for (int s = 0; s < 2; ++s) qf[s] = *(const bf16x8*)(P + qtok * PW + C_MQ + mh * 64 + 32 * s + 8 * fq);
        f32x4 sc[16];
#pragma unroll
        for (int kt = 0; kt < 16; ++kt) { sc[kt] = (f32x4){0.f, 0.f, 0.f, 0.f};
#pragma unroll
            for (int s = 0; s < 2; ++s) { const bf16x8 af = *(const LAS bf16x8*)(Ks + (16 * kt + fr) * KPITCH + (32 * s + 8 * fq) * 2); sc[kt] = __builtin_amdgcn_mfma_f32_16x16x32_bf16(af, qf[s], sc[kt], 0, 0, 0); } }
        float mx = -1e30f;
#pragma unroll
        for (int kt = 0; kt < 16; ++kt)
#pragma unroll
            for (int g = 0; g < 4; ++g) mx = fmaxf(mx, sc[kt][g]);
        mx = fmaxf(mx, __shfl_xor(mx, 16)); mx = fmaxf(mx, __shfl_xor(mx, 32));
        float l = 0.f;
#pragma unroll
        for (int kt = 0; kt < 16; ++kt)
#pragma unroll
            for (int g = 0; g < 4; ++g) { const float p = __expf((sc[kt][g] - mx) * 0.125f); sc[kt][g] = p; l += p; }
        l += __shfl_xor(l, 16); l += __shfl_xor(l, 32);
        f32x4 o[4];
#pragma unroll
        for (int dt = 0; dt < 4; ++dt) o[dt] = (f32x4){0.f, 0.f, 0.f, 0.f};
#pragma unroll
        for (int ks = 0; ks < 8; ++ks) {
            u32x4 pw; pw.x = cvtpk(sc[2 * ks][0], sc[2 * ks][1]); pw.y = cvtpk(sc[2 * ks][2], sc[2 * ks][3]); pw.z = cvtpk(sc[2 * ks + 1][0], sc[2 * ks + 1][1]); pw.w = cvtpk(sc[2 * ks + 1][2], sc[2 * ks + 1][3]);
            const bf16x8 pb = __builtin_bit_cast(bf16x8, pw);
            const LAS unsigned char* vb = Vs + (32 * ks + 4 * fq + (fr >> 2)) * VPITCH + 8 * (fr & 3);
#pragma unroll
            for (int dt = 0; dt < 4; ++dt) { const s16x4 lo = tr_read(vb + dt * 32), hi = tr_read(vb + 16 * VPITCH + dt * 32);
                const bf16x8 af = (bf16x8){lo[0], lo[1], lo[2], lo[3], hi[0], hi[1], hi[2], hi[3]};
                o[dt] = __builtin_amdgcn_mfma_f32_16x16x32_bf16(af, pb, o[dt], 0, 0, 0); } }
        const float il = 1.f / l;
        bf16_t* yp = (bf16_t*)(a.ws + WS_YMEM) + qtok * MEMW + mh * 64 + 4 * fq;
#pragma unroll
        for (int dt = 0; dt < 4; ++dt) { const f32x4 ov = o[dt] * il; *(u32x2*)(yp + 16 * dt) = (u32x2){cvtpk(ov[0], ov[1]), cvtpk(ov[2], ov[3])}; }
    }
    __syncthreads();
}

__device__ __forceinline__ void phase_norm_router(const Args& a, LAS unsigned char* lds, int wave, int lane) {
    const int gw = blockIdx.x * NWAVES + wave, NGW = gridDim.x * NWAVES;
    const float* x1 = a.out; const float* g = a.in[I_NFFNG]; const LAS float* wr = (const LAS float*)lds;
    bf16_t* XN2 = (bf16_t*)(a.ws + WS_XN); float* AFF = (float*)(a.ws + WS_AFF);
    for (int m = gw; m < T; m += NGW) {
        const f32x4* xr = (const f32x4*)(x1 + (size_t)m * DM) + lane; const f32x4* gr = (const f32x4*)g + lane;
        f32x4 v[4]; float s = 0.f;
#pragma unroll
        for (int j = 0; j < 4; ++j) { v[j] = xr[64 * j]; s += (v[j].x * v[j].x + v[j].y * v[j].y) + (v[j].z * v[j].z + v[j].w * v[j].w); }
        const float rstd = 1.f / sqrtf(wave_sum(s) * (1.f / DM) + RMS_EPS);
        unsigned long long* o8 = (unsigned long long*)(XN2 + (size_t)m * DM) + lane;
        float lg[16];
#pragma unroll
        for (int e = 0; e < 16; ++e) lg[e] = 0.f;
#pragma unroll 1
        for (int j = 0; j < 4; ++j) { const f32x4 gg = gr[64 * j]; f32x4 hh; hh.x = v[j].x * rstd * gg.x; hh.y = v[j].y * rstd * gg.y; hh.z = v[j].z * rstd * gg.z; hh.w = v[j].w * rstd * gg.w;
            o8[64 * j] = (unsigned long long)cvtpk(hh.x, hh.y) | ((unsigned long long)cvtpk(hh.z, hh.w) << 32);
            const int d0 = 4 * (64 * j + lane);
#pragma unroll
            for (int dd = 0; dd < 4; ++dd) { const LAS f32x4* wp = (const LAS f32x4*)wr + dd * 256 + (d0 >> 2); const float hv = hh[dd];
#pragma unroll
                for (int e4 = 0; e4 < 4; ++e4) { const f32x4 wv = wp[e4 * 1024]; lg[e4 * 4] += hv * wv.x; lg[e4 * 4 + 1] += hv * wv.y; lg[e4 * 4 + 2] += hv * wv.z; lg[e4 * 4 + 3] += hv * wv.w; } } }
#pragma unroll
        for (int e = 0; e < 16; ++e) lg[e] = wave_sum(lg[e]);
        float mxv = lg[0];
#pragma unroll
        for (int e = 1; e < 16; ++e) mxv = fmaxf(mxv, lg[e]);
        float se = 0.f;
#pragma unroll
        for (int e = 0; e < 16; ++e) { lg[e] = expf(lg[e] - mxv); se += lg[e]; }
        const float inv = 1.f / se;
        if (lane < 4) { f32x4 ov;
            if (lane == 0) ov = (f32x4){lg[0], lg[1], lg[2], lg[3]}; else if (lane == 1) ov = (f32x4){lg[4], lg[5], lg[6], lg[7]};
            else if (lane == 2) ov = (f32x4){lg[8], lg[9], lg[10], lg[11]}; else ov = (f32x4){lg[12], lg[13], lg[14], lg[15]};
            *(f32x4*)(AFF + (size_t)m * NE + lane * 4) = ov * inv; }
    }
}

__device__ __forceinline__ unsigned block_sum_u32(unsigned v, LAS unsigned* red, int tid) {
    unsigned s = v;
#pragma unroll
    for (int o = 1; o < 64; o <<= 1) s += __shfl_xor(s, o);
    if ((tid & 63) == 0) red[tid >> 6] = s;
    __syncthreads();
    unsigned t = 0;
#pragma unroll
    for (int w = 0; w < 8; ++w) t += red[w];
    __syncthreads();
    return t;
}
__device__ __forceinline__ unsigned block_excl_scan(unsigned v, LAS unsigned* red, int tid) {
    const int lane = tid & 63, wv = tid >> 6;
    unsigned inc = v;
#pragma unroll
    for (int o = 1; o < 64; o <<= 1) { const unsigned n = __shfl_up(inc, o); if (lane >= o) inc += n; }
    if (lane == 63) red[wv] = inc;
    __syncthreads();
    unsigned base = 0;
#pragma unroll
    for (int w = 0; w < 8; ++w) if (w < wv) base += red[w];
    __syncthreads();
    return base + inc - v;
}
__device__ __forceinline__ void topk_unit(const Args& a, LAS unsigned char* lds, int unit, int tid) {
    const int e = unit & 15, b = unit >> 4;
    const float* AFF = (const float*)(a.ws + WS_AFF);
    int* TIDX = (int*)(a.ws + WS_TIDX); float* TVAL = (float*)(a.ws + WS_TVAL); int* SLOT = (int*)(a.ws + WS_SLOT);
    LAS unsigned* red = (LAS unsigned*)lds;
    unsigned key[16];
#pragma unroll
    for (int j = 0; j < 16; ++j) key[j] = __float_as_uint(AFF[((size_t)b * SEQ + tid * 16 + j) * NE + e]);
    unsigned prefix = 0;
    for (int bit = 30; bit >= 0; --bit) {
        const unsigned cand = prefix | (1u << bit); unsigned c = 0;
#pragma unroll
        for (int j = 0; j < 16; ++j) c += (key[j] >= cand) ? 1u : 0u;
        const unsigned tot = block_sum_u32(c, red, tid);
        if (tot >= (unsigned)CAP) prefix = cand;
    }
    unsigned cg_ = 0, ce = 0;
#pragma unroll
    for (int j = 0; j < 16; ++j) { cg_ += (key[j] > prefix) ? 1u : 0u; ce += (key[j] == prefix) ? 1u : 0u; }
    const unsigned ngt = block_sum_u32(cg_, red, tid);
    const unsigned need = (unsigned)CAP - ngt;
    unsigned erank = block_excl_scan(ce, red, tid);
    unsigned sel = 0, nsel = 0;
#pragma unroll
    for (int j = 0; j < 16; ++j) { bool s = key[j] > prefix; if (key[j] == prefix) { s = erank < need; ++erank; } if (s) { sel |= 1u << j; ++nsel; } }
    unsigned pos = block_excl_scan(nsel, red, tid);
#pragma unroll
    for (int j = 0; j < 16; ++j) { const int tok = b * SEQ + tid * 16 + j; int slot = -1;
        if (sel & (1u << j)) { slot = e * 4096 + b * 1024 + (int)pos; ++pos; TIDX[slot] = tok; TVAL[slot] = __uint_as_float(key[j]); }
        SLOT[(size_t)tok * NE + e] = slot; }
}

__device__ __forceinline__ void expert_convert(const Args& a, LAS unsigned char* lds, int wave, int lane, int gw, int NGW) {
    LAS float* scr = (LAS float*)(lds + 4096 + wave * 16384);
    bf16_t* WGU = (bf16_t*)(a.ws + WS_WGU); bf16_t* WD = (bf16_t*)(a.ws + WS_WD);
    constexpr int PER_E = 3072, NIT = NE * PER_E;
    for (int it0 = gw; it0 < NIT; it0 += NGW) {
        const int e = it0 / PER_E; int it = it0 % PER_E;
        if (it < 2048) { const int up = it >> 10; it &= 1023; const int kb = it >> 6, nb = it & 63, n0 = 32 * nb;
            const float* W = a.in[up ? I_WEU : I_WEG] + (size_t)e * DM * FF;
            transpose_item(W, FF, WGU + (size_t)e * 4096 * 1024, 1024, 256 * (n0 >> 7) + (up ? 128 : 0) + (n0 & 127), 64 * kb, n0, scr, lane); }
        else { it -= 2048; const int kb = it >> 5, nb = it & 31;
            transpose_item(a.in[I_WED] + (size_t)e * FF * DM, DM, WD + (size_t)e * 1024 * 2048, 2048, 32 * nb, 64 * kb, 32 * nb, scr, lane); }
    }
}

__device__ __forceinline__ void phase_final(const Args& a, int wave, int lane) {
    const int gw = blockIdx.x * NWAVES + wave, NGW = gridDim.x * NWAVES;
    float* x1 = a.out; const float* g = a.in[I_NFING]; const int* SLOT = (const int*)(a.ws + WS_SLOT); const bf16_t* YE = (const bf16_t*)(a.ws + WS_YE);
    for (int m = gw; m < T; m += NGW) {
        f32x4* xr = (f32x4*)(x1 + (size_t)m * DM) + lane; const f32x4* gr = (const f32x4*)g + lane;
        f32x4 v[4];
#pragma unroll
        for (int j = 0; j < 4; ++j) v[j] = xr[64 * j];
        const int myslot = (lane < NE) ? SLOT[(size_t)m * NE + lane] : -1;
        for (int e = 0; e < NE; ++e) { const int sl = __shfl(myslot, e);
            if (sl >= 0) { const u32x2* yp = (const u32x2*)(YE + (size_t)sl * DM) + lane;
#pragma unroll
                for (int j = 0; j < 4; ++j) { const u32x2 y2 = yp[64 * j]; v[j].x += bflo(y2.x); v[j].y += bfhi(y2.x); v[j].z += bflo(y2.y); v[j].w += bfhi(y2.y); } } }
        float s = 0.f;
#pragma unroll
        for (int j = 0; j < 4; ++j) s += (v[j].x * v[j].x + v[j].y * v[j].y) + (v[j].z * v[j].z + v[j].w * v[j].w);
        const float rstd = 1.f / sqrtf(wave_sum(s) * (1.f / DM) + RMS_EPS);
#pragma unroll
        for (int j = 0; j < 4; ++j) { const f32x4 gg = gr[64 * j]; xr[64 * j] = v[j] * rstd * gg; }
    }
}
constexpr int LP = 72;
constexpr int RB = 64 * LP * 2;
#define RWBUF(n) ((LAS bf16_t*)(lds + (n) * RB))

__device__ __forceinline__ void mm64(const LAS bf16_t* A, const LAS bf16_t* Bt, f32x4 (&acc)[2], int wid, int fr, int fq) {
    const int rt = wid >> 1, ct0 = 2 * (wid & 1);
#pragma unroll
    for (int s = 0; s < 2; ++s) {
        const bf16x8 af = *(const LAS bf16x8*)(A + (16 * rt + fr) * LP + 32 * s + 8 * fq);
#pragma unroll
        for (int c = 0; c < 2; ++c) { const bf16x8 bfrag = *(const LAS bf16x8*)(Bt + (16 * (ct0 + c) + fr) * LP + 32 * s + 8 * fq);
            acc[c] = __builtin_amdgcn_mfma_f32_16x16x32_bf16(af, bfrag, acc[c], 0, 0, 0); }
    }
}
__device__ __forceinline__ void zero2(f32x4 (&acc)[2]) { acc[0] = (f32x4){0.f, 0.f, 0.f, 0.f}; acc[1] = acc[0]; }
template <int MASK> __device__ __forceinline__ void mask2(f32x4 (&acc)[2], int wid, int fr, int fq) {
    if (MASK == 0) return;
    const int rt = wid >> 1, ct0 = 2 * (wid & 1);
#pragma unroll
    for (int c = 0; c < 2; ++c)
#pragma unroll
        for (int g = 0; g < 4; ++g) { const int row = 16 * rt + 4 * fq + g, col = 16 * (ct0 + c) + fr; const bool keep = (MASK == 1) ? (row > col) : (row >= col); if (!keep) acc[c][g] = 0.f; }
}
__device__ __forceinline__ void store_rm(LAS bf16_t* D, const f32x4 (&acc)[2], int wid, int fr, int fq) {
    const int rt = wid >> 1, ct0 = 2 * (wid & 1);
#pragma unroll
    for (int c = 0; c < 2; ++c)
#pragma unroll
        for (int g = 0; g < 4; ++g) D[(16 * rt + 4 * fq + g) * LP + 16 * (ct0 + c) + fr] = f2bf(acc[c][g]);
}
__device__ __forceinline__ void store_tr(LAS bf16_t* D, const f32x4 (&acc)[2], int wid, int fr, int fq) {
    const int rt = wid >> 1, ct0 = 2 * (wid & 1);
#pragma unroll
    for (int c = 0; c < 2; ++c) { u32x2 w; w.x = cvtpk(acc[c][0], acc[c][1]); w.y = cvtpk(acc[c][2], acc[c][3]); *(LAS u32x2*)(D + (16 * (ct0 + c) + fr) * LP + 16 * rt + 4 * fq) = w; }
}
__device__ __forceinline__ int afrag_index(int row, int k) {
    const int tile = row >> 4, fr = row & 15, s = k >> 5, j = 4 * ((k >> 4) & 1) + (k & 3), fq = (k >> 2) & 3;
    return ((tile * 2 + s) * 64 + fq * 16 + fr) * 8 + j;
}
__device__ __forceinline__ int nfrag_index(int v, int k) { const int vg = v >> 4, fr = v & 15, kt = k >> 4, fq = (k >> 2) & 3, reg = k & 3; return ((vg * 64 + fq * 16 + fr) * 16) + kt * 4 + reg; }

__device__ __forceinline__ s16x4 bf4(const f32x4 v) { u32x2 w; w.x = cvtpk(v[0], v[1]); w.y = cvtpk(v[2], v[3]); return __builtin_bit_cast(s16x4, w); }
__device__ __forceinline__ float fast_tanh(float x) { return 1.f - 2.f / (1.f + __expf(2.f * x)); }
__device__ __forceinline__ int scan_tok(int d, int c, int i) { const int p = 64 * c + i; return d ? (SEQ - 1 - p) : p; }

struct R1Pre { u32x4 lw[2], la[2], pr[2], pk[2], pv[2], w2, a2; };
constexpr int R1_PRM = 14 * RB + 4352;
__device__ __forceinline__ void r1_issue(const Args& a, int unit, int tid, R1Pre& q) {
    const int c = unit & 127, h = (unit >> 7) % RWH, db = unit / (128 * RWH), b = db & 3, d = db >> 2;
    const int i = tid >> 3, jq = tid & 7, ch0 = h * 64 + jq * 8;
    const bf16_t* P = (const bf16_t*)(a.ws + WS_P);
    const int s_cur = scan_tok(d, c, i); const bool has_prev = !(c == 0 && i == 0); const int s_prev = d ? s_cur + 1 : s_cur - 1;
    const size_t tok = (size_t)b * SEQ + s_cur, tokp = (size_t)b * SEQ + (has_prev ? s_prev : s_cur);
    q.lw[0] = *(const u32x4*)(P + tok * PW + C_LW + jq * 8); q.lw[1] = *(const u32x4*)(P + tokp * PW + C_LW + jq * 8);
    q.la[0] = *(const u32x4*)(P + tok * PW + C_LA + jq * 8); q.la[1] = *(const u32x4*)(P + tokp * PW + C_LA + jq * 8);
    q.pr[0] = *(const u32x4*)(P + tok * PW + C_PR + ch0); q.pr[1] = *(const u32x4*)(P + tokp * PW + C_PR + ch0);
    q.pk[0] = *(const u32x4*)(P + tok * PW + C_PK + ch0); q.pk[1] = *(const u32x4*)(P + tokp * PW + C_PK + ch0);
    q.pv[0] = *(const u32x4*)(P + tok * PW + C_PV + ch0); q.pv[1] = *(const u32x4*)(P + tokp * PW + C_PV + ch0);
    q.w2 = *(const u32x4*)((const bf16_t*)(a.ws + WS_W2T) + ((size_t)d * 384 + h * 64 + i) * 64 + jq * 8);
    q.a2 = *(const u32x4*)((const bf16_t*)(a.ws + WS_A2T) + ((size_t)d * 384 + h * 64 + i) * 64 + jq * 8);
}
__device__ __forceinline__ void r1_params(const Args& a, LAS unsigned char* lds, int d, int h, int tid) {
    if (tid < 144) { const int arr = tid >> 4, q4 = (tid & 15) * 4; const float* src;
        switch (arr) { case 0: src = a.in[I_MUW] + d * 64; break; case 1: src = a.in[I_MUA] + d * 64; break; case 2: src = a.in[I_MURKV] + (d * 3 + 0) * 384 + h * 64; break;
            case 3: src = a.in[I_MURKV] + (d * 3 + 1) * 384 + h * 64; break; case 4: src = a.in[I_MURKV] + (d * 3 + 2) * 384 + h * 64; break; case 5: src = a.in[I_W0] + d * 384 + h * 64; break;
            case 6: src = a.in[I_A0] + d * 384 + h * 64; break; case 7: src = a.in[I_KK] + h * 64; break; default: src = a.in[I_KA] + h * 64; break; }
        *(LAS f32x4*)(lds + R1_PRM + (arr * 64 + q4) * 4) = *(const f32x4*)(src + q4); }
}
__device__ __forceinline__ void lds8f(const LAS float* p, float (&o)[8]) { const f32x4 x0 = *(const LAS f32x4*)p, x1 = *(const LAS f32x4*)(p + 4); o[0] = x0.x; o[1] = x0.y; o[2] = x0.z; o[3] = x0.w; o[4] = x1.x; o[5] = x1.y; o[6] = x1.z; o[7] = x1.w; }
__device__ __forceinline__ void rwkv_chunk_unit(const Args& a, LAS unsigned char* lds, int unit, int tid, const R1Pre& now, int unit_next, R1Pre& nxt, SegT& sg) {
    const int c = unit & 127, h = (unit >> 7) % RWH, db = unit / (128 * RWH), b = db & 3, d = db >> 2;
    const int wid = __builtin_amdgcn_readfirstlane(tid >> 6), lane = tid & 63, fr = lane & 15, fq = lane >> 4;
    const int i = tid >> 3, jq = tid & 7;
    const bool has_prev = !(c == 0 && i == 0);
    const LAS float* PRM = (const LAS float*)(lds + R1_PRM);
    LAS bf16_t *AT = RWBUF(0), *RT = RWBUF(1), *BT = RWBUF(2), *KT = RWBUF(3), *ATc = RWBUF(4), *VTc = RWBUF(5), *KHc = RWBUF(6), *BHc = RWBUF(7);
    LAS bf16_t *X1 = RWBUF(8), *X2 = RWBUF(9), *W2s = RWBUF(10), *A2s = RWBUF(11);
    LAS float *WPf = (LAS float*)(lds + 12 * RB), *APf = (LAS float*)(lds + 0 * RB), *TOT = (LAS float*)(lds + 14 * RB), *GCs = (LAS float*)(lds + 14 * RB + 4096);
    LAS bf16_t* VTm = RWBUF(12);
    SEG_T0(1);
    float pr[8], pk[8], pv[8], tmp[8], mu[8];
    {   float cur[8], prv[8];
        unpack8(now.lw[0], cur); unpack8(now.lw[1], prv); lds8f(PRM + 0 + jq * 8, mu);
#pragma unroll
        for (int j = 0; j < 8; ++j) { const float sh = has_prev ? prv[j] : 0.f; tmp[j] = fast_tanh(cur[j] + (sh - cur[j]) * mu[j]); }
        *(LAS u32x4*)(X1 + i * LP + jq * 8) = pack8(tmp);
        unpack8(now.la[0], cur); unpack8(now.la[1], prv); lds8f(PRM + 64 + jq * 8, mu);
#pragma unroll
        for (int j = 0; j < 8; ++j) { const float sh = has_prev ? prv[j] : 0.f; tmp[j] = cur[j] + (sh - cur[j]) * mu[j]; }
        *(LAS u32x4*)(X2 + i * LP + jq * 8) = pack8(tmp);
        *(LAS u32x4*)(W2s + i * LP + jq * 8) = now.w2; *(LAS u32x4*)(A2s + i * LP + jq * 8) = now.a2;
        unpack8(now.pr[0], cur); unpack8(now.pr[1], prv); lds8f(PRM + 128 + jq * 8, mu);
#pragma unroll
        for (int j = 0; j < 8; ++j) { const float sh = has_prev ? prv[j] : 0.f; pr[j] = cur[j] + (sh - cur[j]) * mu[j]; }
        unpack8(now.pk[0], cur); unpack8(now.pk[1], prv); lds8f(PRM + 192 + jq * 8, mu);
#pragma unroll
        for (int j = 0; j < 8; ++j) { const float sh = has_prev ? prv[j] : 0.f; pk[j] = cur[j] + (sh - cur[j]) * mu[j]; }
        unpack8(now.pv[0], cur); unpack8(now.pv[1], prv); lds8f(PRM + 256 + jq * 8, mu);
#pragma unroll
        for (int j = 0; j < 8; ++j) { const float sh = has_prev ? prv[j] : 0.f; pv[j] = cur[j] + (sh - cur[j]) * mu[j]; }
    }
    __syncthreads();
    if (unit_next >= 0) r1_issue(a, unit_next, tid, nxt);
    SEG_T1(1); SEG_T0(2);
    {   f32x4 acc[2]; const int rt = wid >> 1, ct0 = 2 * (wid & 1);
        zero2(acc); mm64(X1, W2s, acc, wid, fr, fq);
#pragma unroll
        for (int cc = 0; cc < 2; ++cc)
#pragma unroll
            for (int g = 0; g < 4; ++g) WPf[(16 * rt + 4 * fq + g) * 68 + 16 * (ct0 + cc) + fr] = acc[cc][g];
        zero2(acc); mm64(X2, A2s, acc, wid, fr, fq);
#pragma unroll
        for (int cc = 0; cc < 2; ++cc)
#pragma unroll
            for (int g = 0; g < 4; ++g) APf[(16 * rt + 4 * fq + g) * 68 + 16 * (ct0 + cc) + fr] = acc[cc][g];
    }
    __syncthreads();
    float ev[8], ah[8], kk[8], kp[8], G[8];
    {   float w0[8], a0[8], kkw[8], kaw[8], wp[8], ap[8];
        lds8f(PRM + 320 + jq * 8, w0); lds8f(PRM + 384 + jq * 8, a0); lds8f(PRM + 448 + jq * 8, kkw); lds8f(PRM + 512 + jq * 8, kaw);
        { const f32x4 x0 = *(const LAS f32x4*)(WPf + i * 68 + jq * 8), x1 = *(const LAS f32x4*)(WPf + i * 68 + jq * 8 + 4); wp[0] = x0.x; wp[1] = x0.y; wp[2] = x0.z; wp[3] = x0.w; wp[4] = x1.x; wp[5] = x1.y; wp[6] = x1.z; wp[7] = x1.w; }
        { const f32x4 x0 = *(const LAS f32x4*)(APf + i * 68 + jq * 8), x1 = *(const LAS f32x4*)(APf + i * 68 + jq * 8 + 4); ap[0] = x0.x; ap[1] = x0.y; ap[2] = x0.z; ap[3] = x0.w; ap[4] = x1.x; ap[5] = x1.y; ap[6] = x1.z; ap[7] = x1.w; }
        float ss = 0.f;
        const int li = lane >> 3;
#pragma unroll
        for (int j = 0; j < 8; ++j) {
            const float z = -(w0[j] + wp[j]);
            const float sp = (z > 15.f) ? z : __logf(1.f + __expf(z));
            ev[j] = __expf(-sp - 0.5f);
            ah[j] = sigmoidf_(a0[j] + ap[j]);
            kk[j] = pk[j] * kkw[j]; ss += kk[j] * kk[j];
            kp[j] = pk[j] * (1.f + (ah[j] - 1.f) * kaw[j]);
            float v = ev[j]; float t = __shfl_up(v, 8); if (li >= 1) v += t; t = __shfl_up(v, 16); if (li >= 2) v += t; t = __shfl_up(v, 32); if (li >= 4) v += t; G[j] = v;
        }
        ss += __shfl_xor(ss, 1); ss += __shfl_xor(ss, 2); ss += __shfl_xor(ss, 4);
        const float inv = 1.f / fmaxf(sqrtf(ss), 1e-12f);
#pragma unroll
        for (int j = 0; j < 8; ++j) kk[j] *= inv;
        if (li == 7) { *(LAS f32x4*)(TOT + wid * 64 + jq * 8) = (f32x4){G[0], G[1], G[2], G[3]}; *(LAS f32x4*)(TOT + wid * 64 + jq * 8 + 4) = (f32x4){G[4], G[5], G[6], G[7]}; }
    }
    SEG_T1(2); SEG_T0(3);
    __syncthreads();
    float G63[8];
    {
#pragma unroll
        for (int j = 0; j < 8; ++j) G63[j] = 0.f;
#pragma unroll
        for (int q = 0; q < 8; ++q) { const f32x4 t0 = *(const LAS f32x4*)(TOT + q * 64 + jq * 8), t1 = *(const LAS f32x4*)(TOT + q * 64 + jq * 8 + 4);
            const float tt[8] = {t0.x, t0.y, t0.z, t0.w, t1.x, t1.y, t1.z, t1.w};
#pragma unroll
            for (int j = 0; j < 8; ++j) { G63[j] += tt[j]; if (q < wid) G[j] += tt[j]; } }
    }
    SEG_T1(3); SEG_T0(4);
    {   float at[8], rt_[8], bt[8], kt[8];
#pragma unroll
        for (int j = 0; j < 8; ++j) {
            const float gi = __expf(-G[j]), gpi = __expf(-(G[j] - ev[j])), ig = __expf(G[j]);
            const float bb = kk[j] * ah[j];
            at[j] = -kk[j] * gpi; rt_[j] = pr[j] * gi; bt[j] = bb * ig; kt[j] = kp[j] * ig;
        }
        *(LAS u32x4*)(AT + i * LP + jq * 8) = pack8(at); *(LAS u32x4*)(RT + i * LP + jq * 8) = pack8(rt_);
        *(LAS u32x4*)(BT + i * LP + jq * 8) = pack8(bt); *(LAS u32x4*)(KT + i * LP + jq * 8) = pack8(kt);
        *(LAS u32x4*)(VTm + i * LP + jq * 8) = pack8(pv);
        if (i == 0) { float gcv[8];
#pragma unroll
            for (int j = 0; j < 8; ++j) gcv[j] = __expf(-G63[j]);
            float* RG = (float*)((unsigned char*)a.out + DO_RG) + (size_t)unit * 64 + jq * 8;
            *(f32x4*)RG = (f32x4){gcv[0], gcv[1], gcv[2], gcv[3]}; *(f32x4*)(RG + 4) = (f32x4){gcv[4], gcv[5], gcv[6], gcv[7]};
            *(LAS f32x4*)(GCs + jq * 8) = (f32x4){gcv[0], gcv[1], gcv[2], gcv[3]}; *(LAS f32x4*)(GCs + jq * 8 + 4) = (f32x4){gcv[4], gcv[5], gcv[6], gcv[7]}; }
    }
    __syncthreads();
    SEG_T1(4); SEG_T0(5);
    f32x4 acc[2];
    LAS unsigned char* DINV = lds + 14 * RB + 2048;
    LAS bf16_t *LL = RWBUF(8), *AAKb = RWBUF(9), *ARBb = RWBUF(10), *ARKb = RWBUF(11), *ABn = RWBUF(12), *UBn = RWBUF(13);
    {
    zero2(acc); mm64(AT, BT, acc, wid, fr, fq); mask2<1>(acc, wid, fr, fq); store_rm(LL, acc, wid, fr, fq);
    zero2(acc); mm64(AT, KT, acc, wid, fr, fq); mask2<1>(acc, wid, fr, fq); store_rm(AAKb, acc, wid, fr, fq);
    zero2(acc); mm64(RT, BT, acc, wid, fr, fq); mask2<2>(acc, wid, fr, fq); store_rm(ARBb, acc, wid, fr, fq);
    zero2(acc); mm64(RT, KT, acc, wid, fr, fq); mask2<2>(acc, wid, fr, fq); store_rm(ARKb, acc, wid, fr, fq);
    {
        const int rt = wid >> 1, ct0 = 2 * (wid & 1), sI = wid & 1;
        bf16x8 idf[2];
#pragma unroll
        for (int cc = 0; cc < 2; ++cc) { const int j = 16 * (ct0 + cc) + fr - (32 * sI + 8 * fq); u32x4 w = (u32x4){0u, 0u, 0u, 0u};
            const unsigned one = (j & 1) ? 0x3F800000u : 0x00003F80u;
            if (j >= 0 && j < 8) { if ((j >> 1) == 0) w.x = one; else if ((j >> 1) == 1) w.y = one; else if ((j >> 1) == 2) w.z = one; else w.w = one; }
            idf[cc] = __builtin_bit_cast(bf16x8, w); }
        const float gc0 = GCs[16 * ct0 + fr], gc1 = GCs[16 * (ct0 + 1) + fr];
        const int ao = (16 * rt + fr) * LP + 32 * sI + 8 * fq;
        f32x4 t2[2];
        { const bf16x8 af = *(const LAS bf16x8*)(AT + ao); zero2(t2); t2[0] = __builtin_amdgcn_mfma_f32_16x16x32_bf16(af, idf[0], t2[0], 0, 0, 0); t2[1] = __builtin_amdgcn_mfma_f32_16x16x32_bf16(af, idf[1], t2[1], 0, 0, 0); store_tr(ATc, t2, wid, fr, fq); }
        { const bf16x8 af = *(const LAS bf16x8*)(VTm + ao); zero2(t2); t2[0] = __builtin_amdgcn_mfma_f32_16x16x32_bf16(af, idf[0], t2[0], 0, 0, 0); t2[1] = __builtin_amdgcn_mfma_f32_16x16x32_bf16(af, idf[1], t2[1], 0, 0, 0); store_tr(VTc, t2, wid, fr, fq); }
        { const bf16x8 af = *(const LAS bf16x8*)(KT + ao); zero2(t2); t2[0] = __builtin_amdgcn_mfma_f32_16x16x32_bf16(af, idf[0], t2[0], 0, 0, 0); t2[1] = __builtin_amdgcn_mfma_f32_16x16x32_bf16(af, idf[1], t2[1], 0, 0, 0); t2[0] = t2[0] * gc0; t2[1] = t2[1] * gc1; store_tr(KHc, t2, wid, fr, fq); }
        { const bf16x8 af = *(const LAS bf16x8*)(BT + ao); zero2(t2); t2[0] = __builtin_amdgcn_mfma_f32_16x16x32_bf16(af, idf[0], t2[0], 0, 0, 0); t2[1] = __builtin_amdgcn_mfma_f32_16x16x32_bf16(af, idf[1], t2[1], 0, 0, 0); t2[0] = t2[0] * gc0; t2[1] = t2[1] * gc1; store_tr(BHc, t2, wid, fr, fq); }
    }
    if (wid < 4) {
        f32x4 Pm = (f32x4){0.f, 0.f, 0.f, 0.f}, Qm = Pm;
#pragma unroll
        for (int s = 0; s < 2; ++s) { const bf16x8 fa = *(const LAS bf16x8*)(AT + (16 * wid + fr) * LP + 32 * s + 8 * fq), fb = *(const LAS bf16x8*)(BT + (16 * wid + fr) * LP + 32 * s + 8 * fq);
            Pm = __builtin_amdgcn_mfma_f32_16x16x32_bf16(fa, fb, Pm, 0, 0, 0); Qm = __builtin_amdgcn_mfma_f32_16x16x32_bf16(fb, fa, Qm, 0, 0, 0); }
        f32x4 Tm, Tt;
#pragma unroll
        for (int g = 0; g < 4; ++g) { const int row = 4 * fq + g, col = fr; if (!(row > col)) Pm[g] = 0.f; if (!(col > row)) Qm[g] = 0.f; Tm[g] = Pm[g] + (row == col ? 1.f : 0.f); Tt[g] = Qm[g] + (row == col ? 1.f : 0.f); }
#pragma unroll
        for (int it = 0; it < 3; ++it) {
            const s16x4 pb = bf4(Pm), qb = bf4(Qm); const f32x4 z = (f32x4){0.f, 0.f, 0.f, 0.f};
            const f32x4 Pn = __builtin_amdgcn_mfma_f32_16x16x16bf16_1k(qb, pb, z, 0, 0, 0);
            const f32x4 Qn = __builtin_amdgcn_mfma_f32_16x16x16bf16_1k(pb, qb, z, 0, 0, 0);
            const s16x4 pnb = bf4(Pn), qnb = bf4(Qn), tb = bf4(Tm), ttb = bf4(Tt);
            Tm = __builtin_amdgcn_mfma_f32_16x16x16bf16_1k(ttb, pnb, Tm, 0, 0, 0);
            Tt = __builtin_amdgcn_mfma_f32_16x16x16bf16_1k(pnb, ttb, Tt, 0, 0, 0);
            (void)qnb; (void)tb; Pm = Pn; Qm = Qn;
        }
        *(LAS s16x4*)(DINV + wid * 512 + lane * 8) = bf4(Tt);
    }
    __syncthreads();
    SEG_T1(5); SEG_T0(6);
    {   f32x4 rhs[4], sol[4];
        if (wid < 4) {
#pragma unroll
            for (int i4 = 0; i4 < 4; ++i4) { const u32x2 t2 = *(const LAS u32x2*)(ATc + (16 * wid + fr) * LP + 16 * i4 + 4 * fq); rhs[i4] = (f32x4){bflo(t2.x), bfhi(t2.x), bflo(t2.y), bfhi(t2.y)}; }
        } else {
#pragma unroll
            for (int i4 = 0; i4 < 4; ++i4) { rhs[i4] = (f32x4){0.f, 0.f, 0.f, 0.f};
#pragma unroll
                for (int s = 0; s < 2; ++s) { const bf16x8 fa = *(const LAS bf16x8*)(AAKb + (16 * i4 + fr) * LP + 32 * s + 8 * fq), fb = *(const LAS bf16x8*)(VTc + (16 * (wid - 4) + fr) * LP + 32 * s + 8 * fq);
                    rhs[i4] = __builtin_amdgcn_mfma_f32_16x16x32_bf16(fa, fb, rhs[i4], 0, 0, 0); } }
        }
        const f32x4 z = (f32x4){0.f, 0.f, 0.f, 0.f};
#pragma unroll
        for (int i4 = 0; i4 < 4; ++i4) { f32x4 ac = rhs[i4];
#pragma unroll
            for (int j4 = 0; j4 < 4; ++j4) if (j4 < i4) ac = __builtin_amdgcn_mfma_f32_16x16x16bf16_1k(*(const LAS s16x4*)(LL + (16 * i4 + fr) * LP + 16 * j4 + 4 * fq), bf4(sol[j4]), ac, 0, 0, 0);
            sol[i4] = __builtin_amdgcn_mfma_f32_16x16x16bf16_1k(*(const LAS s16x4*)(DINV + i4 * 512 + lane * 8), bf4(ac), z, 0, 0, 0); }
        LAS bf16_t* dst = (wid < 4) ? (ABn + (16 * wid + fr) * LP) : (UBn + (16 * (wid - 4) + fr) * LP);
#pragma unroll
        for (int i4 = 0; i4 < 4; ++i4) *(LAS s16x4*)(dst + 16 * i4 + 4 * fq) = bf4(sol[i4]);
    }
    __syncthreads();
    SEG_T1(6); SEG_T0(7);
    {   const int rt = wid >> 1, ct0 = 2 * (wid & 1);
        bf16_t* RM = (bf16_t*)((unsigned char*)a.out + DO_RM) + (size_t)unit * 4096;
        zero2(acc); mm64(ABn, BHc, acc, wid, fr, fq);
#pragma unroll
        for (int cc = 0; cc < 2; ++cc) *(s16x4*)(RM + afrag_index(16 * (ct0 + cc) + fr, 16 * rt + 4 * fq)) = bf4(acc[cc]);
        bf16_t* RN = (bf16_t*)(a.ws + WS_RN) + (size_t)unit * 4096;
        zero2(acc); mm64(KHc, VTc, acc, wid, fr, fq); mm64(BHc, UBn, acc, wid, fr, fq);
#pragma unroll
        for (int cc = 0; cc < 2; ++cc) *(s16x4*)(RN + nfrag_index(16 * (ct0 + cc) + fr, 16 * rt + 4 * fq)) = bf4(acc[cc]);
        bf16_t* RR = (bf16_t*)((unsigned char*)a.out + DO_RR) + (size_t)unit * 4096;
#pragma unroll
        for (int cc = 0; cc < 2; ++cc) { const u32x2 t2 = *(const LAS u32x2*)(RT + (16 * (ct0 + cc) + fr) * LP + 16 * rt + 4 * fq); acc[cc] = (f32x4){bflo(t2.x), bfhi(t2.x), bflo(t2.y), bfhi(t2.y)}; }
        mm64(ABn, ARBb, acc, wid, fr, fq);
#pragma unroll
        for (int cc = 0; cc < 2; ++cc) *(s16x4*)(RR + (16 * (ct0 + cc) + fr) * 64 + 16 * rt + 4 * fq) = bf4(acc[cc]);
        bf16_t* Y = (bf16_t*)(a.ws + (d ? WS_YB : WS_YRW));
        zero2(acc); mm64(UBn, ARBb, acc, wid, fr, fq); mm64(VTc, ARKb, acc, wid, fr, fq);
#pragma unroll
        for (int cc = 0; cc < 2; ++cc) *(s16x4*)(Y + ((size_t)b * SEQ + scan_tok(d, c, 16 * (ct0 + cc) + fr)) * RWW + h * 64 + 16 * rt + 4 * fq) = bf4(acc[cc]);
    }
    __syncthreads();
    SEG_T1(7);
    }
}

constexpr int R2_SLOT = 12288, R2_MF = 0, R2_NF = 8192, R2_GM = 10240, R2_DM = 11264, R2_NS = 8, R2_AHEAD = 6;
__device__ __forceinline__ void r2_issue(const Args& a, LAS unsigned char* lds, int chain, int vg, int c, int q, int lane) {
    LAS unsigned char* slot = lds + (c & (R2_NS - 1)) * R2_SLOT; const size_t unit = (size_t)chain * NCH + c;
    const unsigned char* RM = (const unsigned char*)a.out + DO_RM + unit * 8192; const unsigned char* RN = a.ws + WS_RN + unit * 8192 + vg * 2048;
    const unsigned char* RG = (const unsigned char*)a.out + DO_RG + unit * 256;
    __builtin_amdgcn_global_load_lds((const unsigned*)(RM + q * 1024 + lane * 16), (LAS unsigned*)(slot + R2_MF + q * 1024), 16, 0, 0);
    __builtin_amdgcn_global_load_lds((const unsigned*)(RM + (q + 4) * 1024 + lane * 16), (LAS unsigned*)(slot + R2_MF + (q + 4) * 1024), 16, 0, 0);
    if (q < 2) __builtin_amdgcn_global_load_lds((const unsigned*)(RN + q * 1024 + lane * 16), (LAS unsigned*)(slot + R2_NF + q * 1024), 16, 0, 0);
    else       __builtin_amdgcn_global_load_lds((const unsigned*)(RG + lane * 16), (LAS unsigned*)(slot + (q == 2 ? R2_GM : R2_DM)), 16, 0, 0);
}
template <bool DRY> __device__ __forceinline__ void rwkv_state_wg(const Args& a, LAS unsigned char* lds, int task, int tid) {
    const int chain = task % (2 * NB * RWH), vg = task / (2 * NB * RWH);
    const int wave = __builtin_amdgcn_readfirstlane(tid >> 6), lane = tid & 63, fr = lane & 15, fq = lane >> 4;
    if (wave >= 4) {
        const int q = wave - 4;
#pragma unroll
        for (int c = 0; c < R2_AHEAD; ++c) r2_issue(a, lds, chain, vg, c, q, lane);
#pragma unroll 1
        for (int c = 0; c < NCH; ++c) {
            if (c + R2_AHEAD < NCH) { r2_issue(a, lds, chain, vg, c + R2_AHEAD, q, lane); asm volatile("s_waitcnt vmcnt(18)" ::: "memory"); }
            else asm volatile("s_waitcnt vmcnt(0)" ::: "memory");
            __builtin_amdgcn_s_barrier();
        }
    } else if (wave != 0) {
#pragma unroll 1
        for (int c = 0; c < NCH; ++c) __builtin_amdgcn_s_barrier();
    } else {
        f32x4 S[4];
#pragma unroll
        for (int kt = 0; kt < 4; ++kt) S[kt] = (f32x4){0.f, 0.f, 0.f, 0.f};
#pragma unroll 1
        for (int c = 0; c < NCH; ++c) {
            bf16_t* S0 = (bf16_t*)(a.ws + WS_RN) + ((size_t)chain * NCH + c) * 4096;
            asm volatile("s_waitcnt lgkmcnt(0)" ::: "memory");
            __builtin_amdgcn_s_barrier();
            asm volatile("" ::: "memory");
            const LAS unsigned char* slot = lds + (c & (R2_NS - 1)) * R2_SLOT;
            bf16x8 mf[4][2];
#pragma unroll
            for (int t4 = 0; t4 < 4; ++t4)
#pragma unroll
                for (int s = 0; s < 2; ++s) mf[t4][s] = *(const LAS bf16x8*)(slot + R2_MF + ((t4 * 2 + s) * 64 + lane) * 16);
            const u32x4 n0 = *(const LAS u32x4*)(slot + R2_NF + lane * 32), n1 = *(const LAS u32x4*)(slot + R2_NF + lane * 32 + 16);
            f32x4 gm4[4];
#pragma unroll
            for (int kt = 0; kt < 4; ++kt) gm4[kt] = *(const LAS f32x4*)(slot + R2_GM + (16 * kt + 4 * fq) * 4);
            bf16x8 bs[2];
#pragma unroll
            for (int s = 0; s < 2; ++s) { u32x4 w; w.x = cvtpk(S[2 * s][0], S[2 * s][1]); w.y = cvtpk(S[2 * s][2], S[2 * s][3]); w.z = cvtpk(S[2 * s + 1][0], S[2 * s + 1][1]); w.w = cvtpk(S[2 * s + 1][2], S[2 * s + 1][3]); bs[s] = __builtin_bit_cast(bf16x8, w); }
            if (!DRY) {
                const u32x4 w0 = __builtin_bit_cast(u32x4, bs[0]), w1 = __builtin_bit_cast(u32x4, bs[1]);
                bf16_t* sp = S0 + (16 * vg + fr) * 64 + 4 * fq;
                *(u32x2*)(sp) = (u32x2){w0.x, w0.y}; *(u32x2*)(sp + 16) = (u32x2){w0.z, w0.w}; *(u32x2*)(sp + 32) = (u32x2){w1.x, w1.y}; *(u32x2*)(sp + 48) = (u32x2){w1.z, w1.w};
            }
            const float nv[16] = {bflo(n0.x), bfhi(n0.x), bflo(n0.y), bfhi(n0.y), bflo(n0.z), bfhi(n0.z), bflo(n0.w), bfhi(n0.w), bflo(n1.x), bfhi(n1.x), bflo(n1.y), bfhi(n1.y), bflo(n1.z), bfhi(n1.z), bflo(n1.w), bfhi(n1.w)};
#pragma unroll
            for (int kt = 0; kt < 4; ++kt) { f32x4 na;
#pragma unroll
                for (int g = 0; g < 4; ++g) na[g] = S[kt][g] * gm4[kt][g] + nv[kt * 4 + g];
                na = __builtin_amdgcn_mfma_f32_16x16x32_bf16(mf[kt][0], bs[0], na, 0, 0, 0); na = __builtin_amdgcn_mfma_f32_16x16x32_bf16(mf[kt][1], bs[1], na, 0, 0, 0);
                S[kt] = na; }
        }
    }
    asm volatile("s_waitcnt vmcnt(0) lgkmcnt(0)" ::: "memory");
    __syncthreads();
}

__device__ __forceinline__ void rwkv_final_unit(const Args& a, LAS unsigned char* lds, int unit, int tid) {
    const int tc = unit & 127, h = (unit >> 7) % RWH, b = unit / (128 * RWH);
    const int wid = __builtin_amdgcn_readfirstlane(tid >> 6), lane = tid & 63, fr = lane & 15, fq = lane >> 4;
    const int i = tid >> 3, jq = tid & 7, ch0 = h * 64 + jq * 8;
    const bf16_t* P = (const bf16_t*)(a.ws + WS_P);
    const int s_cur = tc * 64 + i; const size_t tok = (size_t)b * SEQ + s_cur;
    LAS bf16_t *XA0 = RWBUF(0), *XA1 = RWBUF(1), *A2s0 = RWBUF(2), *A2s1 = RWBUF(3);
    LAS bf16_t *XG = (LAS bf16_t*)(lds + 4 * RB);
    LAS bf16_t *G2s = (LAS bf16_t*)(lds + 4 * RB + 64 * 136 * 2);
    LAS float *YS = (LAS float*)lds;
    LAS float *AP0 = (LAS float*)(lds + 8 * RB), *AP1 = (LAS float*)(lds + 8 * RB + 16384), *GP = (LAS float*)(lds + 8 * RB + 32768);
    float r_[2][8], k_[2][8], v_[2][8];
    {   float cur[8], nb[8], mu[8], tmp[8];
#pragma unroll
        for (int d = 0; d < 2; ++d) {
            const bool has = d ? (s_cur < SEQ - 1) : (s_cur > 0); const size_t tokp = has ? (d ? tok + 1 : tok - 1) : tok;
            unpack8(*(const u32x4*)(P + tok * PW + C_LA + jq * 8), cur); unpack8(*(const u32x4*)(P + tokp * PW + C_LA + jq * 8), nb); ld8f(a.in[I_MUA] + d * 64 + jq * 8, mu);
#pragma unroll
            for (int j = 0; j < 8; ++j) { const float sh = has ? nb[j] : 0.f; tmp[j] = cur[j] + (sh - cur[j]) * mu[j]; }
            *(LAS u32x4*)((d ? XA1 : XA0) + i * LP + jq * 8) = pack8(tmp); __builtin_amdgcn_sched_barrier(0);
            *(LAS u32x4*)((d ? A2s1 : A2s0) + i * LP + jq * 8) = *(const u32x4*)((const bf16_t*)(a.ws + WS_A2T) + ((size_t)d * 384 + h * 64 + i) * 64 + jq * 8);
            unpack8(*(const u32x4*)(P + tok * PW + C_PR + ch0), cur); unpack8(*(const u32x4*)(P + tokp * PW + C_PR + ch0), nb); ld8f(a.in[I_MURKV] + (d * 3 + 0) * 384 + ch0, mu);
#pragma unroll
            for (int j = 0; j < 8; ++j) { const float sh = has ? nb[j] : 0.f; r_[d][j] = cur[j] + (sh - cur[j]) * mu[j]; }
            __builtin_amdgcn_sched_barrier(0);
            unpack8(*(const u32x4*)(P + tok * PW + C_PK + ch0), cur); unpack8(*(const u32x4*)(P + tokp * PW + C_PK + ch0), nb); ld8f(a.in[I_MURKV] + (d * 3 + 1) * 384 + ch0, mu);
#pragma unroll
            for (int j = 0; j < 8; ++j) { const float sh = has ? nb[j] : 0.f; k_[d][j] = cur[j] + (sh - cur[j]) * mu[j]; }
            __builtin_amdgcn_sched_barrier(0);
            unpack8(*(const u32x4*)(P + tok * PW + C_PV + ch0), cur); unpack8(*(const u32x4*)(P + tokp * PW + C_PV + ch0), nb); ld8f(a.in[I_MURKV] + (d * 3 + 2) * 384 + ch0, mu);
#pragma unroll
            for (int j = 0; j < 8; ++j) { const float sh = has ? nb[j] : 0.f; v_[d][j] = cur[j] + (sh - cur[j]) * mu[j]; }
            __builtin_amdgcn_sched_barrier(0);
        }
#pragma unroll
        for (int q = 0; q < 2; ++q) {
            unpack8(*(const u32x4*)(P + tok * PW + C_LG + jq * 16 + q * 8), cur);
#pragma unroll
            for (int j = 0; j < 8; ++j) tmp[j] = sigmoidf_(cur[j]);
            *(LAS u32x4*)(XG + i * 136 + jq * 16 + q * 8) = pack8(tmp); __builtin_amdgcn_sched_barrier(0);
            *(LAS u32x4*)(G2s + i * 136 + jq * 16 + q * 8) = *(const u32x4*)((const bf16_t*)(a.ws + WS_G2T) + ((size_t)h * 64 + i) * 128 + jq * 16 + q * 8);
        }
    }
    __syncthreads();
    {   f32x4 acc[2]; const int rt = wid >> 1, ct0 = 2 * (wid & 1);
        zero2(acc); mm64(XA0, A2s0, acc, wid, fr, fq);
#pragma unroll
        for (int cc = 0; cc < 2; ++cc)
#pragma unroll
            for (int g = 0; g < 4; ++g) AP0[(16 * rt + 4 * fq + g) * 64 + 16 * (ct0 + cc) + fr] = acc[cc][g];
        zero2(acc); mm64(XA1, A2s1, acc, wid, fr, fq);
#pragma unroll
        for (int cc = 0; cc < 2; ++cc)
#pragma unroll
            for (int g = 0; g < 4; ++g) AP1[(16 * rt + 4 * fq + g) * 64 + 16 * (ct0 + cc) + fr] = acc[cc][g];
        zero2(acc);
#pragma unroll
        for (int s = 0; s < 4; ++s) { const bf16x8 af = *(const LAS bf16x8*)(XG + (16 * rt + fr) * 136 + 32 * s + 8 * fq);
#pragma unroll
            for (int cc = 0; cc < 2; ++cc) { const bf16x8 bfrag = *(const LAS bf16x8*)(G2s + (16 * (ct0 + cc) + fr) * 136 + 32 * s + 8 * fq); acc[cc] = __builtin_amdgcn_mfma_f32_16x16x32_bf16(af, bfrag, acc[cc], 0, 0, 0); } }
#pragma unroll
        for (int cc = 0; cc < 2; ++cc)
#pragma unroll
            for (int g = 0; g < 4; ++g) GP[(16 * rt + 4 * fq + g) * 64 + 16 * (ct0 + cc) + fr] = acc[cc][g];
        f32x4 ay[2][2];
#pragma unroll
        for (int d = 0; d < 2; ++d) {
            const size_t ud = ((size_t)((d * 4 + b) * RWH + h)) * NCH + (d ? (NCH - 1 - tc) : tc);
            const bf16_t* RRd = (const bf16_t*)((const unsigned char*)a.out + DO_RR) + ud * 4096; const bf16_t* S0d = (const bf16_t*)(a.ws + WS_RN) + ud * 4096;
            zero2(ay[d]);
#pragma unroll
            for (int s = 0; s < 2; ++s) { const bf16x8 af = *(const bf16x8*)(RRd + (16 * rt + fr) * 64 + 32 * s + 8 * fq);
#pragma unroll
                for (int cc = 0; cc < 2; ++cc) { const bf16x8 bfrag = *(const bf16x8*)(S0d + (16 * (ct0 + cc) + fr) * 64 + 32 * s + 8 * fq); ay[d][cc] = __builtin_amdgcn_mfma_f32_16x16x32_bf16(af, bfrag, ay[d][cc], 0, 0, 0); } }
        }
        __syncthreads();
#pragma unroll
        for (int d = 0; d < 2; ++d)
#pragma unroll
            for (int cc = 0; cc < 2; ++cc)
#pragma unroll
                for (int g = 0; g < 4; ++g) { const int tp = 16 * rt + 4 * fq + g; YS[(d * 64 + (d ? 63 - tp : tp)) * 64 + 16 * (ct0 + cc) + fr] = ay[d][cc][g]; }
    }
    __syncthreads();
    {   float bonus[8], rk[8], kaw[8], a0[8], ap[8];
#pragma unroll
        for (int j = 0; j < 8; ++j) bonus[j] = 0.f;
        ld8f(a.in[I_RK] + ch0, rk); ld8f(a.in[I_KA] + ch0, kaw);
#pragma unroll
        for (int d = 0; d < 2; ++d) {
            ld8f(a.in[I_A0] + d * 384 + ch0, a0);
            const LAS float* APd = d ? AP1 : AP0;
            { const f32x4 x0 = *(const LAS f32x4*)(APd + i * 64 + jq * 8), x1 = *(const LAS f32x4*)(APd + i * 64 + jq * 8 + 4); ap[0] = x0.x; ap[1] = x0.y; ap[2] = x0.z; ap[3] = x0.w; ap[4] = x1.x; ap[5] = x1.y; ap[6] = x1.z; ap[7] = x1.w; }
            float dot = 0.f;
#pragma unroll
            for (int j = 0; j < 8; ++j) { const float ahv = sigmoidf_(a0[j] + ap[j]); const float kp = k_[d][j] * (1.f + (ahv - 1.f) * kaw[j]); dot += r_[d][j] * kp * rk[j]; }
            dot += __shfl_xor(dot, 1); dot += __shfl_xor(dot, 2); dot += __shfl_xor(dot, 4);
#pragma unroll
            for (int j = 0; j < 8; ++j) bonus[j] += dot * v_[d][j];
        }
        float yf[8], yb[8], ys[8], lng[8], lnb[8], gg[8];
        bf16_t* YF = (bf16_t*)(a.ws + WS_YRW) + tok * RWW + ch0; const bf16_t* YBp = (const bf16_t*)(a.ws + WS_YB) + tok * RWW + ch0;
        unpack8(*(const u32x4*)YF, yf); unpack8(*(const u32x4*)YBp, yb); ld8f(a.in[I_LNG] + ch0, lng); ld8f(a.in[I_LNB] + ch0, lnb);
        { const f32x4 x0 = *(const LAS f32x4*)(GP + i * 64 + jq * 8), x1 = *(const LAS f32x4*)(GP + i * 64 + jq * 8 + 4); gg[0] = x0.x; gg[1] = x0.y; gg[2] = x0.z; gg[3] = x0.w; gg[4] = x1.x; gg[5] = x1.y; gg[6] = x1.z; gg[7] = x1.w; }
        float sm = 0.f;
        { const f32x4 f0 = *(const LAS f32x4*)(YS + i * 64 + jq * 8), f1 = *(const LAS f32x4*)(YS + i * 64 + jq * 8 + 4), b0 = *(const LAS f32x4*)(YS + (64 + i) * 64 + jq * 8), b1 = *(const LAS f32x4*)(YS + (64 + i) * 64 + jq * 8 + 4);
          yf[0] += f0.x + b0.x; yf[1] += f0.y + b0.y; yf[2] += f0.z + b0.z; yf[3] += f0.w + b0.w; yf[4] += f1.x + b1.x; yf[5] += f1.y + b1.y; yf[6] += f1.z + b1.z; yf[7] += f1.w + b1.w; }
#pragma unroll
        for (int j = 0; j < 8; ++j) { ys[j] = yf[j] + yb[j]; sm += ys[j]; }
        sm += __shfl_xor(sm, 1); sm += __shfl_xor(sm, 2); sm += __shfl_xor(sm, 4);
        const float mean = sm * (1.f / 64.f); float vs = 0.f;
#pragma unroll
        for (int j = 0; j < 8; ++j) { const float dd = ys[j] - mean; vs += dd * dd; }
        vs += __shfl_xor(vs, 1); vs += __shfl_xor(vs, 2); vs += __shfl_xor(vs, 4);
        const float rstd = 1.f / sqrtf(vs * (1.f / 64.f) + GN_EPS);
        float o[8];
#pragma unroll
        for (int j = 0; j < 8; ++j) o[j] = ((ys[j] - mean) * rstd * lng[j] + lnb[j] + bonus[j]) * gg[j];
        *(u32x4*)YF = pack8(o);
    }
    __syncthreads();
}
#ifndef ONE_LAUNCH
#define ONE_LAUNCH 1
#endif
constexpr int NPHASE = 12;
#ifndef REPMASK
#define REPMASK 0
#endif
#define NREP(k) (1 + ((REPMASK >> (k)) & 1))
#ifndef FUSED_MASK
#define FUSED_MASK 0xfff
#endif
#define XB_TMO      128
#define XB_XCNT(j)  (256  + 64 * (j))
#define XB_XSUB(j)  (1280 + 64 * (j))
#define XB_XGEN(j)  (2304 + 64 * (j))
#define XB_TOP      3328
#define XB_TOPGEN   3392
#define XCD_BAR_WORDS 3456
#define XB_SPIN_CAP (1u << 22)
__device__ __forceinline__ unsigned xb_ld(unsigned* p)              { return __hip_atomic_load(p, __ATOMIC_RELAXED, __HIP_MEMORY_SCOPE_AGENT); }
__device__ __forceinline__ unsigned xb_add(unsigned* p, unsigned v) { return __hip_atomic_fetch_add(p, v, __ATOMIC_RELAXED, __HIP_MEMORY_SCOPE_AGENT); }
__device__ __forceinline__ unsigned xb_xcc_id() { return (unsigned)__builtin_amdgcn_s_getreg((3 << 11) | 20) & 0xFu; }
#define XB_SPIN(cond, bar) do { unsigned _sp = 0; while (cond) { __builtin_amdgcn_s_sleep(1); \
    if ((++_sp & 255u) == 0u) { if (xb_ld(&(bar)[XB_TMO])) break; if (_sp > XB_SPIN_CAP) { atomicAdd(&(bar)[XB_TMO], 1u); break; } } } } while (0)
struct XcdBarrier { unsigned* bar; unsigned x; volatile LAS unsigned* st; };
__device__ __forceinline__ XcdBarrier xcd_barrier_post(unsigned* bar, volatile LAS unsigned* st) {
    XcdBarrier b; b.bar = bar; b.x = xb_xcc_id(); b.st = st;
    if (threadIdx.x == 0) (void)xb_add(&bar[XB_XCNT(b.x)], 1u);
    return b;
}
__device__ __forceinline__ void xcd_barrier_complete(unsigned* bar, unsigned x, unsigned& nloc, unsigned& nx) {
    const unsigned G = gridDim.x * gridDim.y * gridDim.z;
    unsigned sum, cnt, mine, sp = 0u;
    for (;;) {
        sum = 0u; cnt = 0u; mine = 0u;
#pragma unroll
        for (unsigned j = 0; j < 16; ++j) { const unsigned c = xb_ld(&bar[XB_XCNT(j)]); sum += c; cnt += (c > 0u) ? 1u : 0u; mine = (j == x) ? c : mine; }
        if (sum == G) break;
        __builtin_amdgcn_s_sleep(1);
        if ((++sp & 255u) == 0u) { if (xb_ld(&bar[XB_TMO])) break; if (sp > XB_SPIN_CAP) { atomicAdd(&bar[XB_TMO], 1u); break; } }
    }
    nloc = mine > 0u ? mine : 1u; nx = cnt > 0u ? cnt : 1u;
}
__device__ __forceinline__ void xcd_barrier(const XcdBarrier& b) {
    asm volatile("s_waitcnt vmcnt(0)" ::: "memory");
    __syncthreads();
    if (threadIdx.x == 0) {
        unsigned* bar = b.bar;
        __builtin_amdgcn_s_waitcnt(0);
        unsigned nloc = b.st[0], nx = b.st[1];
        if (nloc == 0u) { xcd_barrier_complete(bar, b.x, nloc, nx); b.st[0] = nloc; b.st[1] = nx; }
        const unsigned old = xb_add(&bar[XB_XSUB(b.x)], 1u);
        const unsigned gen = old / nloc;
        if (old + 1u == (gen + 1u) * nloc) {
            __builtin_amdgcn_fence(__ATOMIC_RELEASE, "agent");
            asm volatile("s_waitcnt vmcnt(0)" ::: "memory");
            const unsigned og = xb_add(&bar[XB_TOP], 1u);
            const unsigned tg = og / nx;
            if (og + 1u == (tg + 1u) * nx) xb_add(&bar[XB_TOPGEN], 1u);
            else XB_SPIN(xb_ld(&bar[XB_TOPGEN]) == tg, bar);
            __builtin_amdgcn_fence(__ATOMIC_ACQUIRE, "agent");
            xb_add(&bar[XB_XGEN(b.x)], 1u);
            asm volatile("s_waitcnt vmcnt(0)" ::: "memory");
        } else {
            XB_SPIN(xb_ld(&bar[XB_XGEN(b.x)]) == gen, bar);
            __builtin_amdgcn_fence(__ATOMIC_ACQUIRE, "agent");
            asm volatile("s_waitcnt vmcnt(0)" ::: "memory");
        }
    }
    __syncthreads();
}
typedef const __attribute__((address_space(4))) Args* KArgP;
#if defined(__HIP_DEVICE_COMPILE__)
__device__ __forceinline__ void load_args(Args& a) {
    KArgP ap_ = (KArgP)__builtin_amdgcn_kernarg_segment_ptr(); asm volatile("" : "+s"(ap_));
#pragma unroll
    for (int i = 0; i < 30; ++i) a.in[i] = ap_->in[i];
    a.out = ap_->out; a.ws = ap_->ws; a.ph_lo = 0; a.ph_hi = 0;
}
#define PHASE_ARGS Args a; load_args(a); unsigned char* ws = a.ws; (void)ws
#else
#define PHASE_ARGS const Args a = a_in; unsigned char* ws = a.ws; (void)ws
#endif
template <int PHM> __global__ void __launch_bounds__(NTHR, 2) fwd_kernel(Args a_in) {
    extern __shared__ __attribute__((aligned(16))) unsigned char lds_raw[];
    LAS unsigned char* lds = (LAS unsigned char*)lds_raw;
    const int tid = threadIdx.x, lane = tid & 63, wave = __builtin_amdgcn_readfirstlane(tid >> 6);
    const int G = gridDim.x, bx = blockIdx.x;
    const int ph_lo = a_in.ph_lo, ph_hi = a_in.ph_hi;
#if ONE_LAUNCH
    cg::grid_group grid = cg::this_grid();
    volatile LAS unsigned* xst = (volatile LAS unsigned*)(lds + LDS_BYTES - 64);
    if (tid < 2) xst[tid] = 0u;
    __syncthreads();
    XcdBarrier xbar = xcd_barrier_post((unsigned*)a_in.ws, xst);
#define SEAM(k) do { if ((k) + 1 < ph_hi) { unsigned long long tb0_ = 0; if (PROBE_SEG == 200) tb0_ = __builtin_amdgcn_s_memrealtime(); \
        if ((k) == 0) grid.sync(); else xcd_barrier(xbar); \
        if (PROBE_SEG == 200 && tid == 0) { const unsigned dt_ = (unsigned)(__builtin_amdgcn_s_memrealtime() - tb0_); atomicMax((unsigned*)a_in.ws + 3600 + (k), 0xFFFFFFFFu - dt_); } } } while (0)
#else
#define SEAM(k) do { } while (0)
#endif
#define IN(k) (((PHM >> (k)) & 1) && ph_lo <= (k) && (k) < ph_hi)
    SegT psg{0ull, 0ull};
#define PH_T0(k) do { if (PROBE_SEG == 100 + (k)) psg.t0 = __builtin_amdgcn_s_memrealtime(); } while (0)
#define PH_T1(k) do { if (PROBE_SEG == 100 + (k)) { const unsigned long long te_ = 2ull * __builtin_amdgcn_s_memrealtime() - psg.t0; while (__builtin_amdgcn_s_memrealtime() < te_) __builtin_amdgcn_s_sleep(4); } } while (0)
    if (IN(0)) { PHASE_ARGS; PH_T0(0); for (int rep = 0; rep < NREP(0); ++rep) phase_prologue(a, lds, wave, lane); PH_T1(0); SEAM(0); }
    if (IN(1)) { PHASE_ARGS; PH_T0(1);
        SchedIn S{16, 2048u, 2048u, (const char*)(ws + WS_XN), (const char*)(ws + WS_WIN), (const char*)(ws + WS_MEMN), (const char*)(ws + WS_WMKV), G, bx};
        EpiIn E{(bf16_t*)(ws + WS_P), (bf16_t*)(ws + WS_G), (bf16_t*)(ws + WS_MKV)};
        for (int rep = 0; rep < NREP(1); ++rep) gm::gemm_phase<EpiIn, SchedIn>(lds, S, E);
        PH_T1(1); SEAM(1);
    }
    if (IN(2)) { PHASE_ARGS; PH_T0(2);
        SegT sg{0ull, 0ull};
        for (int rep = 0; rep < NREP(12); ++rep) for (int u = bx; u < NB * GROWS * NAH; u += G) na_unit(a, lds, u, tid, sg);
        for (int rep = 0; rep < NREP(13); ++rep) for (int u = bx; u < NB * MEMH * 16; u += G) mem_unit(a, lds, u, tid);
        for (int rep = 0; rep < NREP(14); ++rep) {
            constexpr int NU = 2 * NB * RWH * NCH; const int per = (NU + G - 1) / G, u0 = bx * per, u1 = min(NU, u0 + per);
            R1Pre pre; int cur_dh = -1;
            if (u0 < u1) r1_issue(a, u0, tid, pre);
            for (int u = u0; u < u1; ++u) {
                const int dh = (u / (128 * RWH * NB)) * RWH + (u >> 7) % RWH;
                if (dh != cur_dh) { cur_dh = dh; r1_params(a, lds, dh / RWH, dh % RWH, tid); __syncthreads(); }
                const R1Pre now = pre;
                rwkv_chunk_unit(a, lds, u, tid, now, (u + 1 < u1) ? u + 1 : -1, pre, sg);
            }
        }
        SEG_SPIN();
        PH_T1(2); SEAM(2);
    }
    if (IN(3)) { PHASE_ARGS; PH_T0(3);
        for (int ch = bx; ch < 2 * NB * RWH * 4; ch += G) { if (NREP(3) > 1) rwkv_state_wg<true>(a, lds, ch, tid); rwkv_state_wg<false>(a, lds, ch, tid); }
        PH_T1(3); SEAM(3);
    }
    if (IN(4)) { PHASE_ARGS; PH_T0(4);
        for (int u = bx; u < NB * RWH * NCH; u += G) rwkv_final_unit(a, lds, u, tid);
        PH_T1(4); SEAM(4);
    }
    if (IN(5)) { PHASE_ARGS; PH_T0(5);
        const bf16_t* WBR = (const bf16_t*)(ws + WS_WBR);
        { SchedMerge S{6, 768u, 768u, (const char*)(ws + WS_YNA), (const char*)WBR, G, bx}; EpiMerge E{(const bf16_t*)(ws + WS_G), (bf16_t*)(ws + WS_MERGED), 0}; gm::gemm_phase<EpiMerge, SchedMerge>(lds, S, E); }
        VM_WAIT(); __syncthreads();
        { SchedMerge S{6, 768u, 768u, (const char*)(ws + WS_YRW), (const char*)(WBR + 1024 * 384), G, bx}; EpiMerge E{(const bf16_t*)(ws + WS_G), (bf16_t*)(ws + WS_MERGED), 1}; gm::gemm_phase<EpiMerge, SchedMerge>(lds, S, E); }
        VM_WAIT(); __syncthreads();
        { SchedMerge S{4, 512u, 512u, (const char*)(ws + WS_YMEM), (const char*)(WBR + 2 * 1024 * 384), G, bx}; EpiMerge E{(const bf16_t*)(ws + WS_G), (bf16_t*)(ws + WS_MERGED), 2}; gm::gemm_phase<EpiMerge, SchedMerge>(lds, S, E); }
        PH_T1(5); SEAM(5);
    }
    if (IN(6)) { PHASE_ARGS; PH_T0(6);
        SchedOut S{16, 2048u, 2048u, (const char*)(ws + WS_MERGED), (const char*)(ws + WS_WOUT), G, bx}; EpiOut E{a.in[I_X], a.out};
        for (int rep = 0; rep < NREP(6); ++rep) gm::gemm_phase<EpiOut, SchedOut>(lds, S, E);
        PH_T1(6); SEAM(6);
    }
    if (IN(7)) { PHASE_ARGS; PH_T0(7);
        {
            const f32x4* src = (const f32x4*)a.in[I_WROUTER]; LAS f32x4* dst = (LAS f32x4*)lds;
            for (int q = tid; q < DM * NE / 4; q += NTHR) { const int dd_ = q >> 2, e4 = q & 3; dst[(e4 * 4 + (dd_ & 3)) * 256 + (dd_ >> 2)] = src[q]; }
            __syncthreads();
        }
        for (int rep = 0; rep < NREP(7); ++rep) phase_norm_router(a, lds, wave, lane);
        PH_T1(7); SEAM(7);
    }
    if (IN(8)) { PHASE_ARGS; PH_T0(8);
        if (bx < NB * NE) topk_unit(a, lds, bx, tid);
        for (int rep = 0; rep < NREP(8); ++rep) expert_convert(a, lds, wave, lane, bx * NWAVES + wave, G * NWAVES);
        PH_T1(8); SEAM(8);
    }
    if (PROBE_SEG == 300) { const unsigned long long te_ = __builtin_amdgcn_s_memrealtime() + 30000ull; while (__builtin_amdgcn_s_memrealtime() < te_) __builtin_amdgcn_s_sleep(4); }
    if (IN(9)) { PHASE_ARGS; PH_T0(9);
        SchedMoe1 S{16, 2048u, 2048u, (const char*)(ws + WS_XN), (const char*)(ws + WS_WGU), (const int*)(ws + WS_TIDX), G, bx}; EpiMoe1 E{(bf16_t*)(ws + WS_ACT)};
        for (int rep = 0; rep < NREP(9); ++rep) gm::gemm_phase<EpiMoe1, SchedMoe1>(lds, S, E);
        PH_T1(9); SEAM(9);
    }
    if (IN(10)) { PHASE_ARGS; PH_T0(10);
        SchedMoe2 S{32, 4096u, 4096u, (const char*)(ws + WS_ACT), (const char*)(ws + WS_WD), G, bx}; EpiMoe2 E{(bf16_t*)(ws + WS_YE), (const float*)(ws + WS_TVAL)};
        for (int rep = 0; rep < NREP(10); ++rep) gm::gemm_phase<EpiMoe2, SchedMoe2>(lds, S, E);
        PH_T1(10); SEAM(10);
    }
    if (IN(11)) { PHASE_ARGS; PH_T0(11); phase_final(a, wave, lane); PH_T1(11);
        if (PROBE_SEG == 200 && bx == 0) { unsigned long long tot_ = 0; for (int q = 0; q < 11; ++q) tot_ += 0xFFFFFFFFu - __hip_atomic_load((unsigned*)a.ws + 3600 + q, __ATOMIC_RELAXED, __HIP_MEMORY_SCOPE_AGENT);
            const unsigned long long te_ = __builtin_amdgcn_s_memrealtime() + tot_; while (__builtin_amdgcn_s_memrealtime() < te_) __builtin_amdgcn_s_sleep(4); } }
#undef IN
#undef SEAM
}

template <int PHM> static bool prep_kernel(int& per_cu) {
    if (hipFuncSetAttribute((const void*)fwd_kernel<PHM>, hipFuncAttributeMaxDynamicSharedMemorySize, LDS_BYTES) != hipSuccess) return false;
    int pc = 0; if (hipOccupancyMaxActiveBlocksPerMultiprocessor(&pc, (const void*)fwd_kernel<PHM>, NTHR, LDS_BYTES) != hipSuccess) pc = 0;
    (void)hipGetLastError(); if (pc < per_cu) per_cu = pc; return true;
}
template <int P> static void launch_phase(int grid, Args a, hipStream_t stream) { a.ph_lo = P; a.ph_hi = P + 1; hipLaunchKernelGGL(fwd_kernel<(1 << P)>, dim3(grid), dim3(NTHR), LDS_BYTES, stream, a); }
extern "C" void kernel_launch(void* const* d_in, const int* in_sizes, int n_in, void* d_out, int out_size, void* d_ws, size_t ws_size, hipStream_t stream) {
    static int grid = 0;
    if (grid == 0) {
        if (n_in != 30 || out_size != T * DM || ws_size < WS_END) { fprintf(stderr, "kernel_launch: unexpected sizes: n_in %d out %d ws %zu (need %zu)\n", n_in, out_size, ws_size, (size_t)WS_END); grid = -1; return; }
        int dev = 0, cus = 0, per_cu = 99; bool ok = true;
        if (hipGetDevice(&dev) != hipSuccess || hipDeviceGetAttribute(&cus, hipDeviceAttributeMultiprocessorCount, dev) != hipSuccess) ok = false;
#if ONE_LAUNCH
        ok = ok && prep_kernel<FUSED_MASK>(per_cu);
#else
        ok = ok && prep_kernel<1>(per_cu) && prep_kernel<2>(per_cu) && prep_kernel<4>(per_cu) && prep_kernel<8>(per_cu) && prep_kernel<16>(per_cu) && prep_kernel<32>(per_cu) && prep_kernel<64>(per_cu)
                && prep_kernel<128>(per_cu) && prep_kernel<256>(per_cu) && prep_kernel<512>(per_cu) && prep_kernel<1024>(per_cu) && prep_kernel<2048>(per_cu);
#endif
        if (!ok || per_cu < 1) { fprintf(stderr, "kernel_launch: set-up failed (ok %d, per_cu %d)\n", (int)ok, per_cu); grid = -1; return; }
        grid = cus;
        fprintf(stderr, "kernel_launch: grid %d, per_cu %d, ws %zu\n", grid, per_cu, ws_size);
    }
    if (grid < 0) return;
    if (hipMemsetAsync(d_ws, 0, 16384, stream) != hipSuccess) { fprintf(stderr, "kernel_launch: memset failed\n"); return; }
    Args a{};
    for (int i = 0; i < 30; ++i) a.in[i] = (const float*)d_in[i];
    a.out = (float*)d_out; a.ws = (unsigned char*)d_ws;
#if ONE_LAUNCH
    a.ph_lo = 0; a.ph_hi = NPHASE;
    void* args[] = {&a};
    hipError_t e = hipLaunchCooperativeKernel((const void*)fwd_kernel<FUSED_MASK>, dim3(grid), dim3(NTHR), args, LDS_BYTES, stream);
    if (e != hipSuccess) fprintf(stderr, "cooperative launch failed: %s\n", hipGetErrorString(e));
#else
    launch_phase<0>(grid, a, stream); launch_phase<1>(grid, a, stream); launch_phase<2>(grid, a, stream); launch_phase<3>(grid, a, stream); launch_phase<4>(grid, a, stream); launch_phase<5>(grid, a, stream);
    launch_phase<6>(grid, a, stream); launch_phase<7>(grid, a, stream); launch_phase<8>(grid, a, stream); launch_phase<9>(grid, a, stream); launch_phase<10>(grid, a, stream); launch_phase<11>(grid, a, stream);
#endif
}
```
